# Optimizing an MI355X kernel written in HIP

```python
import jax, jax.numpy as jnp
from jax import lax
import numpy as np

D_MODEL = 1024
BATCH = 16
SEQ = 4096
DEPTH = 4

N_EVEN = (DEPTH + 1) // 2
N_ODD = DEPTH // 2
MIX_WIDTH = D_MODEL
LRU_WIDTH = MIX_WIDTH // 2
LRU_HEADS = 8
LRU_HEAD_DIM = LRU_WIDTH // LRU_HEADS
CONV_WIDTH = 4
LRU_C = 8.0
HGRN_WIDTH = MIX_WIDTH // 2
HGRN_HEAD_DIM = 128
HGRN_HEADS = HGRN_WIDTH // HGRN_HEAD_DIM
HGRN_CHUNK = 64
SGU_WIDTH = MIX_WIDTH // 2
SGU_GROUPS = 4
SGU_GROUP_DIM = SGU_WIDTH // SGU_GROUPS
SGU_CHUNK = 128
POOL_WIDTH = MIX_WIDTH // 2
POOL_WINDOWS = (2, 4, 8, 16)
POOL_GROUP_DIM = POOL_WIDTH // len(POOL_WINDOWS)
D_FF = 4 * D_MODEL
EVEN_SPLITS = (LRU_WIDTH, LRU_WIDTH, HGRN_WIDTH, HGRN_WIDTH, HGRN_WIDTH, HGRN_WIDTH)
EVEN_IN = sum(EVEN_SPLITS)
ODD_IN = 2 * SGU_WIDTH + POOL_WIDTH
EPS = 1e-6

kernel_name = "hybrid_rglru_hgrn2_sgu_pool_trunk"

F32 = jnp.float32


def rms_norm(x, gain):
    xf = x.astype(F32)
    y = xf * lax.rsqrt(jnp.mean(xf * xf, axis=-1, keepdims=True) + EPS)
    return (y * gain.astype(F32)).astype(x.dtype)


def causal_depthwise_conv(u, w, b):
    s = u.shape[1]
    up = jnp.pad(u.astype(F32), ((0, 0), (CONV_WIDTH - 1, 0), (0, 0)))
    y = b.astype(F32)
    for k in range(CONV_WIDTH):
        y = y + up[:, k:k + s] * w[k].astype(F32)
    return y


def rg_lru(u, w_a, b_a, w_x, b_x, lam):
    bsz, s, w = u.shape
    uh = u.reshape(bsz, s, LRU_HEADS, LRU_HEAD_DIM)
    r = jax.nn.sigmoid(jnp.einsum('bshi,hij->bshj', uh, w_a.astype(F32)).reshape(bsz, s, w) + b_a.astype(F32))
    i = jax.nn.sigmoid(jnp.einsum('bshi,hij->bshj', uh, w_x.astype(F32)).reshape(bsz, s, w) + b_x.astype(F32))
    log_a = -LRU_C * r * jax.nn.softplus(-lam.astype(F32))
    a = jnp.exp(log_a)
    beta = jnp.sqrt(jnp.maximum(-jnp.expm1(2.0 * log_a), 0.0))
    b_term = beta * (i * u)

    def combine(left, right):
        a_l, b_l = left
        a_r, b_r = right
        return a_l * a_r, a_r * b_l + b_r

    _, h = lax.associative_scan(combine, (a, b_term), axis=1)
    return h


def hgrn2(q, f_pre, v, g, lb, norm_gain):
    bsz, s, _ = q.shape
    nh, d, c = HGRN_HEADS, HGRN_HEAD_DIM, HGRN_CHUNK
    nc = s // c
    qf = jax.nn.silu(q.astype(F32))
    z = f_pre.astype(F32)
    lb = lb.astype(F32)
    f = lb + (1.0 - lb) * jax.nn.sigmoid(z)
    log_f = jnp.log(f)
    k = (1.0 - lb) * jax.nn.sigmoid(-z)
    vf = v.astype(F32)

    def to_chunks(t):
        return t.reshape(bsz, nc, c, nh, d).transpose(1, 0, 3, 2, 4)

    causal = jnp.tril(jnp.ones((c, c), dtype=bool))[:, :, None]
    causal_f = causal.astype(F32)

    def step(state, xs):
        qc, kc, vc, lfc = xs
        bcum = jnp.cumsum(lfc, axis=2)
        o_inter = jnp.einsum('bhtd,bhde->bhte', qc * jnp.exp(bcum), state)
        diff = bcum[:, :, :, None, :] - bcum[:, :, None, :, :]
        decay = jnp.exp(jnp.where(causal, diff, 0.0)) * causal_f
        attn = jnp.einsum('bhtd,bhsd,bhtsd->bhts', qc, kc, decay)
        o = o_inter + jnp.einsum('bhts,bhse->bhte', attn, vc)
        b_last = bcum[:, :, -1:, :]
        k_dec = kc * jnp.exp(b_last - bcum)
        new_state = jnp.exp(b_last[:, :, 0, :])[..., None] * state + jnp.einsum('bhsd,bhse->bhde', k_dec, vc)
        return new_state, o

    state0 = jnp.zeros((bsz, nh, d, d), F32)
    _, o = lax.scan(step, state0, (to_chunks(qf), to_chunks(k), to_chunks(vf), to_chunks(log_f)))
    o = o.transpose(1, 0, 3, 2, 4).reshape(bsz, s, nh, d)
    o = o * lax.rsqrt(jnp.mean(o * o, axis=-1, keepdims=True) + EPS)
    return o.reshape(bsz, s, nh * d) * norm_gain.astype(F32) * jax.nn.silu(g.astype(F32))


def spatial_gating(z, sgu_w, sgu_b):
    bsz, s, _ = z.shape
    n = s // SGU_CHUNK
    u = z[..., :SGU_WIDTH].astype(F32)
    v = z[..., SGU_WIDTH:].astype(F32).reshape(bsz, n, SGU_CHUNK, SGU_GROUPS, SGU_GROUP_DIM)
    mu = jnp.mean(v, axis=-1, keepdims=True)
    var = jnp.mean(jnp.square(v - mu), axis=-1, keepdims=True)
    vn = (v - mu) * lax.rsqrt(var + EPS)
    w = sgu_w.astype(F32) * jnp.tril(jnp.ones((SGU_CHUNK, SGU_CHUNK), F32))
    sv = jnp.einsum('gts,bnsgc->bntgc', w, vn) + sgu_b.astype(F32).T[None, None, :, :, None]
    return u * sv.reshape(bsz, s, SGU_WIDTH)


def multiscale_pool(p, pool_w, pool_scale):
    s = p.shape[1]
    pf = p.astype(F32)
    pos = jnp.arange(1, s + 1)
    outs = []
    for gi, win in enumerate(POOL_WINDOWS):
        pg = pf[..., gi * POOL_GROUP_DIM:(gi + 1) * POOL_GROUP_DIM]
        cs = jnp.cumsum(pg, axis=1)
        prev = jnp.pad(cs, ((0, 0), (win, 0), (0, 0)))[:, :s]
        count = jnp.minimum(pos, win).astype(F32)[None, :, None]
        pooled = (cs - prev) / count - pg
        outs.append(jnp.einsum('bsc,cd->bsd', pooled, pool_w[gi].astype(F32)))
    return jnp.concatenate(outs, axis=-1) * pool_scale.astype(F32)


def setup_inputs(seed: int = 0) -> dict:
    key = jax.random.key(seed)
    ks = jax.random.split(key, 24)
    nrm = lambda k, shape, scale: jax.random.normal(k, shape, F32) * scale
    a_init = jax.random.uniform(ks[9], (N_EVEN, LRU_WIDTH), F32, minval=0.9, maxval=0.999)
    s_init = a_init ** (1.0 / LRU_C)
    lam = jnp.log(s_init) - jnp.log1p(-s_init)
    return {
        "x": nrm(ks[0], (BATCH, SEQ, D_MODEL), 1.0),
        "norm_mix": 1.0 + nrm(ks[1], (DEPTH, D_MODEL), 0.02),
        "norm_ffn": 1.0 + nrm(ks[2], (DEPTH, D_MODEL), 0.02),
        "w_in_even": nrm(ks[3], (N_EVEN, D_MODEL, EVEN_IN), D_MODEL ** -0.5),
        "conv_w": nrm(ks[4], (N_EVEN, CONV_WIDTH, LRU_WIDTH), CONV_WIDTH ** -0.5),
        "conv_b": nrm(ks[5], (N_EVEN, LRU_WIDTH), 0.01),
        "lru_wa": nrm(ks[6], (N_EVEN, LRU_HEADS, LRU_HEAD_DIM, LRU_HEAD_DIM), LRU_HEAD_DIM ** -0.5),
        "lru_ba": nrm(ks[7], (N_EVEN, LRU_WIDTH), 0.01),
        "lru_wx": nrm(ks[8], (N_EVEN, LRU_HEADS, LRU_HEAD_DIM, LRU_HEAD_DIM), LRU_HEAD_DIM ** -0.5),
        "lru_bx": nrm(ks[10], (N_EVEN, LRU_WIDTH), 0.01),
        "lru_lambda": lam,
        "hgrn_lb_logits": nrm(ks[11], (N_EVEN, HGRN_WIDTH), 1.0),
        "hgrn_norm": 1.0 + nrm(ks[12], (N_EVEN, HGRN_WIDTH), 0.02),
        "w_out_even": nrm(ks[13], (N_EVEN, MIX_WIDTH, D_MODEL), MIX_WIDTH ** -0.5),
        "w_in_odd": nrm(ks[14], (N_ODD, D_MODEL, ODD_IN), D_MODEL ** -0.5),
        "sgu_w": nrm(ks[15], (N_ODD, SGU_GROUPS, SGU_CHUNK, SGU_CHUNK), SGU_CHUNK ** -0.5),
        "sgu_b": 1.0 + nrm(ks[16], (N_ODD, SGU_GROUPS, SGU_CHUNK), 0.01),
        "pool_w": nrm(ks[17], (N_ODD, len(POOL_WINDOWS), POOL_GROUP_DIM, POOL_GROUP_DIM), POOL_GROUP_DIM ** -0.5),
        "pool_scale": 1.0 + nrm(ks[18], (N_ODD, POOL_WIDTH), 0.02),
        "w_out_odd": nrm(ks[19], (N_ODD, MIX_WIDTH, D_MODEL), MIX_WIDTH ** -0.5),
        "w_ffn_in": nrm(ks[20], (DEPTH, D_MODEL, D_FF), D_MODEL ** -0.5),
        "w_ffn_out": nrm(ks[21], (DEPTH, D_FF, D_MODEL), D_FF ** -0.5),
        "norm_final": 1.0 + nrm(ks[22], (D_MODEL,), 0.02),
    }


def reference(x, norm_mix, norm_ffn, w_in_even, conv_w, conv_b, lru_wa, lru_ba, lru_wx, lru_bx,
              lru_lambda, hgrn_lb_logits, hgrn_norm, w_out_even, w_in_odd, sgu_w, sgu_b, pool_w,
              pool_scale, w_out_odd, w_ffn_in, w_ffn_out, norm_final):
    dt = x.dtype
    p_lb = jax.nn.softmax(hgrn_lb_logits.astype(F32), axis=0)
    lower_bounds = jnp.cumsum(p_lb, axis=0) - p_lb[0]
    even_cuts = [int(c) for c in np.cumsum(EVEN_SPLITS)[:-1]]
    h = x
    for layer in range(DEPTH):
        j = layer // 2
        xn = rms_norm(h, norm_mix[layer])
        if layer % 2 == 0:
            proj = xn @ w_in_even[j]
            xa, ga, q, f_pre, vi, gb = jnp.split(proj, even_cuts, axis=-1)
            ua = causal_depthwise_conv(xa, conv_w[j], conv_b[j])
            ya = rg_lru(ua, lru_wa[j], lru_ba[j], lru_wx[j], lru_bx[j], lru_lambda[j]) * jax.nn.gelu(ga.astype(F32))
            yb = hgrn2(q, f_pre, vi, gb, lower_bounds[j], hgrn_norm[j])
            mix = jnp.concatenate([ya, yb], axis=-1).astype(dt) @ w_out_even[j]
        else:
            proj = xn @ w_in_odd[j]
            zc = jax.nn.gelu(proj[..., :2 * SGU_WIDTH])
            pd = proj[..., 2 * SGU_WIDTH:]
            yc = spatial_gating(zc, sgu_w[j], sgu_b[j])
            yd = multiscale_pool(pd, pool_w[j], pool_scale[j])
            mix = jnp.concatenate([yc, yd], axis=-1).astype(dt) @ w_out_odd[j]
        h = h + mix
        hn = rms_norm(h, norm_ffn[layer])
        hidden = jnp.square(jax.nn.relu(hn @ w_ffn_in[layer]))
        h = h + hidden @ w_ffn_out[layer]
    return rms_norm(h, norm_final)
```

```cpp
#include <hip/hip_runtime.h>
#include <hip/hip_cooperative_groups.h>
#include <cstdio>
namespace cg = cooperative_groups;

#define LAS __attribute__((address_space(3)))
typedef unsigned short bf16_t;
typedef short bf16x8 __attribute__((ext_vector_type(8)));
typedef float f32x4 __attribute__((ext_vector_type(4)));
typedef unsigned u32x4 __attribute__((ext_vector_type(4)));
typedef unsigned u32x2 __attribute__((ext_vector_type(2)));

constexpr int MTOK = 65536, DM = 1024, SEQ = 4096;
constexpr float EPS = 1e-6f;
constexpr int LDS_BYTES = 155648;
#define DBG_REP_EVEN 1
#define DBG_REP_ODD 1
#define DBG_REP_FFNIN 1
#define DBG_REP_P0 1
#define DBG_EPI2 0
#define DBG_EXTRA_SYNCS 0
#define USE_LOCAL_BAR 1
#define DBG_SKIP_EVEN 0
#define DBG_SKIP_LRU 0
#define DBG_SKIP_HGRN 0
#define DBG_SKIP_ODD 0
constexpr int NTHR = 512;

constexpr size_t MiB = 1u << 20;
constexpr size_t WS_WT = 0;
constexpr size_t WS_SMALL = 90 * MiB;
constexpr size_t WS_BAR = 91 * MiB;
constexpr size_t WS_ROWSS = 92 * MiB;
constexpr size_t WS_LRUC = 96 * MiB;
constexpr size_t WS_HGG = 98 * MiB;
constexpr size_t WS_HB = 100 * MiB;
constexpr size_t WS_Y = 228 * MiB;
constexpr size_t WS_BIG = 356 * MiB;
constexpr size_t WS_ST = 868 * MiB;
constexpr size_t OFF_INE = 0, OFF_OUTE = 6291456, OFF_INO = 8388608, OFF_OUTO = 11534336, OFF_FIN = 13631488, OFF_FOUT = 30408704;
constexpr size_t SM_WAT = 0, SM_WXT = 256 * 1024, SM_SGUW = 512 * 1024, SM_PWT = 768 * 1024;

struct Params { const float* in[23]; float* out; unsigned char* ws; };

typedef float f32x2_ __attribute__((ext_vector_type(2)));
typedef __bf16 bf16x2_ __attribute__((ext_vector_type(2)));
__device__ __forceinline__ unsigned cvt_pk_bf16(float lo, float hi) { f32x2_ v = {lo, hi}; bf16x2_ r = __builtin_convertvector(v, bf16x2_); return __builtin_bit_cast(unsigned, r); }
__device__ __forceinline__ float bf_lo(unsigned w) { return __uint_as_float(w << 16); }
__device__ __forceinline__ float bf_hi(unsigned w) { return __uint_as_float(w & 0xffff0000u); }
__device__ __forceinline__ float bf2f(bf16_t b) { return __uint_as_float(((unsigned)b) << 16); }
__device__ __forceinline__ bf16_t f2bf(float f) { return (bf16_t)(cvt_pk_bf16(f, 0.f) & 0xffffu); }
__device__ __forceinline__ float rcp_(float x) { return __builtin_amdgcn_rcpf(x); }
__device__ __forceinline__ float sigmoid_(float x) { return rcp_(1.0f + __expf(-x)); }
__device__ __forceinline__ float gelu_tanh(float x) { const float u = 0.7978845608f * (x + 0.044715f * x * x * x); return x * rcp_(1.0f + __expf(-2.0f * u)); }
__device__ __forceinline__ float silu_(float x) { return x * rcp_(1.0f + __expf(-x)); }
__device__ __forceinline__ size_t tiled(size_t row, int col, int K) { return ((row >> 8) * (size_t)K + (size_t)(col >> 6) * 64) * 256 + ((row & 255) << 6) + (size_t)(col & 63); }
__device__ __forceinline__ size_t proj_off(size_t row, int ldc) { return (row >> 13) * (size_t)33554432 + (row & 8191) * (size_t)ldc; }
#define LDS_WAIT() asm volatile("s_waitcnt lgkmcnt(0)" ::: "memory")

namespace pg8 {
constexpr int BM = 256, BK = 64, HALF = 128, HTB = HALF * BK * 2, STAGE_BYTES = 8 * HTB, NXCD = 8, WGM = 4;
__host__ __device__ __forceinline__ int lds_byte(int r, int c) { const int st = (r >> 4) * 2 + (c >> 5), rr = r & 15, cc = c & 31, ob = rr * 64 + cc * 2; return st * 1024 + (ob ^ (((ob >> 9) & 1) << 5)); }
__host__ __device__ __forceinline__ void stage_rc(int b, int& R, int& C) { const int st = b / 1024, sb = b % 1024, swz = sb ^ (((sb >> 9) & 1) << 5); R = (st >> 1) * 16 + swz / 64; C = (st & 1) * 32 + (swz % 64) / 2; }
__host__ __device__ __forceinline__ int perm32(int rho) { const int n = rho >> 4, i = rho & 15; return 8 * (i >> 2) + 4 * n + (i & 3); }
struct Unit { int pm, pn; };
struct Gemm { const bf16_t* A; const bf16_t* Bt; int M, N, K; };
struct StaticOrder {
    int nM, nN, nwg, G, c, rev;
    __device__ void init(int M, int N, int G_, int c_, int rev_ = 0) { nM = M / BM; nN = N / BM; nwg = nM * nN; G = G_; c = c_; rev = rev_; }
    __device__ bool next(int i, Unit& u) const {
        const int nround = (nwg + G - 1) / G; if (i >= nround) return false;
        const long L = (long)(rev ? (nround - 1 - i) : i) * G + c; if (L >= nwg) return false;
        int wgid = (int)L; { const int q = nwg / NXCD, r = nwg % NXCD, xcd = wgid % NXCD, off = wgid / NXCD; wgid = (xcd < r ? xcd * (q + 1) : r * (q + 1) + (xcd - r) * q) + off; }
        const int nig = WGM * nN, gid = wgid / nig, fm = gid * WGM, gsz = (nM - fm) < WGM ? (nM - fm) : WGM;
        u.pm = fm + ((wgid % nig) % gsz); u.pn = (wgid % nig) / gsz; return true;
    }
};

template <int ACT> struct EpiIn {
    static constexpr bool PERM = true, PRE = true;
    bf16_t* O; int ldc; const float* rowss;
    __device__ __forceinline__ void operator()(const f32x4 (&acc)[2][2][4][2], const Unit& u, int wr, int wc, int fr, int fq, const LAS float* RS) const {
        const int row0 = u.pm * BM + wr * 64 + fr, col0 = u.pn * BM + wc * 32 + 8 * fq;
        const bool do_gelu = (ACT == 1) && (u.pn < 4);
        float rs[8];
#pragma unroll
        for (int i = 0; i < 8; ++i) rs[i] = RS[(i >> 2) * HALF + wr * 64 + (i & 3) * 16 + fr];
#pragma unroll
        for (int ai = 0; ai < 2; ++ai)
#pragma unroll
            for (int m = 0; m < 4; ++m) {
                const int row = row0 + ai * HALF + m * 16;
                const float rstd = rs[ai * 4 + m];
                bf16_t* rowp = (ACT == 2) ? O + tiled((size_t)row, col0, ldc) : O + proj_off((size_t)row, ldc) + col0;
#pragma unroll
                for (int bj = 0; bj < 2; ++bj) {
                    f32x4 v0 = acc[ai][bj][m][0] * rstd, v1 = acc[ai][bj][m][1] * rstd;
                    if (ACT == 1) { if (do_gelu) {
#pragma unroll
                        for (int q = 0; q < 4; ++q) { v0[q] = gelu_tanh(v0[q]); v1[q] = gelu_tanh(v1[q]); } } }
                    if (ACT == 2) {
#pragma unroll
                        for (int q = 0; q < 4; ++q) { const float a = fmaxf(v0[q], 0.f), b = fmaxf(v1[q], 0.f); v0[q] = a * a; v1[q] = b * b; } }
                    u32x4 w; w.x = cvt_pk_bf16(v0[0], v0[1]); w.y = cvt_pk_bf16(v0[2], v0[3]); w.z = cvt_pk_bf16(v1[0], v1[1]); w.w = cvt_pk_bf16(v1[2], v1[3]);
                    *(u32x4*)(rowp + bj * ((ACT == 2) ? HALF * 256 : HALF)) = w;
                }
            }
    }
};
struct EpiRes {
    static constexpr bool PERM = true, PRE = false;
    const float* res; float* H; bf16_t* HB; float* rowss;
    __device__ __forceinline__ void operator()(const f32x4 (&acc)[2][2][4][2], const Unit& u, int wr, int wc, int fr, int fq, const LAS float*) const {
        const int row0 = u.pm * BM + wr * 64 + fr, col0 = u.pn * BM + wc * 32 + 8 * fq;
#pragma unroll
        for (int ai = 0; ai < 2; ++ai) {
            f32x4 r[4][4];
#pragma unroll
            for (int m = 0; m < 4; ++m) {
                const size_t off = (size_t)(row0 + ai * HALF + m * 16) * DM + col0;
#pragma unroll
                for (int q = 0; q < 4; ++q) r[m][q] = *(const f32x4*)(res + off + (q >> 1) * HALF + (q & 1) * 4);
            }
#pragma unroll
            for (int m = 0; m < 4; ++m) {
                const int row = row0 + ai * HALF + m * 16;
                const size_t off = (size_t)row * DM + col0;
                float ss = 0.f;
#pragma unroll
                for (int bj = 0; bj < 2; ++bj) {
                    const f32x4 v0 = r[m][bj * 2] + acc[ai][bj][m][0], v1 = r[m][bj * 2 + 1] + acc[ai][bj][m][1];
                    *(f32x4*)(H + off + bj * HALF) = v0; *(f32x4*)(H + off + bj * HALF + 4) = v1;
                    ss += ((v0[0] * v0[0] + v0[1] * v0[1]) + (v0[2] * v0[2] + v0[3] * v0[3])) + ((v1[0] * v1[0] + v1[1] * v1[1]) + (v1[2] * v1[2] + v1[3] * v1[3]));
                    u32x4 w; w.x = cvt_pk_bf16(v0[0], v0[1]); w.y = cvt_pk_bf16(v0[2], v0[3]); w.z = cvt_pk_bf16(v1[0], v1[1]); w.w = cvt_pk_bf16(v1[2], v1[3]);
                    *(u32x4*)(HB + tiled((size_t)row, col0 + bj * HALF, DM)) = w;
                }
                ss += __shfl_xor(ss, 16); ss += __shfl_xor(ss, 32);
                if (fq == 0) rowss[(size_t)row * 16 + u.pn * 4 + wc] = ss;
            }
        }
    }
};

template <class Epi, class Sched>
__device__ __forceinline__ void gemm_phase(LAS unsigned char* lds, const Gemm g, const Sched& S, const Epi& E) {
    int tid = threadIdx.x; asm volatile("" : "+v"(tid));
    const int wid = __builtin_amdgcn_readfirstlane(tid >> 6), lane = tid & 63, wr = wid >> 2, wc = wid & 3, fr = lane & 15, fq = lane >> 4;
    const int K = g.K, nt = K / BK;
    unsigned voffA[2], voffB[2];
#pragma unroll
    for (int i = 0; i < 2; ++i) { int R, C; stage_rc(tid * 16 + i * 8192, R, C); const int Rb = Epi::PERM ? ((R & ~31) + perm32(R & 31)) : R;
        voffA[i] = (unsigned)(R * BK + C) * 2u; voffB[i] = (unsigned)(Rb * K + C) * 2u; }
    const size_t kstep = (size_t)(BK * 2);
    const size_t hstep = (size_t)HALF * K * 2;
    const size_t tstep = 2 * hstep;
    const size_t kstepA = (size_t)BM * BK * 2, hstepA = (size_t)HALF * BK * 2;
    const unsigned ldsw = (unsigned)wid * 1024u;
    const int aoff = lds_byte(wr * 64 + fr, fq * 8), boff = lds_byte(wc * 32 + fr, fq * 8);
    LAS float* RS = (LAS float*)(lds + STAGE_BYTES);
#define PG8_SA(b, h) (((b) * 2 + (h)) * HTB)
#define PG8_SB(b, h) ((4 + (b) * 2 + (h)) * HTB)
#define PG8_STAGE(bufoff, gbase, voff) do { _Pragma("unroll") for (int _i = 0; _i < 2; ++_i) \
        __builtin_amdgcn_global_load_lds((const unsigned*)((const char*)(gbase) + (voff)[_i]), (LAS unsigned*)(lds + (bufoff) + ldsw + _i * 8192), 16, 0, 0); } while (0)
#define PG8_LDA(dst, b, h) do { _Pragma("unroll") for (int m = 0; m < 4; ++m) _Pragma("unroll") for (int k = 0; k < 2; ++k) dst[m][k] = *(const LAS bf16x8*)(lds + PG8_SA(b, h) + aoff + m * 2048 + k * 1024); } while (0)
#define PG8_LDB(dst, b, h) do { _Pragma("unroll") for (int n = 0; n < 2; ++n) _Pragma("unroll") for (int k = 0; k < 2; ++k) dst[n][k] = *(const LAS bf16x8*)(lds + PG8_SB(b, h) + boff + n * 2048 + k * 1024); } while (0)
#define PG8_MMA(ai, bj, At, Bt) do { __builtin_amdgcn_s_setprio(1); _Pragma("unroll") for (int m = 0; m < 4; ++m) _Pragma("unroll") for (int n = 0; n < 2; ++n) _Pragma("unroll") for (int k = 0; k < 2; ++k) \
        acc[ai][bj][m][n] = __builtin_amdgcn_mfma_f32_16x16x32_bf16(Bt[n][k], At[m][k], acc[ai][bj][m][n], 0, 0, 0); __builtin_amdgcn_s_setprio(0); } while (0)
#define PG8_WAIT_V(n) asm volatile("s_waitcnt vmcnt(" #n ")" ::: "memory")
#define PG8_WAIT_L(n) asm volatile("s_waitcnt lgkmcnt(" #n ")" ::: "memory")
#define PG8_BAR __builtin_amdgcn_s_barrier()
#define PG8_SCHED __builtin_amdgcn_sched_barrier(0)
    Unit cur, nxt; int ui = 0;
    if (!S.next(0, cur)) return;
    f32x4 acc[2][2][4][2];
#pragma unroll
    for (int a = 0; a < 2; ++a)
#pragma unroll
        for (int b = 0; b < 2; ++b)
#pragma unroll
            for (int m = 0; m < 4; ++m)
#pragma unroll
                for (int n = 0; n < 2; ++n) acc[a][b][m][n] = (f32x4){0.f, 0.f, 0.f, 0.f};
    bf16x8 At[4][2], B0[2][2], B1[2][2];
    const char* cA = (const char*)g.A + (size_t)cur.pm * tstep; const char* cB = (const char*)g.Bt + (size_t)cur.pn * tstep;
    PG8_STAGE(PG8_SB(0, 0), cB, voffB); PG8_STAGE(PG8_SA(0, 0), cA, voffA); PG8_STAGE(PG8_SB(0, 1), cB + hstep, voffB); PG8_STAGE(PG8_SA(0, 1), cA + hstepA, voffA);
    if (wr == 1) PG8_BAR;
    PG8_WAIT_V(4); PG8_BAR;
    PG8_STAGE(PG8_SB(1, 0), cB + kstep, voffB); PG8_STAGE(PG8_SA(1, 0), cA + kstepA, voffA); PG8_STAGE(PG8_SB(1, 1), cB + hstep + kstep, voffB);
    PG8_WAIT_V(6); PG8_BAR;
    for (;;) {
        const bool has_next = S.next(ui + 1, nxt);
        const char* nA = has_next ? (const char*)g.A + (size_t)nxt.pm * tstep : cA; const char* nB = has_next ? (const char*)g.Bt + (size_t)nxt.pn * tstep : cB;
        for (int t = 0; t < nt; t += 2) {
            const bool last = (t == nt - 2);
            const char* a1 = cA + (size_t)(t + 1) * kstepA;
            const char* a2 = last ? nA : cA + (size_t)(t + 2) * kstepA; const char* b2 = last ? nB : cB + (size_t)(t + 2) * kstep;
            const char* a3 = a2 + kstepA; const char* b3 = b2 + kstep;
            f32x4 rsA;
            if constexpr (Epi::PRE) { if (t <= 2) { const float* rp = E.rowss + (size_t)(cur.pm * BM + (t >> 1) * HALF + (tid >> 2)) * 16 + (tid & 3) * 4;
                asm volatile("global_load_dwordx4 %0, %1, off" : "=&v"(rsA) : "v"(rp) : "memory"); } }
            PG8_LDB(B0, 0, 0); PG8_SCHED; PG8_LDA(At, 0, 0); PG8_STAGE(PG8_SA(1, 1), a1 + hstepA, voffA);
            PG8_WAIT_L(8); PG8_BAR; PG8_WAIT_L(0); PG8_MMA(0, 0, At, B0); PG8_BAR; PG8_SCHED;
            PG8_LDB(B1, 0, 1); PG8_STAGE(PG8_SB(0, 0), b2, voffB);
            PG8_BAR; PG8_WAIT_L(0); PG8_MMA(0, 1, At, B1); PG8_BAR;
            PG8_LDA(At, 0, 1); PG8_STAGE(PG8_SA(0, 0), a2, voffA);
            PG8_BAR; PG8_WAIT_L(0); PG8_MMA(1, 0, At, B0); PG8_BAR; PG8_SCHED;
            PG8_STAGE(PG8_SB(0, 1), b2 + hstep, voffB);
            PG8_WAIT_V(6); PG8_BAR; PG8_MMA(1, 1, At, B1); PG8_BAR;
            if constexpr (Epi::PRE) { if (t <= 2) { asm volatile("s_waitcnt vmcnt(8)" : "+v"(rsA) :: "memory"); float sq = (rsA[0] + rsA[1]) + (rsA[2] + rsA[3]); sq += __shfl_xor(sq, 1); sq += __shfl_xor(sq, 2);
                if (!(tid & 3)) RS[(t >> 1) * HALF + (tid >> 2)] = rsqrtf(sq * (1.0f / 1024.0f) + EPS); } }
            PG8_LDB(B0, 1, 0); PG8_SCHED; PG8_LDA(At, 1, 0); PG8_STAGE(PG8_SA(0, 1), a2 + hstepA, voffA);
            PG8_WAIT_L(8); PG8_BAR; PG8_WAIT_L(0); PG8_MMA(0, 0, At, B0); PG8_BAR; PG8_SCHED;
            PG8_LDB(B1, 1, 1); PG8_STAGE(PG8_SB(1, 0), b3, voffB);
            PG8_BAR; PG8_WAIT_L(0); PG8_MMA(0, 1, At, B1); PG8_BAR;
            PG8_LDA(At, 1, 1); PG8_STAGE(PG8_SA(1, 0), a3, voffA);
            PG8_BAR; PG8_WAIT_L(0); PG8_MMA(1, 0, At, B0); PG8_BAR; PG8_SCHED;
            PG8_STAGE(PG8_SB(1, 1), b3 + hstep, voffB);
            PG8_WAIT_V(6); PG8_BAR; PG8_MMA(1, 1, At, B1); PG8_BAR;
        }
        E(acc, cur, wr, wc, fr, fq, RS);
        if (!has_next) break;
#pragma unroll
        for (int a = 0; a < 2; ++a)
#pragma unroll
            for (int b = 0; b < 2; ++b)
#pragma unroll
                for (int m = 0; m < 4; ++m)
#pragma unroll
                    for (int n = 0; n < 2; ++n) acc[a][b][m][n] = (f32x4){0.f, 0.f, 0.f, 0.f};
        cur = nxt; cA = nA; cB = nB; ++ui;
    }
    PG8_WAIT_V(0);
    if (wr == 0) PG8_BAR;
    PG8_BAR;
#undef PG8_SA
#undef PG8_SB
#undef PG8_STAGE
#undef PG8_LDA
#undef PG8_LDB
#undef PG8_MMA
#undef PG8_WAIT_V
#undef PG8_WAIT_L
#undef PG8_BAR
#undef PG8_SCHED
}
}

__device__ __forceinline__ void transpose_item(const float* W, int K, int N, bf16_t* WT, const float* kscale, LAS float* scr, int item, int lane) {
    const int nblk = N / 32, kb = item / nblk, nb = item % nblk, k0 = 64 * kb, n0 = 32 * nb;
    float wv[32];
#pragma unroll
    for (int i = 0; i < 32; ++i) wv[i] = W[(size_t)(k0 + 2 * i + (lane >> 5)) * N + n0 + (lane & 31)];
#pragma unroll
    for (int i = 0; i < 32; ++i) { const int kk = 2 * i + (lane >> 5); const float s = kscale ? kscale[k0 + kk] : 1.0f; scr[kk * 33 + (lane & 31)] = wv[i] * s; }
    LDS_WAIT();
    const int c = lane & 7;
#pragma unroll
    for (int j = 0; j < 4; ++j) { const int n = (lane >> 3) + 8 * j; const LAS float* s = scr + (8 * c) * 33 + n;
        u32x4 o; o.x = cvt_pk_bf16(s[0 * 33], s[1 * 33]); o.y = cvt_pk_bf16(s[2 * 33], s[3 * 33]); o.z = cvt_pk_bf16(s[4 * 33], s[5 * 33]); o.w = cvt_pk_bf16(s[6 * 33], s[7 * 33]);
        *(u32x4*)(WT + (size_t)(n0 + n) * K + k0 + 8 * c) = o; }
    LDS_WAIT();
}

__device__ __forceinline__ void phase0(LAS unsigned char* lds, const Params& p) {
    int tid = threadIdx.x; asm volatile("" : "+v"(tid));
    const int lane = tid & 63, wave = tid >> 6;
    const int gw = blockIdx.x * 8 + wave, NGW = gridDim.x * 8;
    LAS float* scr = (LAS float*)(lds + wave * 8704);
    bf16_t* WTb = (bf16_t*)(p.ws + WS_WT);
#pragma unroll 1
    for (int mat = 0; mat < 16; ++mat) {
        const float* W; int K, N; bf16_t* WT; const float* ks = nullptr;
        if (mat < 2)       { W = p.in[3] + (size_t)mat * 1024 * 3072; K = 1024; N = 3072; WT = WTb + OFF_INE + (size_t)mat * 3145728; ks = p.in[1] + (2 * mat) * 1024; }
        else if (mat < 4)  { const int j = mat - 2; W = p.in[13] + (size_t)j * 1048576; K = 1024; N = 1024; WT = WTb + OFF_OUTE + (size_t)j * 1048576; }
        else if (mat < 6)  { const int j = mat - 4; W = p.in[14] + (size_t)j * 1024 * 1536; K = 1024; N = 1536; WT = WTb + OFF_INO + (size_t)j * 1572864; ks = p.in[1] + (2 * j + 1) * 1024; }
        else if (mat < 8)  { const int j = mat - 6; W = p.in[19] + (size_t)j * 1048576; K = 1024; N = 1024; WT = WTb + OFF_OUTO + (size_t)j * 1048576; }
        else if (mat < 12) { const int l = mat - 8; W = p.in[20] + (size_t)l * 4194304; K = 1024; N = 4096; WT = WTb + OFF_FIN + (size_t)l * 4194304; ks = p.in[2] + l * 1024; }
        else               { const int l = mat - 12; W = p.in[21] + (size_t)l * 4194304; K = 4096; N = 1024; WT = WTb + OFF_FOUT + (size_t)l * 4194304; }
        const int nitems = (K / 64) * (N / 32);
        for (int it = gw; it < nitems; it += NGW) transpose_item(W, K, N, WT, ks, scr, it, lane);
    }
    {
        const size_t gtid = (size_t)blockIdx.x * NTHR + tid, gsz = (size_t)gridDim.x * NTHR;
        bf16_t* WaT = (bf16_t*)(p.ws + WS_SMALL + SM_WAT); bf16_t* WxT = (bf16_t*)(p.ws + WS_SMALL + SM_WXT);
        bf16_t* SW = (bf16_t*)(p.ws + WS_SMALL + SM_SGUW); bf16_t* PWT = (bf16_t*)(p.ws + WS_SMALL + SM_PWT);
        for (size_t i = gtid; i < 131072; i += gsz) {
            const int ii = i & 63, jo = (i >> 6) & 63; const size_t lh = i >> 12;
            if (i < 65536) { WaT[i] = f2bf(p.in[6][lh * 4096 + ii * 64 + jo]);
            WxT[i] = f2bf(p.in[8][lh * 4096 + ii * 64 + jo]); }
            const int s = i & 127, t = (i >> 7) & 127;
            SW[i] = f2bf(s <= t ? p.in[15][i] : 0.f);
            const int c = i & 127, d = (i >> 7) & 127; const size_t lg = i >> 14; const size_t l = lg >> 2, gi = lg & 3;
            PWT[i] = f2bf(p.in[17][lg * 16384 + c * 128 + d] * p.in[18][l * 512 + gi * 128 + d]);
        }
    }
    {
        const float* x = p.in[0]; bf16_t* HB = (bf16_t*)(p.ws + WS_HB); float* rowss = (float*)(p.ws + WS_ROWSS);
        for (int row = gw; row < MTOK; row += 2 * NGW) {
            const int row2 = row + NGW;
            const f32x4* xr = (const f32x4*)(x + (size_t)row * DM) + lane;
            const f32x4* xr2 = (const f32x4*)(x + (size_t)row2 * DM) + lane;
            f32x4 v[4], v2[4]; float s = 0.f, s2 = 0.f;
#pragma unroll
            for (int j = 0; j < 4; ++j) { v[j] = xr[64 * j]; v2[j] = xr2[64 * j]; }
#pragma unroll
            for (int j = 0; j < 4; ++j) { s += (v[j][0] * v[j][0] + v[j][1] * v[j][1]) + (v[j][2] * v[j][2] + v[j][3] * v[j][3]); s2 += (v2[j][0] * v2[j][0] + v2[j][1] * v2[j][1]) + (v2[j][2] * v2[j][2] + v2[j][3] * v2[j][3]); }
#pragma unroll
            for (int o = 1; o < 64; o <<= 1) { s += __shfl_xor(s, o); s2 += __shfl_xor(s2, o); }
            u32x2* o8 = (u32x2*)(HB + tiled((size_t)row, 4 * lane, DM)); u32x2* o82 = (u32x2*)(HB + tiled((size_t)row2, 4 * lane, DM));
#pragma unroll
            for (int j = 0; j < 4; ++j) { u32x2 w; w.x = cvt_pk_bf16(v[j][0], v[j][1]); w.y = cvt_pk_bf16(v[j][2], v[j][3]); o8[16384 * j] = w;
                u32x2 w2; w2.x = cvt_pk_bf16(v2[j][0], v2[j][1]); w2.y = cvt_pk_bf16(v2[j][2], v2[j][3]); o82[16384 * j] = w2; }
            if (lane < 16) { rowss[(size_t)row * 16 + lane] = (lane == 0) ? s : 0.f; rowss[(size_t)row2 * 16 + lane] = (lane == 0) ? s2 : 0.f; }
        }
    }
}

template <int PASS>
__device__ __forceinline__ void lru_pass(LAS unsigned char* lds, const Params& p, int j, int item) {
    int tid = threadIdx.x; asm volatile("" : "+v"(tid));
    const int lane = tid & 63, w = __builtin_amdgcn_readfirstlane(tid >> 6), fr = lane & 15, fq = lane >> 4;
    const int b = item >> 4, seg = item & 15;
    const bf16_t* PROJ = (const bf16_t*)(p.ws + WS_BIG);
    bf16_t* Y = (bf16_t*)(p.ws + WS_Y);
    float* Pbuf = (float*)(p.ws + WS_LRUC); float* Hbuf = Pbuf + 256 * 512;
    LAS bf16_t* U = (LAS bf16_t*)lds;
    LAS bf16_t* HS = (LAS bf16_t*)(lds + 66560);
    const bf16_t* WaT = (const bf16_t*)(p.ws + WS_SMALL + SM_WAT) + (size_t)(j * 8 + w) * 4096;
    const bf16_t* WxT = (const bf16_t*)(p.ws + WS_SMALL + SM_WXT) + (size_t)(j * 8 + w) * 4096;
    bf16x8 Ba[4][2], Bx[4][2];
#pragma unroll
    for (int n = 0; n < 4; ++n)
#pragma unroll
        for (int kk = 0; kk < 2; ++kk) { Ba[n][kk] = *(const bf16x8*)(WaT + (n * 16 + fr) * 64 + kk * 32 + fq * 8); Bx[n][kk] = *(const bf16x8*)(WxT + (n * 16 + fr) * 64 + kk * 32 + fq * 8); }
    float ba[4], bx[4], sp[4], h[4], P[4];
#pragma unroll
    for (int n = 0; n < 4; ++n) {
        const int c = w * 64 + n * 16 + fr;
        ba[n] = p.in[7][j * 512 + c]; bx[n] = p.in[9][j * 512 + c];
        const float lam = p.in[10][j * 512 + c];
        sp[n] = 8.0f * 1.44269504f * log1pf(__expf(-lam));
        float hh = 0.f;
        if (PASS == 2) {
            float pq[15], hq[15];
#pragma unroll
            for (int s = 0; s < 15; ++s) { pq[s] = Pbuf[(size_t)(b * 16 + s) * 512 + c]; hq[s] = Hbuf[(size_t)(b * 16 + s) * 512 + c]; }
#pragma unroll
            for (int s = 0; s < 15; ++s) hh = (s < seg) ? pq[s] * hh + hq[s] : hh;
        }
        h[n] = hh; P[n] = 1.0f;
    }
    const int c8 = (tid & 63) * 8, tg = tid >> 6;
    LAS float* CW = (LAS float*)(lds + 133120);
    {
        const float* src = (tid < 128 * 4) ? p.in[4] + (size_t)j * 2048 : p.in[4];
        *(LAS f32x4*)(CW + tid * 4) = *(const f32x4*)(src + tid * 4);
        if (tid < 128) *(LAS f32x4*)(CW + 2048 + tid * 4) = *(const f32x4*)(p.in[5] + j * 512 + tid * 4);
    }
    __syncthreads();
#pragma unroll 1
    for (int sub = 0; sub < 4; ++sub) {
        const int t0 = seg * 256 + sub * 64;
        const size_t rowbase = (size_t)b * SEQ + t0;

        {
            float cw[4][8], cb[8];
#pragma unroll
            for (int k = 0; k < 4; ++k) { const f32x4 a = *(const LAS f32x4*)(CW + k * 512 + c8), bq = *(const LAS f32x4*)(CW + k * 512 + c8 + 4);
#pragma unroll
                for (int q = 0; q < 4; ++q) { cw[k][q] = a[q]; cw[k][4 + q] = bq[q]; } }
            { const f32x4 a = *(const LAS f32x4*)(CW + 2048 + c8), bq = *(const LAS f32x4*)(CW + 2048 + c8 + 4);
#pragma unroll
                for (int q = 0; q < 4; ++q) { cb[q] = a[q]; cb[4 + q] = bq[q]; } }
            u32x4 xw[4];
#pragma unroll
            for (int k = 0; k < 3; ++k) { const int tl = tg * 8 - 3 + k; xw[k] = (t0 + tl >= 0) ? *(const u32x4*)(PROJ + proj_off(rowbase + tl, 3072) + c8) : (u32x4){0u, 0u, 0u, 0u}; }
#pragma unroll
            for (int i = 0; i < 8; ++i) {
                const int tl = tg * 8 + i;
                xw[3] = *(const u32x4*)(PROJ + proj_off(rowbase + tl, 3072) + c8);
                float uo[8];
#pragma unroll
                for (int q = 0; q < 4; ++q) {
                    float lo = cb[2 * q], hi = cb[2 * q + 1];
#pragma unroll
                    for (int k = 0; k < 4; ++k) { lo += cw[k][2 * q] * bf_lo(xw[k][q]); hi += cw[k][2 * q + 1] * bf_hi(xw[k][q]); }
                    uo[2 * q] = lo; uo[2 * q + 1] = hi;
                }
                u32x4 o; o.x = cvt_pk_bf16(uo[0], uo[1]); o.y = cvt_pk_bf16(uo[2], uo[3]); o.z = cvt_pk_bf16(uo[4], uo[5]); o.w = cvt_pk_bf16(uo[6], uo[7]);
                *(LAS u32x4*)(U + tl * 520 + c8) = o;
                xw[0] = xw[1]; xw[1] = xw[2]; xw[2] = xw[3];
            }
        }
        __syncthreads();
#pragma unroll 1
        for (int tt = 0; tt < 4; ++tt) {
            bf16x8 a0 = *(const LAS bf16x8*)(U + (tt * 16 + fr) * 520 + w * 64 + fq * 8);
            bf16x8 a1 = *(const LAS bf16x8*)(U + (tt * 16 + fr) * 520 + w * 64 + 32 + fq * 8);
#pragma unroll
            for (int n = 0; n < 4; ++n) {
                f32x4 ar = (f32x4){ba[n], ba[n], ba[n], ba[n]}, ai = (f32x4){bx[n], bx[n], bx[n], bx[n]};
                ar = __builtin_amdgcn_mfma_f32_16x16x32_bf16(a0, Ba[n][0], ar, 0, 0, 0); ar = __builtin_amdgcn_mfma_f32_16x16x32_bf16(a1, Ba[n][1], ar, 0, 0, 0);
                ai = __builtin_amdgcn_mfma_f32_16x16x32_bf16(a0, Bx[n][0], ai, 0, 0, 0); ai = __builtin_amdgcn_mfma_f32_16x16x32_bf16(a1, Bx[n][1], ai, 0, 0, 0);
                const int c = w * 64 + n * 16 + fr;
                float av[4], bv[4];
#pragma unroll
                for (int jj = 0; jj < 4; ++jj) {
                    const int t = tt * 16 + fq * 4 + jj;
                    const float u = bf2f(U[t * 520 + c]);
                    const float r = sigmoid_(ar[jj]), ig = sigmoid_(ai[jj]);
                    const float a = __builtin_amdgcn_exp2f(-r * sp[n]);
                    const float beta = __builtin_amdgcn_sqrtf(fmaxf(1.0f - a * a, 0.f));
                    av[jj] = a; bv[jj] = beta * ig * u;
                }
                const float A4 = (av[0] * av[1]) * (av[2] * av[3]);
                const float B4 = ((bv[0] * av[1] + bv[1]) * av[2] + bv[2]) * av[3] + bv[3];
                float hs = h[n];
#pragma unroll
                for (int g = 0; g < 4; ++g) {
                    const float he = A4 * hs + B4;
                    const float nx = __shfl(he, fr + 16 * g);
                    if (fq > g) hs = nx;
                    if (g == 3) h[n] = nx;
                }
                if (PASS == 1) { float pp = A4; pp *= __shfl_xor(pp, 16); pp *= __shfl_xor(pp, 32); P[n] *= pp; }
                if (PASS == 2) {
                    float xh = hs;
#pragma unroll
                    for (int jj = 0; jj < 4; ++jj) { xh = av[jj] * xh + bv[jj]; HS[(tt * 16 + fq * 4 + jj) * 520 + c] = f2bf(xh); }
                }
            }
        }
        if (PASS == 2) {
            __syncthreads();
            u32x4 gpre[8];
#pragma unroll
            for (int i = 0; i < 8; ++i) gpre[i] = *(const u32x4*)(PROJ + proj_off(rowbase + tg * 8 + i, 3072) + 512 + c8);
#pragma unroll
            for (int i = 0; i < 8; ++i) {
                const int tl = tg * 8 + i;
                const u32x4 hv = *(const LAS u32x4*)(HS + tl * 520 + c8);
                const u32x4 gv = gpre[i];
                u32x4 o;
#pragma unroll
                for (int q = 0; q < 4; ++q) o[q] = cvt_pk_bf16(bf_lo(hv[q]) * gelu_tanh(bf_lo(gv[q])), bf_hi(hv[q]) * gelu_tanh(bf_hi(gv[q])));
                *(u32x4*)(Y + tiled(rowbase + tl, c8, 1024)) = o;
            }
        }
        __syncthreads();
    }
    if (PASS == 1) {
        if (fq == 0) {
#pragma unroll
            for (int n = 0; n < 4; ++n) { const int c = w * 64 + n * 16 + fr; Pbuf[(size_t)item * 512 + c] = P[n]; Hbuf[(size_t)item * 512 + c] = h[n]; }
        }
    }
}


__device__ __forceinline__ void hgrn_bcum2(LAS float* BC, LAS float* PT, const u32x4 (&zv)[2], const float (&lb)[8], int tid, float (&kout)[2][8]) {
    {
        const int d8 = (tid & 15) * 8, t = tid >> 4;
#pragma unroll
        for (int rr = 0; rr < 2; ++rr) {
            const int tr = t + rr * 32;
            float lf[8];
#pragma unroll
            for (int q = 0; q < 4; ++q) {
                const float z0 = bf_lo(zv[rr][q]), z1 = bf_hi(zv[rr][q]);
                const float k0 = (1.0f - lb[2 * q]) * sigmoid_(-z0), k1 = (1.0f - lb[2 * q + 1]) * sigmoid_(-z1);
                kout[rr][2 * q] = k0; kout[rr][2 * q + 1] = k1;
                lf[2 * q] = __logf(fmaxf(1.0f - k0, 1e-20f));
                lf[2 * q + 1] = __logf(fmaxf(1.0f - k1, 1e-20f));
            }
            *(LAS f32x4*)(BC + tr * 128 + d8) = (f32x4){lf[0], lf[1], lf[2], lf[3]};
            *(LAS f32x4*)(BC + tr * 128 + d8 + 4) = (f32x4){lf[4], lf[5], lf[6], lf[7]};
        }
    }
    __syncthreads();
    const int d = tid & 127, part = tid >> 7;
    {
        float a = 0.f;
#pragma unroll
        for (int i = 0; i < 16; ++i) { const int t = part * 16 + i; a += BC[t * 128 + d]; BC[t * 128 + d] = a; }
        PT[part * 128 + d] = a;
    }
    __syncthreads();
}
struct HcPre { u32x4 zv[2], vv[2], qv[2], gp[2]; };
template <int PASS>
__device__ __forceinline__ void hgrn2_load(const Params& p, int item, int c, HcPre& r) {
    int tid = threadIdx.x; asm volatile("" : "+v"(tid));
    const int bh = item >> 3, sup = item & 7, b = bh >> 2, h = bh & 3;
    const bf16_t* PROJ = (const bf16_t*)(p.ws + WS_BIG);
    const size_t rowbase = (size_t)b * SEQ + (size_t)(sup * 8 + c) * 64;
    const int d8 = (tid & 15) * 8, t = tid >> 4;
#pragma unroll
    for (int rr = 0; rr < 2; ++rr) {
        r.zv[rr] = *(const u32x4*)(PROJ + proj_off(rowbase + t + rr * 32, 3072) + 1536 + h * 128 + d8);
        r.vv[rr] = *(const u32x4*)(PROJ + proj_off(rowbase + t + rr * 32, 3072) + 2048 + h * 128 + d8);
        if (PASS == 2) r.qv[rr] = *(const u32x4*)(PROJ + proj_off(rowbase + t + rr * 32, 3072) + 1024 + h * 128 + d8);
    }
    if (PASS == 2) {
        const bf16_t* gp = PROJ + proj_off(rowbase + (tid >> 3), 3072) + 2560 + h * 128 + (tid & 7) * 16;
        r.gp[0] = *(const u32x4*)gp; r.gp[1] = *(const u32x4*)(gp + 8);
    }
}
template <int PASS>
__device__ __forceinline__ void hgrn2_init(const Params& p, int item, f32x4 (&S)[8], float (&Gt)[4]) {
    int tid = threadIdx.x; asm volatile("" : "+v"(tid));
    const int lane = tid & 63, w = __builtin_amdgcn_readfirstlane(tid >> 6), fq = lane >> 4;
#pragma unroll
    for (int n = 0; n < 8; ++n) S[n] = (f32x4){0.f, 0.f, 0.f, 0.f};
#pragma unroll
    for (int jj = 0; jj < 4; ++jj) Gt[jj] = 1.0f;
    if (PASS == 2) {
        const int bh = item >> 3, sup = item & 7;
        const float* SUMb = (const float*)(p.ws + WS_ST); const float* GTb = (const float*)(p.ws + WS_HGG);
        for (int s2 = 0; s2 < sup; ++s2) {
            const size_t it2 = (size_t)bh * 8 + s2;
            const f32x4 g4 = *(const f32x4*)(GTb + it2 * 128 + w * 16 + fq * 4);
#pragma unroll
            for (int n = 0; n < 8; ++n) { const f32x4 T = *(const f32x4*)(SUMb + it2 * 16384 + (size_t)((n * 8 + w) * 64 + lane) * 4); S[n] = g4 * S[n] + T; }
        }
    }
}
__device__ __forceinline__ void hgrn2_finish(const Params& p, int item, const f32x4 (&S)[8], const float (&Gt)[4]) {
    int tid = threadIdx.x; asm volatile("" : "+v"(tid));
    const int lane = tid & 63, w = __builtin_amdgcn_readfirstlane(tid >> 6), fr = lane & 15, fq = lane >> 4;
    float* SUMb = (float*)(p.ws + WS_ST); float* GTb = (float*)(p.ws + WS_HGG);
#pragma unroll
    for (int n = 0; n < 8; ++n) *(f32x4*)(SUMb + (size_t)item * 16384 + (size_t)((n * 8 + w) * 64 + lane) * 4) = S[n];
    if (fr == 0) *(f32x4*)(GTb + (size_t)item * 128 + w * 16 + fq * 4) = (f32x4){Gt[0], Gt[1], Gt[2], Gt[3]};
}
template <int PASS>
__device__ __forceinline__ void hgrn2_chunk(LAS unsigned char* lds, const Params& p, int j, int item, int c, const HcPre& pre, f32x4 (&S)[8], float (&Gt)[4]) {
    int tid = threadIdx.x; asm volatile("" : "+v"(tid));
    const int lane = tid & 63, w = __builtin_amdgcn_readfirstlane(tid >> 6), fr = lane & 15, fq = lane >> 4;
    const int bh = item >> 3, sup = item & 7, b = bh >> 2, h = bh & 3;
    bf16_t* Y = (bf16_t*)(p.ws + WS_Y);
    const size_t rowbase = (size_t)b * SEQ + (size_t)(sup * 8 + c) * 64;
    LAS float* BC = (LAS float*)lds;
    LAS bf16_t* QA = (LAS bf16_t*)(lds + 32768);
    LAS bf16_t* KA = (LAS bf16_t*)(lds + 50176);
    LAS bf16_t* VT = (LAS bf16_t*)(lds + 67584);
    LAS bf16_t* SS = (LAS bf16_t*)(lds + 86016);
    LAS bf16_t* AT = (LAS bf16_t*)(lds + 120832);
    LAS float* PT = (LAS float*)(lds + 130048);
    LAS bf16_t* VN = SS;
    const float* lbl = p.in[11];
    const int d8 = (tid & 15) * 8, t = tid >> 4;
    u32x4 zv[2], vv[2], qv[2], gpre[2]; float lb[8];
#pragma unroll
    for (int rr = 0; rr < 2; ++rr) { zv[rr] = pre.zv[rr]; vv[rr] = pre.vv[rr]; if (PASS == 2) { qv[rr] = pre.qv[rr]; gpre[rr] = pre.gp[rr]; } }
    f32x4 gnv[4];
    if (PASS == 2) {
        const float* gn0 = p.in[12] + j * 512 + h * 128 + (tid & 7) * 16;
#pragma unroll
        for (int q = 0; q < 4; ++q) gnv[q] = *(const f32x4*)(gn0 + q * 4);
    }
#pragma unroll
    for (int q = 0; q < 8; ++q) { const int ch = h * 128 + d8 + q; lb[q] = (j == 0) ? 0.f : sigmoid_(lbl[512 + ch] - lbl[ch]); }
#pragma unroll
    for (int rr = 0; rr < 2; ++rr) *(LAS u32x4*)(VN + (t + rr * 32) * 136 + d8) = vv[rr];
    float kq[2][8];
    hgrn_bcum2(BC, PT, zv, lb, tid, kq);
    {
        float bref[8], c1[8], c2[8], c3[8];
        {
            const f32x4 pa0 = *(const LAS f32x4*)(PT + d8), pa1 = *(const LAS f32x4*)(PT + d8 + 4);
            const f32x4 pb0 = *(const LAS f32x4*)(PT + 128 + d8), pb1 = *(const LAS f32x4*)(PT + 128 + d8 + 4);
            const f32x4 pc0 = *(const LAS f32x4*)(PT + 256 + d8), pc1 = *(const LAS f32x4*)(PT + 256 + d8 + 4);
#pragma unroll
            for (int q = 0; q < 4; ++q) { c1[q] = pa0[q]; c1[4 + q] = pa1[q]; c2[q] = pa0[q] + pb0[q]; c2[4 + q] = pa1[q] + pb1[q]; c3[q] = c2[q] + pc0[q]; c3[4 + q] = c2[4 + q] + pc1[q]; }
        }
        const bool hi16 = (t >> 4) != 0;
#pragma unroll
        for (int q = 0; q < 8; ++q) bref[q] = BC[31 * 128 + d8 + q] + c1[q];
#pragma unroll
        for (int rr = 0; rr < 2; ++rr) {
            const int tr = t + rr * 32;
            float qa[8], ka[8];
#pragma unroll
            for (int q = 0; q < 8; ++q) {
                const float bc = BC[tr * 128 + d8 + q] + (rr == 0 ? (hi16 ? c1[q] : 0.f) : (hi16 ? c3[q] : c2[q]));
                const float dq = fminf(fmaxf(bc - bref[q], -80.f), 80.f);
                const float e1 = __expf(dq);
                if (PASS == 2) { const float qq = silu_((q & 1) ? bf_hi(qv[rr][q >> 1]) : bf_lo(qv[rr][q >> 1])); qa[q] = qq * e1; }
                ka[q] = kq[rr][q] * rcp_(e1);
            }
            u32x4 o;
            if (PASS == 2) {
#pragma unroll
                for (int q = 0; q < 4; ++q) o[q] = cvt_pk_bf16(qa[2 * q], qa[2 * q + 1]);
                *(LAS u32x4*)(QA + tr * 136 + d8) = o;
            }
#pragma unroll
            for (int q = 0; q < 4; ++q) o[q] = cvt_pk_bf16(ka[2 * q], ka[2 * q + 1]);
            *(LAS u32x4*)(KA + tr * 136 + d8) = o;
        }
        {
            const int e = tid & 127, tq = tid >> 7;
            bf16_t vq[16];
#pragma unroll
            for (int i = 0; i < 16; ++i) vq[i] = VN[(tq * 16 + i) * 136 + e];
            u32x4 p0, p1;
#pragma unroll
            for (int q = 0; q < 4; ++q) { p0[q] = (unsigned)vq[2 * q] | ((unsigned)vq[2 * q + 1] << 16); p1[q] = (unsigned)vq[8 + 2 * q] | ((unsigned)vq[8 + 2 * q + 1] << 16); }
            *(LAS u32x4*)(VT + e * 72 + tq * 16) = p0; *(LAS u32x4*)(VT + e * 72 + tq * 16 + 8) = p1;
        }
    }
    float gsc[4], sc[4], eb[4];
#pragma unroll
    for (int jj = 0; jj < 4; ++jj) { const int dd = w * 16 + fq * 4 + jj; const float p0 = PT[dd], br = BC[31 * 128 + dd] + p0, bl = BC[63 * 128 + dd] + ((p0 + PT[128 + dd]) + PT[256 + dd]); gsc[jj] = __expf(bl); sc[jj] = __expf(bl - br); eb[jj] = __expf(br); }
    __syncthreads();
    if (PASS == 2) {
#pragma unroll
        for (int n = 0; n < 8; ++n) { u32x2 o; o.x = cvt_pk_bf16(S[n][0] * eb[0], S[n][1] * eb[1]); o.y = cvt_pk_bf16(S[n][2] * eb[2], S[n][3] * eb[3]);
            *(LAS u32x2*)(SS + (n * 16 + fr) * 136 + w * 16 + fq * 4) = o; }
        {
            const int tt = w >> 1;
#pragma unroll
            for (int si = 0; si < 2; ++si) {
                const int ss = (w & 1) * 2 + si;
                f32x4 acc = (f32x4){0.f, 0.f, 0.f, 0.f};
                if (ss <= tt) {
#pragma unroll
                    for (int kk = 0; kk < 4; ++kk) {
                        const bf16x8 a = *(const LAS bf16x8*)(QA + (tt * 16 + fr) * 136 + kk * 32 + fq * 8);
                        const bf16x8 bb = *(const LAS bf16x8*)(KA + (ss * 16 + fr) * 136 + kk * 32 + fq * 8);
                        acc = __builtin_amdgcn_mfma_f32_16x16x32_bf16(a, bb, acc, 0, 0, 0);
                    }
                }
#pragma unroll
                for (int jj = 0; jj < 4; ++jj) {
                    const int tq2 = tt * 16 + fq * 4 + jj, sq2 = ss * 16 + fr;
                    const float v = (sq2 <= tq2) ? acc[jj] : 0.f;
                    AT[tq2 * 72 + sq2] = f2bf(v);
                }
            }
        }
        __syncthreads();
        {
            const int tt = w >> 1, n0 = (w & 1) * 4;
            f32x4 acc[4];
#pragma unroll
            for (int n = 0; n < 4; ++n) acc[n] = (f32x4){0.f, 0.f, 0.f, 0.f};
#pragma unroll
            for (int kk = 0; kk < 4; ++kk) {
                const bf16x8 a = *(const LAS bf16x8*)(QA + (tt * 16 + fr) * 136 + kk * 32 + fq * 8);
#pragma unroll
                for (int n = 0; n < 4; ++n) { const bf16x8 bb = *(const LAS bf16x8*)(SS + ((n0 + n) * 16 + fr) * 136 + kk * 32 + fq * 8); acc[n] = __builtin_amdgcn_mfma_f32_16x16x32_bf16(a, bb, acc[n], 0, 0, 0); }
            }
#pragma unroll
            for (int kk = 0; kk < 2; ++kk) {
                if (kk * 32 <= tt * 16 + 15) {
                    const bf16x8 a = *(const LAS bf16x8*)(AT + (tt * 16 + fr) * 72 + kk * 32 + fq * 8);
#pragma unroll
                    for (int n = 0; n < 4; ++n) { const bf16x8 bb = *(const LAS bf16x8*)(VT + ((n0 + n) * 16 + fr) * 72 + kk * 32 + fq * 8); acc[n] = __builtin_amdgcn_mfma_f32_16x16x32_bf16(a, bb, acc[n], 0, 0, 0); }
                }
            }
            LAS float* OS = BC;
#pragma unroll
            for (int n = 0; n < 4; ++n)
#pragma unroll
                for (int jj = 0; jj < 4; ++jj) OS[(tt * 16 + fq * 4 + jj) * 128 + (n0 + n) * 16 + fr] = acc[n][jj];
        }
    }
    {
        bf16x8 af[2];
#pragma unroll
        for (int kk = 0; kk < 2; ++kk)
#pragma unroll
            for (int i = 0; i < 8; ++i) af[kk][i] = (short)KA[(kk * 32 + fq * 8 + i) * 136 + w * 16 + fr];
#pragma unroll
        for (int n = 0; n < 8; ++n) {
            f32x4 acc = (f32x4){0.f, 0.f, 0.f, 0.f};
#pragma unroll
            for (int kk = 0; kk < 2; ++kk) { const bf16x8 bb = *(const LAS bf16x8*)(VT + (n * 16 + fr) * 72 + kk * 32 + fq * 8); acc = __builtin_amdgcn_mfma_f32_16x16x32_bf16(af[kk], bb, acc, 0, 0, 0); }
#pragma unroll
            for (int jj = 0; jj < 4; ++jj) S[n][jj] = gsc[jj] * S[n][jj] + sc[jj] * acc[jj];
        }
        if (PASS == 1) {
#pragma unroll
            for (int jj = 0; jj < 4; ++jj) Gt[jj] *= gsc[jj];
        }
    }
    if (PASS == 2) {
        __syncthreads();
        LAS float* OS = BC;
        const int t2 = tid >> 3, e16 = (tid & 7) * 16;
        f32x4 ov[4]; float ss = 0.f;
#pragma unroll
        for (int q = 0; q < 4; ++q) { ov[q] = *(const LAS f32x4*)(OS + t2 * 128 + e16 + q * 4); ss += (ov[q][0] * ov[q][0] + ov[q][1] * ov[q][1]) + (ov[q][2] * ov[q][2] + ov[q][3] * ov[q][3]); }
        ss += __shfl_xor(ss, 1); ss += __shfl_xor(ss, 2); ss += __shfl_xor(ss, 4);
        const float rstd = rsqrtf(ss * (1.0f / 128.0f) + EPS);
        bf16_t* yp = Y + tiled(rowbase + t2, 512 + h * 128 + e16, 1024);
#pragma unroll
        for (int hlf = 0; hlf < 2; ++hlf) {
            const u32x4 gv = gpre[hlf];
            const f32x4 n0v = gnv[hlf * 2], n1v = gnv[hlf * 2 + 1];
            u32x4 o;
#pragma unroll
            for (int q = 0; q < 4; ++q) {
                const float o0 = ov[hlf * 2 + (q >> 1)][(q & 1) * 2], o1 = ov[hlf * 2 + (q >> 1)][(q & 1) * 2 + 1];
                const float g0 = (q < 2) ? n0v[2 * q] : n1v[2 * q - 4], g1 = (q < 2) ? n0v[2 * q + 1] : n1v[2 * q - 3];
                o[q] = cvt_pk_bf16(o0 * rstd * g0 * silu_(bf_lo(gv[q])), o1 * rstd * g1 * silu_(bf_hi(gv[q])));
            }
            *(u32x4*)(yp + hlf * 8) = o;
        }
        __syncthreads();
    }
}
template <int PASS>
__device__ __forceinline__ void hgrn2_run(LAS unsigned char* lds, const Params& p, int j, int bid, int G, int nitems) {
    f32x4 S[8]; float Gt[4]; HcPre nxt;
    const int nsteps = nitems * 8;
    if (nsteps <= 0) return;
    hgrn2_load<PASS>(p, bid, 0, nxt);
#pragma unroll 1
    for (int step = 0; step < nsteps; ++step) {
        const bool mir = (G == 32) && (nitems == 2);
        const int k0 = step >> 3, k1 = (step + 1) >> 3;
        const int item = (mir && k0 == 1) ? ((bid & ~31) + 32 + ((bid & 31) ^ 7)) : bid + k0 * G, c = step & 7;
        const HcPre cur = nxt;
        if (step + 1 < nsteps) hgrn2_load<PASS>(p, (mir && k1 == 1) ? ((bid & ~31) + 32 + ((bid & 31) ^ 7)) : bid + k1 * G, (step + 1) & 7, nxt);
        if (c == 0) hgrn2_init<PASS>(p, item, S, Gt);
        hgrn2_chunk<PASS>(lds, p, j, item, c, cur, S, Gt);
        if (PASS == 1 && c == 7) hgrn2_finish(p, item, S, Gt);
    }
    __syncthreads();
}

__device__ __forceinline__ void sgu_item(LAS unsigned char* lds, const Params& p, int j, int item) {
    int tid = threadIdx.x; asm volatile("" : "+v"(tid));
    const int lane = tid & 63, w = __builtin_amdgcn_readfirstlane(tid >> 6), fr = lane & 15, fq = lane >> 4;
    const int g = item & 3, n = (item >> 2) & 31, b = item >> 7;
    const bf16_t* PROJ = (const bf16_t*)(p.ws + WS_BIG);
    bf16_t* Y = (bf16_t*)(p.ws + WS_Y);
    const size_t rowbase = (size_t)b * SEQ + n * 128;
    LAS bf16_t* VT = (LAS bf16_t*)lds;
    LAS bf16_t* WL = (LAS bf16_t*)(lds + 69632);
    const int tC = w * 16 + fr;
    u32x4 wt[4]; u32x2 uv[8];
    {
        const bf16_t* Wm = (const bf16_t*)(p.ws + WS_SMALL + SM_SGUW) + (size_t)(j * 4 + g) * 16384;
#pragma unroll
        for (int i = 0; i < 4; ++i) { const int idx = tid + i * 512; wt[i] = *(const u32x4*)(Wm + (idx >> 4) * 128 + (idx & 15) * 8); }
        const bf16_t* up = PROJ + proj_off(rowbase + tC, 1536) + g * 128 + fq * 4;
#pragma unroll
        for (int q = 0; q < 8; ++q) uv[q] = *(const u32x2*)(up + q * 16);
    }
    {
        const int s = tid >> 2, qtr = tid & 3;
        const bf16_t* vp = PROJ + proj_off(rowbase + s, 1536) + 512 + g * 128 + qtr * 32;
        float v[32]; float sum = 0.f;
#pragma unroll
        for (int i = 0; i < 4; ++i) { const u32x4 vv = *(const u32x4*)(vp + i * 8);
#pragma unroll
            for (int q = 0; q < 4; ++q) { v[i * 8 + 2 * q] = bf_lo(vv[q]); v[i * 8 + 2 * q + 1] = bf_hi(vv[q]); sum += v[i * 8 + 2 * q] + v[i * 8 + 2 * q + 1]; } }
        sum += __shfl_xor(sum, 1); sum += __shfl_xor(sum, 2);
        const float mu = sum * (1.0f / 128.0f); float var = 0.f;
#pragma unroll
        for (int i = 0; i < 32; ++i) { v[i] -= mu; var += v[i] * v[i]; }
        var += __shfl_xor(var, 1); var += __shfl_xor(var, 2);
        const float rstd = rsqrtf(var * (1.0f / 128.0f) + EPS);
        LAS bf16_t* VN = (LAS bf16_t*)(lds + 34816);
#pragma unroll
        for (int i = 0; i < 4; ++i) { u32x4 o;
#pragma unroll
            for (int q = 0; q < 4; ++q) o[q] = cvt_pk_bf16(v[i * 8 + 2 * q] * rstd, v[i * 8 + 2 * q + 1] * rstd);
            *(LAS u32x4*)(VN + s * 136 + qtr * 32 + i * 8) = o; }
#pragma unroll
        for (int i = 0; i < 4; ++i) { const int idx = tid + i * 512; *(LAS u32x4*)(WL + (idx >> 4) * 136 + (idx & 15) * 8) = wt[i]; }
    }
    __syncthreads();
    {
        LAS const bf16_t* VN = (LAS const bf16_t*)(lds + 34816);
        const int c = tid & 127, sq = tid >> 7;
        bf16_t vq[32];
#pragma unroll
        for (int i = 0; i < 32; ++i) vq[i] = VN[(sq * 32 + i) * 136 + c];
#pragma unroll
        for (int i = 0; i < 4; ++i) { u32x4 o;
#pragma unroll
            for (int q = 0; q < 4; ++q) o[q] = (unsigned)vq[i * 8 + 2 * q] | ((unsigned)vq[i * 8 + 2 * q + 1] << 16);
            *(LAS u32x4*)(VT + c * 136 + sq * 32 + i * 8) = o; }
    }
    __syncthreads();
    {
        f32x4 acc[8];
#pragma unroll
        for (int q = 0; q < 8; ++q) acc[q] = (f32x4){0.f, 0.f, 0.f, 0.f};
        const int kmax = w >> 1;
#pragma unroll
        for (int kk = 0; kk < 4; ++kk) {
            if (kk <= kmax) {
                const bf16x8 wf = *(const LAS bf16x8*)(WL + (w * 16 + fr) * 136 + kk * 32 + fq * 8);
#pragma unroll
                for (int q = 0; q < 8; ++q) { const bf16x8 vf = *(const LAS bf16x8*)(VT + (q * 16 + fr) * 136 + kk * 32 + fq * 8); acc[q] = __builtin_amdgcn_mfma_f32_16x16x32_bf16(vf, wf, acc[q], 0, 0, 0); }
            }
        }
        const float bias = p.in[16][(size_t)(j * 4 + g) * 128 + tC];
        bf16_t* yp = Y + tiled(rowbase + tC, g * 128 + fq * 4, 1024);
#pragma unroll
        for (int q = 0; q < 8; ++q) {
            u32x2 o; o.x = cvt_pk_bf16(bf_lo(uv[q].x) * (acc[q][0] + bias), bf_hi(uv[q].x) * (acc[q][1] + bias)); o.y = cvt_pk_bf16(bf_lo(uv[q].y) * (acc[q][2] + bias), bf_hi(uv[q].y) * (acc[q][3] + bias));
            *(u32x2*)(yp + (q >> 2) * 16384 + (q & 3) * 16) = o;
        }
    }
    __syncthreads();
}

__device__ __forceinline__ void pool_item(LAS unsigned char* lds, const Params& p, int j, int item) {
    int tid = threadIdx.x; asm volatile("" : "+v"(tid));
    const int lane = tid & 63, w = __builtin_amdgcn_readfirstlane(tid >> 6), fr = lane & 15, fq = lane >> 4;
    const int gi = item & 3, tile = (item >> 2) & 31, b = item >> 7;
    const bf16_t* PROJ = (const bf16_t*)(p.ws + WS_BIG);
    bf16_t* Y = (bf16_t*)(p.ws + WS_Y);
    const int t0 = tile * 128;
    const size_t rowbase = (size_t)b * SEQ + t0;
    LAS float* PL = (LAS float*)lds;
    LAS bf16_t* PA = (LAS bf16_t*)(lds + 73728);
    LAS bf16_t* PWL = (LAS bf16_t*)(lds + 108544);
    {
        const bf16_t* PWT = (const bf16_t*)(p.ws + WS_SMALL + SM_PWT) + (size_t)(j * 4 + gi) * 16384;
        u32x4 wt[4];
#pragma unroll
        for (int i = 0; i < 4; ++i) { const int idx = tid + i * 512; wt[i] = *(const u32x4*)(PWT + (idx >> 4) * 128 + (idx & 15) * 8); }
        for (int idx = tid; idx < 144 * 16; idx += NTHR) {
            const int r = idx >> 4, c8 = (idx & 15) * 8; const int ts = t0 - 16 + r;
            u32x4 vv = (u32x4){0u, 0u, 0u, 0u};
            if (ts >= 0) vv = *(const u32x4*)(PROJ + proj_off((size_t)b * SEQ + ts, 1536) + 1024 + gi * 128 + c8);
            *(LAS f32x4*)(PL + r * 128 + c8) = (f32x4){bf_lo(vv[0]), bf_hi(vv[0]), bf_lo(vv[1]), bf_hi(vv[1])};
            *(LAS f32x4*)(PL + r * 128 + c8 + 4) = (f32x4){bf_lo(vv[2]), bf_hi(vv[2]), bf_lo(vv[3]), bf_hi(vv[3])};
        }
#pragma unroll
        for (int i = 0; i < 4; ++i) { const int idx = tid + i * 512; *(LAS u32x4*)(PWL + (idx >> 4) * 136 + (idx & 15) * 8) = wt[i]; }
    }
    __syncthreads();
    {
        const int tg = tid >> 4, c8 = (tid & 15) * 8; const int win = 2 << gi;
        const int tf = tg * 4;
        f32x4 s0 = (f32x4){0.f, 0.f, 0.f, 0.f}, s1 = (f32x4){0.f, 0.f, 0.f, 0.f};
        for (int k = 0; k < win; ++k) { const LAS float* rp = PL + (tf + 16 - k) * 128 + c8; s0 += *(const LAS f32x4*)rp; s1 += *(const LAS f32x4*)(rp + 4); }
#pragma unroll
        for (int i = 0; i < 4; ++i) {
            const int t = tf + i;
            const LAS float* cp = PL + (t + 16) * 128 + c8;
            const f32x4 c0 = *(const LAS f32x4*)cp, c1 = *(const LAS f32x4*)(cp + 4);
            if (i > 0) { const LAS float* op = PL + (t + 16 - win) * 128 + c8; s0 += c0 - *(const LAS f32x4*)op; s1 += c1 - *(const LAS f32x4*)(op + 4); }
            const int tabs = t0 + t; const int cnt = (tabs + 1 < win) ? tabs + 1 : win;
            const float inv = rcp_((float)cnt);
            const f32x4 a = s0 * inv - c0, bq = s1 * inv - c1;
            u32x4 o; o.x = cvt_pk_bf16(a[0], a[1]); o.y = cvt_pk_bf16(a[2], a[3]); o.z = cvt_pk_bf16(bq[0], bq[1]); o.w = cvt_pk_bf16(bq[2], bq[3]);
            *(LAS u32x4*)(PA + t * 136 + c8) = o;
        }
    }
    __syncthreads();
    {
        f32x4 acc[8];
#pragma unroll
        for (int q = 0; q < 8; ++q) acc[q] = (f32x4){0.f, 0.f, 0.f, 0.f};
#pragma unroll
        for (int kk = 0; kk < 4; ++kk) {
            const bf16x8 pf = *(const LAS bf16x8*)(PA + (w * 16 + fr) * 136 + kk * 32 + fq * 8);
#pragma unroll
            for (int q = 0; q < 8; ++q) { const bf16x8 wf = *(const LAS bf16x8*)(PWL + (q * 16 + fr) * 136 + kk * 32 + fq * 8); acc[q] = __builtin_amdgcn_mfma_f32_16x16x32_bf16(wf, pf, acc[q], 0, 0, 0); }
        }
        const int t = w * 16 + fr;
        bf16_t* yp = Y + tiled(rowbase + t, 512 + gi * 128 + fq * 4, 1024);
#pragma unroll
        for (int q = 0; q < 8; ++q) { u32x2 o; o.x = cvt_pk_bf16(acc[q][0], acc[q][1]); o.y = cvt_pk_bf16(acc[q][2], acc[q][3]); *(u32x2*)(yp + (q >> 2) * 16384 + (q & 3) * 16) = o; }
    }
    __syncthreads();
}

__device__ __forceinline__ void zero_y(const Params& p) {
    int tid = threadIdx.x; asm volatile("" : "+v"(tid));
    u32x4* yz = (u32x4*)(p.ws + WS_Y);
    for (size_t i = (size_t)blockIdx.x * NTHR + tid; i < (size_t)MTOK * 128; i += (size_t)gridDim.x * NTHR) yz[i] = (u32x4){0u, 0u, 0u, 0u};
}
__device__ __forceinline__ void final_norm(const Params& p) {
    int tid = threadIdx.x; asm volatile("" : "+v"(tid));
    const int lane = tid & 63, wave = tid >> 6;
    const int gw = blockIdx.x * 8 + wave, NGW = gridDim.x * 8;
    const float* rowss = (const float*)(p.ws + WS_ROWSS); const float* gain = p.in[22];
    f32x4 gv[4];
#pragma unroll
    for (int q = 0; q < 4; ++q) gv[q] = *((const f32x4*)gain + lane + 64 * q);
    for (int row = gw; row < MTOK; row += 2 * NGW) {
        const int row2 = row + NGW;
        f32x4* hr = (f32x4*)(p.out + (size_t)row * DM) + lane; f32x4* hr2 = (f32x4*)(p.out + (size_t)row2 * DM) + lane;
        f32x4 v[4], v2[4];
#pragma unroll
        for (int q = 0; q < 4; ++q) { v[q] = hr[64 * q]; v2[q] = hr2[64 * q]; }
        const f32x4* sp = (const f32x4*)(rowss + (size_t)row * 16); const f32x4* sp2 = (const f32x4*)(rowss + (size_t)row2 * 16);
        const f32x4 st = (sp[0] + sp[1]) + (sp[2] + sp[3]), st2 = (sp2[0] + sp2[1]) + (sp2[2] + sp2[3]);
        const float rstd = rsqrtf(((st[0] + st[1]) + (st[2] + st[3])) * (1.0f / 1024.0f) + EPS);
        const float rstd2 = rsqrtf(((st2[0] + st2[1]) + (st2[2] + st2[3])) * (1.0f / 1024.0f) + EPS);
#pragma unroll
        for (int q = 0; q < 4; ++q) { hr[64 * q] = v[q] * rstd * gv[q]; hr2[64 * q] = v2[q] * rstd2 * gv[q]; }
    }
}

#define XB_TMO      128
#define XB_XCNT(j)  (256  + 64 * (j))
#define XB_XSUB(j)  (1280 + 64 * (j))
#define XB_XGEN(j)  (2304 + 64 * (j))
#define XB_TOP      3328
#define XB_TOPGEN   3392
#define XCD_BAR_WORDS 3456
#define XB_SPIN_CAP (1u << 18)
__device__ __forceinline__ unsigned xb_ld(unsigned* p)              { return __hip_atomic_load(p, __ATOMIC_RELAXED, __HIP_MEMORY_SCOPE_AGENT); }
__device__ __forceinline__ unsigned xb_add(unsigned* p, unsigned v) { return __hip_atomic_fetch_add(p, v, __ATOMIC_RELAXED, __HIP_MEMORY_SCOPE_AGENT); }
__device__ __forceinline__ unsigned xb_xcc_id() { return (unsigned)__builtin_amdgcn_s_getreg((3 << 11) | 20) & 0xFu; }
#define XB_SPIN(cond, bar) do { unsigned _sp = 0; while (cond) { __builtin_amdgcn_s_sleep(1); \
    if ((++_sp & 255u) == 0u) { if (xb_ld(&(bar)[XB_TMO])) break; if (_sp > XB_SPIN_CAP) { atomicAdd(&(bar)[XB_TMO], 1u); break; } } } } while (0)
struct XcdBarrier { unsigned* bar; unsigned x; volatile LAS unsigned* st; };
__device__ __forceinline__ XcdBarrier xcd_barrier_post(unsigned* bar, volatile LAS unsigned* st) {
    XcdBarrier b; b.bar = bar; b.x = xb_xcc_id(); b.st = st;
    if (threadIdx.x == 0) (void)xb_add(&bar[XB_XCNT(b.x)], 1u);
    return b;
}
__device__ __forceinline__ void xcd_barrier_complete(unsigned* bar, unsigned x, unsigned& nloc, unsigned& nx) {
    const unsigned G = gridDim.x * gridDim.y * gridDim.z;
    unsigned sum, cnt, mine, sp = 0u;
    for (;;) {
        sum = 0u; cnt = 0u; mine = 0u;
#pragma unroll
        for (unsigned j = 0; j < 16; ++j) { const unsigned c = xb_ld(&bar[XB_XCNT(j)]); sum += c; cnt += (c > 0u) ? 1u : 0u; mine = (j == x) ? c : mine; }
        if (sum == G) break;
        __builtin_amdgcn_s_sleep(1);
        if ((++sp & 255u) == 0u) { if (xb_ld(&bar[XB_TMO])) break; if (sp > XB_SPIN_CAP) { atomicAdd(&bar[XB_TMO], 1u); break; } }
    }
    nloc = mine > 0u ? mine : 1u; nx = cnt > 0u ? cnt : 1u;
}
__device__ __forceinline__ void xcd_barrier(const XcdBarrier& b) {
    asm volatile("s_waitcnt vmcnt(0)" ::: "memory");
    __syncthreads();
    if (threadIdx.x == 0) {
        unsigned* bar = b.bar;
        __builtin_amdgcn_s_waitcnt(0);
        unsigned nloc = b.st[0], nx = b.st[1];
        if (nloc == 0u) { xcd_barrier_complete(bar, b.x, nloc, nx); b.st[0] = nloc; b.st[1] = nx; }
        const unsigned old = xb_add(&bar[XB_XSUB(b.x)], 1u);
        const unsigned gen = old / nloc;
        if (old + 1u == (gen + 1u) * nloc) {
            __builtin_amdgcn_fence(__ATOMIC_RELEASE, "agent");
            asm volatile("s_waitcnt vmcnt(0)" ::: "memory");
            const unsigned og = xb_add(&bar[XB_TOP], 1u);
            const unsigned tg = og / nx;
            if (og + 1u == (tg + 1u) * nx) xb_add(&bar[XB_TOPGEN], 1u);
            else XB_SPIN(xb_ld(&bar[XB_TOPGEN]) == tg, bar);
            __builtin_amdgcn_fence(__ATOMIC_ACQUIRE, "agent");
            xb_add(&bar[XB_XGEN(b.x)], 1u);
            asm volatile("s_waitcnt vmcnt(0)" ::: "memory");
        } else {
            XB_SPIN(xb_ld(&bar[XB_XGEN(b.x)]) == gen, bar);
            __builtin_amdgcn_fence(__ATOMIC_ACQUIRE, "agent");
            asm volatile("s_waitcnt vmcnt(0)" ::: "memory");
        }
    }
    __syncthreads();
}

__device__ __forceinline__ void xcd_local_barrier(const XcdBarrier& b) {
    asm volatile("s_waitcnt vmcnt(0)" ::: "memory");
    __syncthreads();
    if (threadIdx.x == 0) {
        unsigned* bar = b.bar;
        __builtin_amdgcn_s_waitcnt(0);
        const unsigned nloc = b.st[0];
        const unsigned old = xb_add(&bar[XB_XSUB(b.x)], 1u);
        const unsigned gen = old / nloc;
        if (old + 1u == (gen + 1u) * nloc) xb_add(&bar[XB_XGEN(b.x)], 1u);
        else XB_SPIN(xb_ld(&bar[XB_XGEN(b.x)]) == gen, bar);
        __builtin_amdgcn_fence(__ATOMIC_ACQUIRE, "agent");
        asm volatile("s_waitcnt vmcnt(0)" ::: "memory");
    }
    __syncthreads();
}

__global__ void __launch_bounds__(NTHR, 2) fwd_megakernel(Params p) {
    extern __shared__ __attribute__((aligned(16))) unsigned char lds_raw[];
    LAS unsigned char* lds = (LAS unsigned char*)lds_raw;
    const int G = gridDim.x, bid = blockIdx.x;
    bf16_t* WTb = (bf16_t*)(p.ws + WS_WT);
    bf16_t* HB = (bf16_t*)(p.ws + WS_HB); bf16_t* Y = (bf16_t*)(p.ws + WS_Y); bf16_t* BIG = (bf16_t*)(p.ws + WS_BIG);
    float* rowss = (float*)(p.ws + WS_ROWSS);

    volatile LAS unsigned* xst = (volatile LAS unsigned*)(lds + LDS_BYTES - 64);
    if (threadIdx.x < 8) xst[threadIdx.x] = 0u;
    __syncthreads();
    XcdBarrier xbar; xbar.bar = (unsigned*)(p.ws + WS_BAR); xbar.st = xst; xbar.x = xb_xcc_id();
    if (threadIdx.x == 0) xst[2] = xb_add(&xbar.bar[XB_XCNT(xbar.x)], 1u);
    for (int rep = 0; rep < DBG_REP_P0; ++rep) phase0(lds, p);
    cg::this_grid().sync();
    if (threadIdx.x == 0) {
        bool okc = (G % 8) == 0;
        for (unsigned jx = 0; jx < 16; ++jx) { const unsigned cx = xb_ld(&xbar.bar[XB_XCNT(jx)]); okc = okc && (cx == (jx < 8 ? (unsigned)G / 8u : 0u)); }
        xst[4] = okc ? (xst[2] * 8u + xbar.x) : (unsigned)bid; xst[5] = okc ? 1u : 0u;
    }
    __syncthreads();
    const int vid = __builtin_amdgcn_readfirstlane((int)xst[4]);
    const bool xlocal = USE_LOCAL_BAR && (__builtin_amdgcn_readfirstlane((int)xst[5]) != 0);
    const int NX = ((G & 7) == 0) ? 8 : 1, xv = vid % NX, rk = vid / NX, RK = G / NX;
#define SEAM() do { if (xlocal) xcd_local_barrier(xbar); else xcd_barrier(xbar); } while (0)
#define GRID_SYNC() xcd_barrier(xbar)
#pragma unroll 1
    for (int layer = 0; layer < 4; ++layer) {
        const int j = layer >> 1;
        const bool even = (layer & 1) == 0;
        if (even) {
            pg8::Gemm g{HB, WTb + OFF_INE + (size_t)j * 3145728, MTOK, 3072, 1024}; pg8::StaticOrder S; int vq1 = vid, Gq1 = G; asm volatile("" : "+s"(vq1), "+s"(Gq1)); S.init(MTOK, 3072, Gq1, vq1, 0);
            pg8::EpiIn<0> E{BIG, 3072, rowss};
            pg8::gemm_phase(lds, g, S, E);
        } else {
            pg8::Gemm g{HB, WTb + OFF_INO + (size_t)j * 1572864, MTOK, 1536, 1024}; pg8::StaticOrder S; int vq2 = vid, Gq2 = G; asm volatile("" : "+s"(vq2), "+s"(Gq2)); S.init(MTOK, 1536, Gq2, vq2, 0);
            pg8::EpiIn<1> E{BIG, 1536, rowss};
            pg8::gemm_phase(lds, g, S, E);
        }
        if (layer == 0) GRID_SYNC(); else SEAM();
        if (even) {
            for (int i = rk; i < 256 / NX; i += RK) lru_pass<1>(lds, p, j, xv * (256 / NX) + i);
            hgrn2_run<1>(lds, p, j, xv * (512 / NX) + rk, RK, (512 / NX - rk + RK - 1) / RK);
            SEAM();
            for (int i = rk; i < 256 / NX; i += RK) lru_pass<2>(lds, p, j, xv * (256 / NX) + i);
            hgrn2_run<2>(lds, p, j, xv * (512 / NX) + rk, RK, (512 / NX - rk + RK - 1) / RK);
        } else {
            for (int i = rk; i < 2048 / NX; i += RK) sgu_item(lds, p, j, xv * (2048 / NX) + i);
            for (int i = rk, k = 0; i < 2048 / NX; i += RK, ++k) pool_item(lds, p, j, xv * (2048 / NX) + (i & ~3) + ((i + k) & 3));
        }
        SEAM();
        {
            const bf16_t* Wt = even ? WTb + OFF_OUTE + (size_t)j * 1048576 : WTb + OFF_OUTO + (size_t)j * 1048576;
            pg8::Gemm g{Y, Wt, MTOK, 1024, 1024}; pg8::StaticOrder S; int vq3 = vid, Gq3 = G; asm volatile("" : "+s"(vq3), "+s"(Gq3)); S.init(MTOK, 1024, Gq3, vq3, 1);
            pg8::EpiRes E{layer == 0 ? p.in[0] : (const float*)p.out, p.out, HB, rowss};
            pg8::gemm_phase(lds, g, S, E);
        }
        SEAM();
        {
            pg8::Gemm g{HB, WTb + OFF_FIN + (size_t)layer * 4194304, MTOK, 4096, 1024}; pg8::StaticOrder S; int vq4 = vid, Gq4 = G; asm volatile("" : "+s"(vq4), "+s"(Gq4)); S.init(MTOK, 4096, Gq4, vq4, 0);
            pg8::EpiIn<2> E{BIG, 4096, rowss};
            pg8::gemm_phase(lds, g, S, E);
        }
        SEAM();
        {
            pg8::Gemm g{BIG, WTb + OFF_FOUT + (size_t)layer * 4194304, MTOK, 1024, 4096}; pg8::StaticOrder S; int vq5 = vid, Gq5 = G; asm volatile("" : "+s"(vq5), "+s"(Gq5)); S.init(MTOK, 1024, Gq5, vq5, 1);
            pg8::EpiRes E{(const float*)p.out, p.out, HB, rowss};
            pg8::gemm_phase(lds, g, S, E);
        }
        if (layer == 3) GRID_SYNC(); else SEAM();
    }
    for (int rep = 0; rep < DBG_EXTRA_SYNCS; ++rep) GRID_SYNC();
    final_norm(p);
}

extern "C" void kernel_launch(void* const* d_in, const int* in_sizes, int n_in, void* d_out, int out_size, void* d_ws, size_t ws_size, hipStream_t stream) {
    static int grid_blocks = 0;
    if (!grid_blocks) {
        int dev = 0, cus = 0, per_cu = 0;
        (void)hipGetDevice(&dev);
        (void)hipDeviceGetAttribute(&cus, hipDeviceAttributeMultiprocessorCount, dev);
        (void)hipFuncSetAttribute((const void*)fwd_megakernel, hipFuncAttributeMaxDynamicSharedMemorySize, LDS_BYTES);
        (void)hipOccupancyMaxActiveBlocksPerMultiprocessor(&per_cu, (const void*)fwd_megakernel, NTHR, LDS_BYTES);
        (void)hipGetLastError();
        grid_blocks = cus > 0 ? cus : 256;
        if (n_in != 23 || out_size != MTOK * DM || ws_size < (size_t)868 * MiB) fprintf(stderr, "kernel_launch: unexpected shapes n_in %d out %d ws %zu\n", n_in, out_size, ws_size);
    }
    Params p{};
    for (int i = 0; i < 23; ++i) p.in[i] = (const float*)d_in[i];
    p.out = (float*)d_out; p.ws = (unsigned char*)d_ws;
    (void)hipMemsetAsync((unsigned char*)d_ws + WS_BAR, 0, 16384, stream);
    void* args[] = {&p};
    hipError_t e = hipLaunchCooperativeKernel((void*)fwd_megakernel, dim3(grid_blocks), dim3(NTHR), args, LDS_BYTES, stream);
    if (e != hipSuccess) fprintf(stderr, "cooperative launch failed: %s (grid %d)\n", hipGetErrorString(e), grid_blocks);
}
```

```cpp
#include <hip/hip_runtime.h>
#include <hip/hip_cooperative_groups.h>
#include <cstdio>
namespace cg = cooperative_groups;

#define LAS __attribute__((address_space(3)))
typedef unsigned short bf16_t;
typedef short bf16x8 __attribute__((ext_vector_type(8)));
typedef float f32x4 __attribute__((ext_vector_type(4)));
typedef unsigned u32x4 __attribute__((ext_vector_type(4)));
typedef unsigned u32x2 __attribute__((ext_vector_type(2)));

constexpr int MTOK = 65536, DM = 1024, SEQ = 4096;
constexpr float EPS = 1e-6f;
constexpr int LDS_BYTES = 155648;
#define DBG_REP_EVEN 1
#define DBG_REP_ODD 1
#define DBG_REP_FFNIN 1
#define DBG_REP_P0 1
#define DBG_EPI2 0
#define DBG_EXTRA_SYNCS 0
#define USE_LOCAL_BAR 1
#define DBG_SKIP_EVEN 0
#define DBG_SKIP_LRU 0
#define DBG_SKIP_HGRN 0
#define DBG_SKIP_ODD 0
constexpr int NTHR = 512;

constexpr size_t MiB = 1u << 20;
constexpr size_t WS_WT = 0;
constexpr size_t WS_SMALL = 90 * MiB;
constexpr size_t WS_BAR = 91 * MiB;
constexpr size_t WS_ROWSS = 92 * MiB;
constexpr size_t WS_LRUC = 96 * MiB;
constexpr size_t WS_HGG = 98 * MiB;
constexpr size_t WS_HB = 100 * MiB;
constexpr size_t WS_Y = 228 * MiB;
constexpr size_t WS_BIG = 356 * MiB;
constexpr size_t WS_ST = 868 * MiB;
constexpr size_t OFF_INE = 0, OFF_OUTE = 6291456, OFF_INO = 8388608, OFF_OUTO = 11534336, OFF_FIN = 13631488, OFF_FOUT = 30408704;
constexpr size_t SM_WAT = 0, SM_WXT = 256 * 1024, SM_SGUW = 512 * 1024, SM_PWT = 768 * 1024;

struct Params { const float* in[23]; float* out; unsigned char* ws; };

typedef float f32x2_ __attribute__((ext_vector_type(2)));
typedef __bf16 bf16x2_ __attribute__((ext_vector_type(2)));
__device__ __forceinline__ unsigned cvt_pk_bf16(float lo, float hi) { f32x2_ v = {lo, hi}; bf16x2_ r = __builtin_convertvector(v, bf16x2_); return __builtin_bit_cast(unsigned, r); }
__device__ __forceinline__ float bf_lo(unsigned w) { return __uint_as_float(w << 16); }
__device__ __forceinline__ float bf_hi(unsigned w) { return __uint_as_float(w & 0xffff0000u); }
__device__ __forceinline__ float bf2f(bf16_t b) { return __uint_as_float(((unsigned)b) << 16); }
__device__ __forceinline__ bf16_t f2bf(float f) { return (bf16_t)(cvt_pk_bf16(f, 0.f) & 0xffffu); }
__device__ __forceinline__ float rcp_(float x) { return __builtin_amdgcn_rcpf(x); }
__device__ __forceinline__ float sigmoid_(float x) { return rcp_(1.0f + __expf(-x)); }
__device__ __forceinline__ float gelu_tanh(float x) { const float u = 0.7978845608f * (x + 0.044715f * x * x * x); return x * rcp_(1.0f + __expf(-2.0f * u)); }
__device__ __forceinline__ float silu_(float x) { return x * rcp_(1.0f + __expf(-x)); }
__device__ __forceinline__ size_t tiled(size_t row, int col, int K) { return ((row >> 8) * (size_t)K + (size_t)(col >> 6) * 64) * 256 + ((row & 255) << 6) + (size_t)(col & 63); }
__device__ __forceinline__ size_t proj_off(size_t row, int ldc) { return (row >> 13) * (size_t)33554432 + (row & 8191) * (size_t)ldc; }
#define LDS_WAIT() asm volatile("s_waitcnt lgkmcnt(0)" ::: "memory")

namespace pg8 {
constexpr int BM = 256, BK = 64, HALF = 128, HTB = HALF * BK * 2, STAGE_BYTES = 8 * HTB, NXCD = 8, WGM = 4;
__host__ __device__ __forceinline__ int lds_byte(int r, int c) { const int st = (r >> 4) * 2 + (c >> 5), rr = r & 15, cc = c & 31, ob = rr * 64 + cc * 2; return st * 1024 + (ob ^ (((ob >> 9) & 1) << 5)); }
__host__ __device__ __forceinline__ void stage_rc(int b, int& R, int& C) { const int st = b / 1024, sb = b % 1024, swz = sb ^ (((sb >> 9) & 1) << 5); R = (st >> 1) * 16 + swz / 64; C = (st & 1) * 32 + (swz % 64) / 2; }
__host__ __device__ __forceinline__ int perm32(int rho) { const int n = rho >> 4, i = rho & 15; return 8 * (i >> 2) + 4 * n + (i & 3); }
struct Unit { int pm, pn; };
struct Gemm { const bf16_t* A; const bf16_t* Bt; int M, N, K; };
struct StaticOrder {
    int nM, nN, nwg, G, c, rev;
    __device__ void init(int M, int N, int G_, int c_, int rev_ = 0) { nM = M / BM; nN = N / BM; nwg = nM * nN; G = G_; c = c_; rev = rev_; }
    __device__ bool next(int i, Unit& u) const {
        const int nround = (nwg + G - 1) / G; if (i >= nround) return false;
        const long L = (long)(rev ? (nround - 1 - i) : i) * G + c; if (L >= nwg) return false;
        int wgid = (int)L; { const int q = nwg / NXCD, r = nwg % NXCD, xcd = wgid % NXCD, off = wgid / NXCD; wgid = (xcd < r ? xcd * (q + 1) : r * (q + 1) + (xcd - r) * q) + off; }
        const int nig = WGM * nN, gid = wgid / nig, fm = gid * WGM, gsz = (nM - fm) < WGM ? (nM - fm) : WGM;
        u.pm = fm + ((wgid % nig) % gsz); u.pn = (wgid % nig) / gsz; return true;
    }
};

template <int ACT> struct EpiIn {
    static constexpr bool PERM = true, PRE = true;
    bf16_t* O; int ldc; const float* rowss;
    __device__ __forceinline__ void operator()(const f32x4 (&acc)[2][2][4][2], const Unit& u, int wr, int wc, int fr, int fq, const LAS float* RS) const {
        const int row0 = u.pm * BM + wr * 64 + fr, col0 = u.pn * BM + wc * 32 + 8 * fq;
        const bool do_gelu = (ACT == 1) && (u.pn < 4);
        float rs[8];
#pragma unroll
        for (int i = 0; i < 8; ++i) rs[i] = RS[(i >> 2) * HALF + wr * 64 + (i & 3) * 16 + fr];
#pragma unroll
        for (int ai = 0; ai < 2; ++ai)
#pragma unroll
            for (int m = 0; m < 4; ++m) {
                const int row = row0 + ai * HALF + m * 16;
                const float rstd = rs[ai * 4 + m];
                bf16_t* rowp = (ACT == 2) ? O + tiled((size_t)row, col0, ldc) : O + proj_off((size_t)row, ldc) + col0;
#pragma unroll
                for (int bj = 0; bj < 2; ++bj) {
                    f32x4 v0 = acc[ai][bj][m][0] * rstd, v1 = acc[ai][bj][m][1] * rstd;
                    if (ACT == 1) { if (do_gelu) {
#pragma unroll
                        for (int q = 0; q < 4; ++q) { v0[q] = gelu_tanh(v0[q]); v1[q] = gelu_tanh(v1[q]); } } }
                    if (ACT == 2) {
#pragma unroll
                        for (int q = 0; q < 4; ++q) { const float a = fmaxf(v0[q], 0.f), b = fmaxf(v1[q], 0.f); v0[q] = a * a; v1[q] = b * b; } }
                    u32x4 w; w.x = cvt_pk_bf16(v0[0], v0[1]); w.y = cvt_pk_bf16(v0[2], v0[3]); w.z = cvt_pk_bf16(v1[0], v1[1]); w.w = cvt_pk_bf16(v1[2], v1[3]);
                    *(u32x4*)(rowp + bj * ((ACT == 2) ? HALF * 256 : HALF)) = w;
                }
            }
    }
};
struct EpiRes {
    static constexpr bool PERM = true, PRE = false;
    const float* res; float* H; bf16_t* HB; float* rowss;
    __device__ __forceinline__ void operator()(const f32x4 (&acc)[2][2][4][2], const Unit& u, int wr, int wc, int fr, int fq, const LAS float*) const {
        const int row0 = u.pm * BM + wr * 64 + fr, col0 = u.pn * BM + wc * 32 + 8 * fq;
#pragma unroll
        for (int ai = 0; ai < 2; ++ai) {
            f32x4 r[4][4];
#pragma unroll
            for (int m = 0; m < 4; ++m) {
                const size_t off = (size_t)(row0 + ai * HALF + m * 16) * DM + col0;
#pragma unroll
                for (int q = 0; q < 4; ++q) r[m][q] = *(const f32x4*)(res + off + (q >> 1) * HALF + (q & 1) * 4);
            }
#pragma unroll
            for (int m = 0; m < 4; ++m) {
                const int row = row0 + ai * HALF + m * 16;
                const size_t off = (size_t)row * DM + col0;
                float ss = 0.f;
#pragma unroll
                for (int bj = 0; bj < 2; ++bj) {
                    const f32x4 v0 = r[m][bj * 2] + acc[ai][bj][m][0], v1 = r[m][bj * 2 + 1] + acc[ai][bj][m][1];
                    *(f32x4*)(H + off + bj * HALF) = v0; *(f32x4*)(H + off + bj * HALF + 4) = v1;
                    ss += ((v0[0] * v0[0] + v0[1] * v0[1]) + (v0[2] * v0[2] + v0[3] * v0[3])) + ((v1[0] * v1[0] + v1[1] * v1[1]) + (v1[2] * v1[2] + v1[3] * v1[3]));
                    u32x4 w; w.x = cvt_pk_bf16(v0[0], v0[1]); w.y = cvt_pk_bf16(v0[2], v0[3]); w.z = cvt_pk_bf16(v1[0], v1[1]); w.w = cvt_pk_bf16(v1[2], v1[3]);
                    *(u32x4*)(HB + tiled((size_t)row, col0 + bj * HALF, DM)) = w;
                }
                ss += __shfl_xor(ss, 16); ss += __shfl_xor(ss, 32);
                if (fq == 0) rowss[(size_t)row * 16 + u.pn * 4 + wc] = ss;
            }
        }
    }
};

template <class Epi, class Sched>
__device__ __forceinline__ void gemm_phase(LAS unsigned char* lds, const Gemm g, const Sched& S, const Epi& E) {
    int tid = threadIdx.x; asm volatile("" : "+v"(tid));
    const int wid = __builtin_amdgcn_readfirstlane(tid >> 6), lane = tid & 63, wr = wid >> 2, wc = wid & 3, fr = lane & 15, fq = lane >> 4;
    const int K = g.K, nt = K / BK;
    unsigned voffA[2], voffB[2];
#pragma unroll
    for (int i = 0; i < 2; ++i) { int R, C; stage_rc(tid * 16 + i * 8192, R, C); const int Rb = Epi::PERM ? ((R & ~31) + perm32(R & 31)) : R;
        voffA[i] = (unsigned)(R * BK + C) * 2u; voffB[i] = (unsigned)(Rb * K + C) * 2u; }
    const size_t kstep = (size_t)(BK * 2);
    const size_t hstep = (size_t)HALF * K * 2;
    const size_t tstep = 2 * hstep;
    const size_t kstepA = (size_t)BM * BK * 2, hstepA = (size_t)HALF * BK * 2;
    const unsigned ldsw = (unsigned)wid * 1024u;
    const int aoff = lds_byte(wr * 64 + fr, fq * 8), boff = lds_byte(wc * 32 + fr, fq * 8);
    LAS float* RS = (LAS float*)(lds + STAGE_BYTES);
#define PG8_SA(b, h) (((b) * 2 + (h)) * HTB)
#define PG8_SB(b, h) ((4 + (b) * 2 + (h)) * HTB)
#define PG8_STAGE(bufoff, gbase, voff) do { _Pragma("unroll") for (int _i = 0; _i < 2; ++_i) \
        __builtin_amdgcn_global_load_lds((const unsigned*)((const char*)(gbase) + (voff)[_i]), (LAS unsigned*)(lds + (bufoff) + ldsw + _i * 8192), 16, 0, 0); } while (0)
#define PG8_LDA(dst, b, h) do { _Pragma("unroll") for (int m = 0; m < 4; ++m) _Pragma("unroll") for (int k = 0; k < 2; ++k) dst[m][k] = *(const LAS bf16x8*)(lds + PG8_SA(b, h) + aoff + m * 2048 + k * 1024); } while (0)
#define PG8_LDB(dst, b, h) do { _Pragma("unroll") for (int n = 0; n < 2; ++n) _Pragma("unroll") for (int k = 0; k < 2; ++k) dst[n][k] = *(const LAS bf16x8*)(lds + PG8_SB(b, h) + boff + n * 2048 + k * 1024); } while (0)
#define PG8_MMA(ai, bj, At, Bt) do { __builtin_amdgcn_s_setprio(1); _Pragma("unroll") for (int m = 0; m < 4; ++m) _Pragma("unroll") for (int n = 0; n < 2; ++n) _Pragma("unroll") for (int k = 0; k < 2; ++k) \
        acc[ai][bj][m][n] = __builtin_amdgcn_mfma_f32_16x16x32_bf16(Bt[n][k], At[m][k], acc[ai][bj][m][n], 0, 0, 0); __builtin_amdgcn_s_setprio(0); } while (0)
#define PG8_WAIT_V(n) asm volatile("s_waitcnt vmcnt(" #n ")" ::: "memory")
#define PG8_WAIT_L(n) asm volatile("s_waitcnt lgkmcnt(" #n ")" ::: "memory")
#define PG8_BAR __builtin_amdgcn_s_barrier()
#define PG8_SCHED __builtin_amdgcn_sched_barrier(0)
    Unit cur, nxt; int ui = 0;
    if (!S.next(0, cur)) return;
    f32x4 acc[2][2][4][2];
#pragma unroll
    for (int a = 0; a < 2; ++a)
#pragma unroll
        for (int b = 0; b < 2; ++b)
#pragma unroll
            for (int m = 0; m < 4; ++m)
#pragma unroll
                for (int n = 0; n < 2; ++n) acc[a][b][m][n] = (f32x4){0.f, 0.f, 0.f, 0.f};
    bf16x8 At[4][2], B0[2][2], B1[2][2];
    const char* cA = (const char*)g.A + (size_t)cur.pm * tstep; const char* cB = (const char*)g.Bt + (size_t)cur.pn * tstep;
    PG8_STAGE(PG8_SB(0, 0), cB, voffB); PG8_STAGE(PG8_SA(0, 0), cA, voffA); PG8_STAGE(PG8_SB(0, 1), cB + hstep, voffB); PG8_STAGE(PG8_SA(0, 1), cA + hstepA, voffA);
    if (wr == 1) PG8_BAR;
    PG8_WAIT_V(4); PG8_BAR;
    PG8_STAGE(PG8_SB(1, 0), cB + kstep, voffB); PG8_STAGE(PG8_SA(1, 0), cA + kstepA, voffA); PG8_STAGE(PG8_SB(1, 1), cB + hstep + kstep, voffB);
    PG8_WAIT_V(6); PG8_BAR;
    for (;;) {
        const bool has_next = S.next(ui + 1, nxt);
        const char* nA = has_next ? (const char*)g.A + (size_t)nxt.pm * tstep : cA; const char* nB = has_next ? (const char*)g.Bt + (size_t)nxt.pn * tstep : cB;
        for (int t = 0; t < nt; t += 2) {
            const bool last = (t == nt - 2);
            const char* a1 = cA + (size_t)(t + 1) * kstepA;
            const char* a2 = last ? nA : cA + (size_t)(t + 2) * kstepA; const char* b2 = last ? nB : cB + (size_t)(t + 2) * kstep;
            const char* a3 = a2 + kstepA; const char* b3 = b2 + kstep;
            f32x4 rsA;
            if constexpr (Epi::PRE) { if (t <= 2) { const float* rp = E.rowss + (size_t)(cur.pm * BM + (t >> 1) * HALF + (tid >> 2)) * 16 + (tid & 3) * 4;
                asm volatile("global_load_dwordx4 %0, %1, off" : "=&v"(rsA) : "v"(rp) : "memory"); } }
            PG8_LDB(B0, 0, 0); PG8_SCHED; PG8_LDA(At, 0, 0); PG8_STAGE(PG8_SA(1, 1), a1 + hstepA, voffA);
            PG8_WAIT_L(8); PG8_BAR; PG8_WAIT_L(0); PG8_MMA(0, 0, At, B0); PG8_BAR; PG8_SCHED;
            PG8_LDB(B1, 0, 1); PG8_STAGE(PG8_SB(0, 0), b2, voffB);
            PG8_BAR; PG8_WAIT_L(0); PG8_MMA(0, 1, At, B1); PG8_BAR;
            PG8_LDA(At, 0, 1); PG8_STAGE(PG8_SA(0, 0), a2, voffA);
            PG8_BAR; PG8_WAIT_L(0); PG8_MMA(1, 0, At, B0); PG8_BAR; PG8_SCHED;
            PG8_STAGE(PG8_SB(0, 1), b2 + hstep, voffB);
            PG8_WAIT_V(6); PG8_BAR; PG8_MMA(1, 1, At, B1); PG8_BAR;
            if constexpr (Epi::PRE) { if (t <= 2) { asm volatile("s_waitcnt vmcnt(8)" : "+v"(rsA) :: "memory"); float sq = (rsA[0] + rsA[1]) + (rsA[2] + rsA[3]); sq += __shfl_xor(sq, 1); sq += __shfl_xor(sq, 2);
                if (!(tid & 3)) RS[(t >> 1) * HALF + (tid >> 2)] = rsqrtf(sq * (1.0f / 1024.0f) + EPS); } }
            PG8_LDB(B0, 1, 0); PG8_SCHED; PG8_LDA(At, 1, 0); PG8_STAGE(PG8_SA(0, 1), a2 + hstepA, voffA);
            PG8_WAIT_L(8); PG8_BAR; PG8_WAIT_L(0); PG8_MMA(0, 0, At, B0); PG8_BAR; PG8_SCHED;
            PG8_LDB(B1, 1, 1); PG8_STAGE(PG8_SB(1, 0), b3, voffB);
            PG8_BAR; PG8_WAIT_L(0); PG8_MMA(0, 1, At, B1); PG8_BAR;
            PG8_LDA(At, 1, 1); PG8_STAGE(PG8_SA(1, 0), a3, voffA);
            PG8_BAR; PG8_WAIT_L(0); PG8_MMA(1, 0, At, B0); PG8_BAR; PG8_SCHED;
            PG8_STAGE(PG8_SB(1, 1), b3 + hstep, voffB);
            PG8_WAIT_V(6); PG8_BAR; PG8_MMA(1, 1, At, B1); PG8_BAR;
        }
        E(acc, cur, wr, wc, fr, fq, RS);
        if (!has_next) break;
#pragma unroll
        for (int a = 0; a < 2; ++a)
#pragma unroll
            for (int b = 0; b < 2; ++b)
#pragma unroll
                for (int m = 0; m < 4; ++m)
#pragma unroll
                    for (int n = 0; n < 2; ++n) acc[a][b][m][n] = (f32x4){0.f, 0.f, 0.f, 0.f};
        cur = nxt; cA = nA; cB = nB; ++ui;
    }
    PG8_WAIT_V(0);
    if (wr == 0) PG8_BAR;
    PG8_BAR;
#undef PG8_SA
#undef PG8_SB
#undef PG8_STAGE
#undef PG8_LDA
#undef PG8_LDB
#undef PG8_MMA
#undef PG8_WAIT_V
#undef PG8_WAIT_L
#undef PG8_BAR
#undef PG8_SCHED
}
}

__device__ __forceinline__ void transpose_item(const float* W, int K, int N, bf16_t* WT, const float* kscale, LAS float* scr, int item, int lane) {
    const int nblk = N / 32, kb = item / nblk, nb = item % nblk, k0 = 64 * kb, n0 = 32 * nb;
    float wv[32];
#pragma unroll
    for (int i = 0; i < 32; ++i) wv[i] = W[(size_t)(k0 + 2 * i + (lane >> 5)) * N + n0 + (lane & 31)];
#pragma unroll
    for (int i = 0; i < 32; ++i) { const int kk = 2 * i + (lane >> 5); const float s = kscale ? kscale[k0 + kk] : 1.0f; scr[kk * 33 + (lane & 31)] = wv[i] * s; }
    LDS_WAIT();
    const int c = lane & 7;
#pragma unroll
    for (int j = 0; j < 4; ++j) { const int n = (lane >> 3) + 8 * j; const LAS float* s = scr + (8 * c) * 33 + n;
        u32x4 o; o.x = cvt_pk_bf16(s[0 * 33], s[1 * 33]); o.y = cvt_pk_bf16(s[2 * 33], s[3 * 33]); o.z = cvt_pk_bf16(s[4 * 33], s[5 * 33]); o.w = cvt_pk_bf16(s[6 * 33], s[7 * 33]);
        *(u32x4*)(WT + (size_t)(n0 + n) * K + k0 + 8 * c) = o; }
    LDS_WAIT();
}

__device__ __forceinline__ void phase0(LAS unsigned char* lds, const Params& p) {
    int tid = threadIdx.x; asm volatile("" : "+v"(tid));
    const int lane = tid & 63, wave = tid >> 6;
    const int gw = blockIdx.x * 8 + wave, NGW = gridDim.x * 8;
    LAS float* scr = (LAS float*)(lds + wave * 8704);
    bf16_t* WTb = (bf16_t*)(p.ws + WS_WT);
#pragma unroll 1
    for (int mat = 0; mat < 16; ++mat) {
        const float* W; int K, N; bf16_t* WT; const float* ks = nullptr;
        if (mat < 2)       { W = p.in[3] + (size_t)mat * 1024 * 3072; K = 1024; N = 3072; WT = WTb + OFF_INE + (size_t)mat * 3145728; ks = p.in[1] + (2 * mat) * 1024; }
        else if (mat < 4)  { const int j = mat - 2; W = p.in[13] + (size_t)j * 1048576; K = 1024; N = 1024; WT = WTb + OFF_OUTE + (size_t)j * 1048576; }
        else if (mat < 6)  { const int j = mat - 4; W = p.in[14] + (size_t)j * 1024 * 1536; K = 1024; N = 1536; WT = WTb + OFF_INO + (size_t)j * 1572864; ks = p.in[1] + (2 * j + 1) * 1024; }
        else if (mat < 8)  { const int j = mat - 6; W = p.in[19] + (size_t)j * 1048576; K = 1024; N = 1024; WT = WTb + OFF_OUTO + (size_t)j * 1048576; }
        else if (mat < 12) { const int l = mat - 8; W = p.in[20] + (size_t)l * 4194304; K = 1024; N = 4096; WT = WTb + OFF_FIN + (size_t)l * 4194304; ks = p.in[2] + l * 1024; }
        else               { const int l = mat - 12; W = p.in[21] + (size_t)l * 4194304; K = 4096; N = 1024; WT = WTb + OFF_FOUT + (size_t)l * 4194304; }
        const int nitems = (K / 64) * (N / 32);
        for (int it = gw; it < nitems; it += NGW) transpose_item(W, K, N, WT, ks, scr, it, lane);
    }
    {
        const size_t gtid = (size_t)blockIdx.x * NTHR + tid, gsz = (size_t)gridDim.x * NTHR;
        bf16_t* WaT = (bf16_t*)(p.ws + WS_SMALL + SM_WAT); bf16_t* WxT = (bf16_t*)(p.ws + WS_SMALL + SM_WXT);
        bf16_t* SW = (bf16_t*)(p.ws + WS_SMALL + SM_SGUW); bf16_t* PWT = (bf16_t*)(p.ws + WS_SMALL + SM_PWT);
        for (size_t i = gtid; i < 131072; i += gsz) {
            const int ii = i & 63, jo = (i >> 6) & 63; const size_t lh = i >> 12;
            if (i < 65536) { WaT[i] = f2bf(p.in[6][lh * 4096 + ii * 64 + jo]);
            WxT[i] = f2bf(p.in[8][lh * 4096 + ii * 64 + jo]); }
            const int s = i & 127, t = (i >> 7) & 127;
            SW[i] = f2bf(s <= t ? p.in[15][i] : 0.f);
            const int c = i & 127, d = (i >> 7) & 127; const size_t lg = i >> 14; const size_t l = lg >> 2, gi = lg & 3;
            PWT[i] = f2bf(p.in[17][lg * 16384 + c * 128 + d] * p.in[18][l * 512 + gi * 128 + d]);
        }
    }
    {
        const float* x = p.in[0]; bf16_t* HB = (bf16_t*)(p.ws + WS_HB); float* rowss = (float*)(p.ws + WS_ROWSS);
        for (int row = gw; row < MTOK; row += 2 * NGW) {
            const int row2 = row + NGW;
            const f32x4* xr = (const f32x4*)(x + (size_t)row * DM) + lane;
            const f32x4* xr2 = (const f32x4*)(x + (size_t)row2 * DM) + lane;
            f32x4 v[4], v2[4]; float s = 0.f, s2 = 0.f;
#pragma unroll
            for (int j = 0; j < 4; ++j) { v[j] = xr[64 * j]; v2[j] = xr2[64 * j]; }
#pragma unroll
            for (int j = 0; j < 4; ++j) { s += (v[j][0] * v[j][0] + v[j][1] * v[j][1]) + (v[j][2] * v[j][2] + v[j][3] * v[j][3]); s2 += (v2[j][0] * v2[j][0] + v2[j][1] * v2[j][1]) + (v2[j][2] * v2[j][2] + v2[j][3] * v2[j][3]); }
#pragma unroll
            for (int o = 1; o < 64; o <<= 1) { s += __shfl_xor(s, o); s2 += __shfl_xor(s2, o); }
            u32x2* o8 = (u32x2*)(HB + tiled((size_t)row, 4 * lane, DM)); u32x2* o82 = (u32x2*)(HB + tiled((size_t)row2, 4 * lane, DM));
#pragma unroll
            for (int j = 0; j < 4; ++j) { u32x2 w; w.x = cvt_pk_bf16(v[j][0], v[j][1]); w.y = cvt_pk_bf16(v[j][2], v[j][3]); o8[16384 * j] = w;
                u32x2 w2; w2.x = cvt_pk_bf16(v2[j][0], v2[j][1]); w2.y = cvt_pk_bf16(v2[j][2], v2[j][3]); o82[16384 * j] = w2; }
            if (lane < 16) { rowss[(size_t)row * 16 + lane] = (lane == 0) ? s : 0.f; rowss[(size_t)row2 * 16 + lane] = (lane == 0) ? s2 : 0.f; }
        }
    }
}

template <int PASS>
__device__ __forceinline__ void lru_pass(LAS unsigned char* lds, const Params& p, int j, int item) {
    int tid = threadIdx.x; asm volatile("" : "+v"(tid));
    const int lane = tid & 63, w = __builtin_amdgcn_readfirstlane(tid >> 6), fr = lane & 15, fq = lane >> 4;
    const int b = item >> 4, seg = item & 15;
    const bf16_t* PROJ = (const bf16_t*)(p.ws + WS_BIG);
    bf16_t* Y = (bf16_t*)(p.ws + WS_Y);
    float* Pbuf = (float*)(p.ws + WS_LRUC); float* Hbuf = Pbuf + 256 * 512;
    LAS bf16_t* U = (LAS bf16_t*)lds;
    LAS bf16_t* HS = (LAS bf16_t*)(lds + 66560);
    const bf16_t* WaT = (const bf16_t*)(p.ws + WS_SMALL + SM_WAT) + (size_t)(j * 8 + w) * 4096;
    const bf16_t* WxT = (const bf16_t*)(p.ws + WS_SMALL + SM_WXT) + (size_t)(j * 8 + w) * 4096;
    bf16x8 Ba[4][2], Bx[4][2];
#pragma unroll
    for (int n = 0; n < 4; ++n)
#pragma unroll
        for (int kk = 0; kk < 2; ++kk) { Ba[n][kk] = *(const bf16x8*)(WaT + (n * 16 + fr) * 64 + kk * 32 + fq * 8); Bx[n][kk] = *(const bf16x8*)(WxT + (n * 16 + fr) * 64 + kk * 32 + fq * 8); }
    float ba[4], bx[4], sp[4], h[4], P[4];
#pragma unroll
    for (int n = 0; n < 4; ++n) {
        const int c = w * 64 + n * 16 + fr;
        ba[n] = p.in[7][j * 512 + c]; bx[n] = p.in[9][j * 512 + c];
        const float lam = p.in[10][j * 512 + c];
        sp[n] = 8.0f * 1.44269504f * log1pf(__expf(-lam));
        float hh = 0.f;
        if (PASS == 2) { for (int s = 0; s < seg; ++s) hh = Pbuf[(size_t)(b * 16 + s) * 512 + c] * hh + Hbuf[(size_t)(b * 16 + s) * 512 + c]; }
        h[n] = hh; P[n] = 1.0f;
    }
    const int c8 = (tid & 63) * 8, tg = tid >> 6;
#pragma unroll 1
    for (int sub = 0; sub < 4; ++sub) {
        const int t0 = seg * 256 + sub * 64;
        const size_t rowbase = (size_t)b * SEQ + t0;
        {
            float cw[4][8], cb[8];
#pragma unroll
            for (int k = 0; k < 4; ++k) { const f32x4 a = *(const f32x4*)(p.in[4] + (size_t)(j * 4 + k) * 512 + c8), bq = *(const f32x4*)(p.in[4] + (size_t)(j * 4 + k) * 512 + c8 + 4);
#pragma unroll
                for (int q = 0; q < 4; ++q) { cw[k][q] = a[q]; cw[k][4 + q] = bq[q]; } }
            { const f32x4 a = *(const f32x4*)(p.in[5] + j * 512 + c8), bq = *(const f32x4*)(p.in[5] + j * 512 + c8 + 4);
#pragma unroll
                for (int q = 0; q < 4; ++q) { cb[q] = a[q]; cb[4 + q] = bq[q]; } }
            u32x4 xw[4];
#pragma unroll
            for (int k = 0; k < 3; ++k) { const int tl = tg * 8 - 3 + k; xw[k] = (t0 + tl >= 0) ? *(const u32x4*)(PROJ + proj_off(rowbase + tl, 3072) + c8) : (u32x4){0u, 0u, 0u, 0u}; }
#pragma unroll
            for (int i = 0; i < 8; ++i) {
                const int tl = tg * 8 + i;
                xw[3] = *(const u32x4*)(PROJ + proj_off(rowbase + tl, 3072) + c8);
                float uo[8];
#pragma unroll
                for (int q = 0; q < 4; ++q) {
                    float lo = cb[2 * q], hi = cb[2 * q + 1];
#pragma unroll
                    for (int k = 0; k < 4; ++k) { lo += cw[k][2 * q] * bf_lo(xw[k][q]); hi += cw[k][2 * q + 1] * bf_hi(xw[k][q]); }
                    uo[2 * q] = lo; uo[2 * q + 1] = hi;
                }
                u32x4 o; o.x = cvt_pk_bf16(uo[0], uo[1]); o.y = cvt_pk_bf16(uo[2], uo[3]); o.z = cvt_pk_bf16(uo[4], uo[5]); o.w = cvt_pk_bf16(uo[6], uo[7]);
                *(LAS u32x4*)(U + tl * 520 + c8) = o;
                xw[0] = xw[1]; xw[1] = xw[2]; xw[2] = xw[3];
            }
        }
        __syncthreads();
#pragma unroll 1
        for (int tt = 0; tt < 4; ++tt) {
            bf16x8 a0 = *(const LAS bf16x8*)(U + (tt * 16 + fr) * 520 + w * 64 + fq * 8);
            bf16x8 a1 = *(const LAS bf16x8*)(U + (tt * 16 + fr) * 520 + w * 64 + 32 + fq * 8);
#pragma unroll
            for (int n = 0; n < 4; ++n) {
                f32x4 ar = (f32x4){ba[n], ba[n], ba[n], ba[n]}, ai = (f32x4){bx[n], bx[n], bx[n], bx[n]};
                ar = __builtin_amdgcn_mfma_f32_16x16x32_bf16(a0, Ba[n][0], ar, 0, 0, 0); ar = __builtin_amdgcn_mfma_f32_16x16x32_bf16(a1, Ba[n][1], ar, 0, 0, 0);
                ai = __builtin_amdgcn_mfma_f32_16x16x32_bf16(a0, Bx[n][0], ai, 0, 0, 0); ai = __builtin_amdgcn_mfma_f32_16x16x32_bf16(a1, Bx[n][1], ai, 0, 0, 0);
                const int c = w * 64 + n * 16 + fr;
                float av[4], bv[4];
#pragma unroll
                for (int jj = 0; jj < 4; ++jj) {
                    const int t = tt * 16 + fq * 4 + jj;
                    const float u = bf2f(U[t * 520 + c]);
                    const float r = sigmoid_(ar[jj]), ig = sigmoid_(ai[jj]);
                    const float a = __builtin_amdgcn_exp2f(-r * sp[n]);
                    const float beta = __builtin_amdgcn_sqrtf(fmaxf(1.0f - a * a, 0.f));
                    av[jj] = a; bv[jj] = beta * ig * u;
                }
                const float A4 = (av[0] * av[1]) * (av[2] * av[3]);
                const float B4 = ((bv[0] * av[1] + bv[1]) * av[2] + bv[2]) * av[3] + bv[3];
                float hs = h[n];
#pragma unroll
                for (int g = 0; g < 4; ++g) {
                    const float he = A4 * hs + B4;
                    const float nx = __shfl(he, fr + 16 * g);
                    if (fq > g) hs = nx;
                    if (g == 3) h[n] = nx;
                }
                if (PASS == 1) { float pp = A4; pp *= __shfl_xor(pp, 16); pp *= __shfl_xor(pp, 32); P[n] *= pp; }
                if (PASS == 2) {
                    float xh = hs;
#pragma unroll
                    for (int jj = 0; jj < 4; ++jj) { xh = av[jj] * xh + bv[jj]; HS[(tt * 16 + fq * 4 + jj) * 520 + c] = f2bf(xh); }
                }
            }
        }
        if (PASS == 2) {
            __syncthreads();
#pragma unroll 2
            for (int i = 0; i < 8; ++i) {
                const int tl = tg * 8 + i;
                const u32x4 hv = *(const LAS u32x4*)(HS + tl * 520 + c8);
                const u32x4 gv = *(const u32x4*)(PROJ + proj_off(rowbase + tl, 3072) + 512 + c8);
                u32x4 o;
#pragma unroll
                for (int q = 0; q < 4; ++q) o[q] = cvt_pk_bf16(bf_lo(hv[q]) * gelu_tanh(bf_lo(gv[q])), bf_hi(hv[q]) * gelu_tanh(bf_hi(gv[q])));
                *(u32x4*)(Y + tiled(rowbase + tl, c8, 1024)) = o;
            }
        }
        __syncthreads();
    }
    if (PASS == 1) {
        if (fq == 0) {
#pragma unroll
            for (int n = 0; n < 4; ++n) { const int c = w * 64 + n * 16 + fr; Pbuf[(size_t)item * 512 + c] = P[n]; Hbuf[(size_t)item * 512 + c] = h[n]; }
        }
    }
}


__device__ __forceinline__ void hgrn_bcum2(LAS float* BC, LAS float* PT, const u32x4 (&zv)[2], const float (&lb)[8], int tid, float (&kout)[2][8]) {
    {
        const int d8 = (tid & 15) * 8, t = tid >> 4;
#pragma unroll
        for (int rr = 0; rr < 2; ++rr) {
            const int tr = t + rr * 32;
            float lf[8];
#pragma unroll
            for (int q = 0; q < 4; ++q) {
                const float z0 = bf_lo(zv[rr][q]), z1 = bf_hi(zv[rr][q]);
                const float k0 = (1.0f - lb[2 * q]) * sigmoid_(-z0), k1 = (1.0f - lb[2 * q + 1]) * sigmoid_(-z1);
                kout[rr][2 * q] = k0; kout[rr][2 * q + 1] = k1;
                lf[2 * q] = __logf(fmaxf(1.0f - k0, 1e-20f));
                lf[2 * q + 1] = __logf(fmaxf(1.0f - k1, 1e-20f));
            }
            *(LAS f32x4*)(BC + tr * 128 + d8) = (f32x4){lf[0], lf[1], lf[2], lf[3]};
            *(LAS f32x4*)(BC + tr * 128 + d8 + 4) = (f32x4){lf[4], lf[5], lf[6], lf[7]};
        }
    }
    __syncthreads();
    const int d = tid & 127, part = tid >> 7;
    {
        float a = 0.f;
#pragma unroll
        for (int i = 0; i < 16; ++i) { const int t = part * 16 + i; a += BC[t * 128 + d]; BC[t * 128 + d] = a; }
        PT[part * 128 + d] = a;
    }
    __syncthreads();
}
struct HcPre { u32x4 zv[2], vv[2], qv[2], gp[2]; };
template <int PASS>
__device__ __forceinline__ void hgrn2_load(const Params& p, int item, int c, HcPre& r) {
    int tid = threadIdx.x; asm volatile("" : "+v"(tid));
    const int bh = item >> 3, sup = item & 7, b = bh >> 2, h = bh & 3;
    const bf16_t* PROJ = (const bf16_t*)(p.ws + WS_BIG);
    const size_t rowbase = (size_t)b * SEQ + (size_t)(sup * 8 + c) * 64;
    const int d8 = (tid & 15) * 8, t = tid >> 4;
#pragma unroll
    for (int rr = 0; rr < 2; ++rr) {
        r.zv[rr] = *(const u32x4*)(PROJ + proj_off(rowbase + t + rr * 32, 3072) + 1536 + h * 128 + d8);
        r.vv[rr] = *(const u32x4*)(PROJ + proj_off(rowbase + t + rr * 32, 3072) + 2048 + h * 128 + d8);
        if (PASS == 2) r.qv[rr] = *(const u32x4*)(PROJ + proj_off(rowbase + t + rr * 32, 3072) + 1024 + h * 128 + d8);
    }
    if (PASS == 2) {
        const bf16_t* gp = PROJ + proj_off(rowbase + (tid >> 3), 3072) + 2560 + h * 128 + (tid & 7) * 16;
        r.gp[0] = *(const u32x4*)gp; r.gp[1] = *(const u32x4*)(gp + 8);
    }
}
template <int PASS>
__device__ __forceinline__ void hgrn2_init(const Params& p, int item, f32x4 (&S)[8], float (&Gt)[4]) {
    int tid = threadIdx.x; asm volatile("" : "+v"(tid));
    const int lane = tid & 63, w = __builtin_amdgcn_readfirstlane(tid >> 6), fq = lane >> 4;
#pragma unroll
    for (int n = 0; n < 8; ++n) S[n] = (f32x4){0.f, 0.f, 0.f, 0.f};
#pragma unroll
    for (int jj = 0; jj < 4; ++jj) Gt[jj] = 1.0f;
    if (PASS == 2) {
        const int bh = item >> 3, sup = item & 7;
        const float* SUMb = (const float*)(p.ws + WS_ST); const float* GTb = (const float*)(p.ws + WS_HGG);
        for (int s2 = 0; s2 < sup; ++s2) {
            const size_t it2 = (size_t)bh * 8 + s2;
            const f32x4 g4 = *(const f32x4*)(GTb + it2 * 128 + w * 16 + fq * 4);
#pragma unroll
            for (int n = 0; n < 8; ++n) { const f32x4 T = *(const f32x4*)(SUMb + it2 * 16384 + (size_t)((n * 8 + w) * 64 + lane) * 4); S[n] = g4 * S[n] + T; }
        }
    }
}
__device__ __forceinline__ void hgrn2_finish(const Params& p, int item, const f32x4 (&S)[8], const float (&Gt)[4]) {
    int tid = threadIdx.x; asm volatile("" : "+v"(tid));
    const int lane = tid & 63, w = __builtin_amdgcn_readfirstlane(tid >> 6), fr = lane & 15, fq = lane >> 4;
    float* SUMb = (float*)(p.ws + WS_ST); float* GTb = (float*)(p.ws + WS_HGG);
#pragma unroll
    for (int n = 0; n < 8; ++n) *(f32x4*)(SUMb + (size_t)item * 16384 + (size_t)((n * 8 + w) * 64 + lane) * 4) = S[n];
    if (fr == 0) *(f32x4*)(GTb + (size_t)item * 128 + w * 16 + fq * 4) = (f32x4){Gt[0], Gt[1], Gt[2], Gt[3]};
}
template <int PASS>
__device__ __forceinline__ void hgrn2_chunk(LAS unsigned char* lds, const Params& p, int j, int item, int c, const HcPre& pre, f32x4 (&S)[8], float (&Gt)[4]) {
    int tid = threadIdx.x; asm volatile("" : "+v"(tid));
    const int lane = tid & 63, w = __builtin_amdgcn_readfirstlane(tid >> 6), fr = lane & 15, fq = lane >> 4;
    const int bh = item >> 3, sup = item & 7, b = bh >> 2, h = bh & 3;
    bf16_t* Y = (bf16_t*)(p.ws + WS_Y);
    const size_t rowbase = (size_t)b * SEQ + (size_t)(sup * 8 + c) * 64;
    LAS float* BC = (LAS float*)lds;
    LAS bf16_t* QA = (LAS bf16_t*)(lds + 32768);
    LAS bf16_t* KA = (LAS bf16_t*)(lds + 50176);
    LAS bf16_t* VT = (LAS bf16_t*)(lds + 67584);
    LAS bf16_t* SS = (LAS bf16_t*)(lds + 86016);
    LAS bf16_t* AT = (LAS bf16_t*)(lds + 120832);
    LAS float* PT = (LAS float*)(lds + 130048);
    LAS bf16_t* VN = SS;
    const float* lbl = p.in[11];
    const int d8 = (tid & 15) * 8, t = tid >> 4;
    u32x4 zv[2], vv[2], qv[2], gpre[2]; float lb[8];
#pragma unroll
    for (int rr = 0; rr < 2; ++rr) { zv[rr] = pre.zv[rr]; vv[rr] = pre.vv[rr]; if (PASS == 2) { qv[rr] = pre.qv[rr]; gpre[rr] = pre.gp[rr]; } }
#pragma unroll
    for (int q = 0; q < 8; ++q) { const int ch = h * 128 + d8 + q; lb[q] = (j == 0) ? 0.f : sigmoid_(lbl[512 + ch] - lbl[ch]); }
#pragma unroll
    for (int rr = 0; rr < 2; ++rr) *(LAS u32x4*)(VN + (t + rr * 32) * 136 + d8) = vv[rr];
    float kq[2][8];
    hgrn_bcum2(BC, PT, zv, lb, tid, kq);
    {
        float bref[8], c1[8], c2[8], c3[8];
        {
            const f32x4 pa0 = *(const LAS f32x4*)(PT + d8), pa1 = *(const LAS f32x4*)(PT + d8 + 4);
            const f32x4 pb0 = *(const LAS f32x4*)(PT + 128 + d8), pb1 = *(const LAS f32x4*)(PT + 128 + d8 + 4);
            const f32x4 pc0 = *(const LAS f32x4*)(PT + 256 + d8), pc1 = *(const LAS f32x4*)(PT + 256 + d8 + 4);
#pragma unroll
            for (int q = 0; q < 4; ++q) { c1[q] = pa0[q]; c1[4 + q] = pa1[q]; c2[q] = pa0[q] + pb0[q]; c2[4 + q] = pa1[q] + pb1[q]; c3[q] = c2[q] + pc0[q]; c3[4 + q] = c2[4 + q] + pc1[q]; }
        }
        const bool hi16 = (t >> 4) != 0;
#pragma unroll
        for (int q = 0; q < 8; ++q) bref[q] = BC[31 * 128 + d8 + q] + c1[q];
#pragma unroll
        for (int rr = 0; rr < 2; ++rr) {
            const int tr = t + rr * 32;
            float qa[8], ka[8];
#pragma unroll
            for (int q = 0; q < 8; ++q) {
                const float bc = BC[tr * 128 + d8 + q] + (rr == 0 ? (hi16 ? c1[q] : 0.f) : (hi16 ? c3[q] : c2[q]));
                const float dq = fminf(fmaxf(bc - bref[q], -80.f), 80.f);
                const float e1 = __expf(dq);
                if (PASS == 2) { const float qq = silu_((q & 1) ? bf_hi(qv[rr][q >> 1]) : bf_lo(qv[rr][q >> 1])); qa[q] = qq * e1; }
                ka[q] = kq[rr][q] * rcp_(e1);
            }
            u32x4 o;
            if (PASS == 2) {
#pragma unroll
                for (int q = 0; q < 4; ++q) o[q] = cvt_pk_bf16(qa[2 * q], qa[2 * q + 1]);
                *(LAS u32x4*)(QA + tr * 136 + d8) = o;
            }
#pragma unroll
            for (int q = 0; q < 4; ++q) o[q] = cvt_pk_bf16(ka[2 * q], ka[2 * q + 1]);
            *(LAS u32x4*)(KA + tr * 136 + d8) = o;
        }
        {
            const int e = tid & 127, tq = tid >> 7;
            bf16_t vq[16];
#pragma unroll
            for (int i = 0; i < 16; ++i) vq[i] = VN[(tq * 16 + i) * 136 + e];
            u32x4 p0, p1;
#pragma unroll
            for (int q = 0; q < 4; ++q) { p0[q] = (unsigned)vq[2 * q] | ((unsigned)vq[2 * q + 1] << 16); p1[q] = (unsigned)vq[8 + 2 * q] | ((unsigned)vq[8 + 2 * q + 1] << 16); }
            *(LAS u32x4*)(VT + e * 72 + tq * 16) = p0; *(LAS u32x4*)(VT + e * 72 + tq * 16 + 8) = p1;
        }
    }
    float gsc[4], sc[4], eb[4];
#pragma unroll
    for (int jj = 0; jj < 4; ++jj) { const int dd = w * 16 + fq * 4 + jj; const float p0 = PT[dd], br = BC[31 * 128 + dd] + p0, bl = BC[63 * 128 + dd] + ((p0 + PT[128 + dd]) + PT[256 + dd]); gsc[jj] = __expf(bl); sc[jj] = __expf(bl - br); eb[jj] = __expf(br); }
    __syncthreads();
    if (PASS == 2) {
#pragma unroll
        for (int n = 0; n < 8; ++n) { u32x2 o; o.x = cvt_pk_bf16(S[n][0] * eb[0], S[n][1] * eb[1]); o.y = cvt_pk_bf16(S[n][2] * eb[2], S[n][3] * eb[3]);
            *(LAS u32x2*)(SS + (n * 16 + fr) * 136 + w * 16 + fq * 4) = o; }
        {
            const int tt = w >> 1;
#pragma unroll
            for (int si = 0; si < 2; ++si) {
                const int ss = (w & 1) * 2 + si;
                f32x4 acc = (f32x4){0.f, 0.f, 0.f, 0.f};
                if (ss <= tt) {
#pragma unroll
                    for (int kk = 0; kk < 4; ++kk) {
                        const bf16x8 a = *(const LAS bf16x8*)(QA + (tt * 16 + fr) * 136 + kk * 32 + fq * 8);
                        const bf16x8 bb = *(const LAS bf16x8*)(KA + (ss * 16 + fr) * 136 + kk * 32 + fq * 8);
                        acc = __builtin_amdgcn_mfma_f32_16x16x32_bf16(a, bb, acc, 0, 0, 0);
                    }
                }
#pragma unroll
                for (int jj = 0; jj < 4; ++jj) {
                    const int tq2 = tt * 16 + fq * 4 + jj, sq2 = ss * 16 + fr;
                    const float v = (sq2 <= tq2) ? acc[jj] : 0.f;
                    AT[tq2 * 72 + sq2] = f2bf(v);
                }
            }
        }
        __syncthreads();
        {
            const int tt = w >> 1, n0 = (w & 1) * 4;
            f32x4 acc[4];
#pragma unroll
            for (int n = 0; n < 4; ++n) acc[n] = (f32x4){0.f, 0.f, 0.f, 0.f};
#pragma unroll
            for (int kk = 0; kk < 4; ++kk) {
                const bf16x8 a = *(const LAS bf16x8*)(QA + (tt * 16 + fr) * 136 + kk * 32 + fq * 8);
#pragma unroll
                for (int n = 0; n < 4; ++n) { const bf16x8 bb = *(const LAS bf16x8*)(SS + ((n0 + n) * 16 + fr) * 136 + kk * 32 + fq * 8); acc[n] = __builtin_amdgcn_mfma_f32_16x16x32_bf16(a, bb, acc[n], 0, 0, 0); }
            }
#pragma unroll
            for (int kk = 0; kk < 2; ++kk) {
                if (kk * 32 <= tt * 16 + 15) {
                    const bf16x8 a = *(const LAS bf16x8*)(AT + (tt * 16 + fr) * 72 + kk * 32 + fq * 8);
#pragma unroll
                    for (int n = 0; n < 4; ++n) { const bf16x8 bb = *(const LAS bf16x8*)(VT + ((n0 + n) * 16 + fr) * 72 + kk * 32 + fq * 8); acc[n] = __builtin_amdgcn_mfma_f32_16x16x32_bf16(a, bb, acc[n], 0, 0, 0); }
                }
            }
            LAS float* OS = BC;
#pragma unroll
            for (int n = 0; n < 4; ++n)
#pragma unroll
                for (int jj = 0; jj < 4; ++jj) OS[(tt * 16 + fq * 4 + jj) * 128 + (n0 + n) * 16 + fr] = acc[n][jj];
        }
    }
    {
        bf16x8 af[2];
#pragma unroll
        for (int kk = 0; kk < 2; ++kk)
#pragma unroll
            for (int i = 0; i < 8; ++i) af[kk][i] = (short)KA[(kk * 32 + fq * 8 + i) * 136 + w * 16 + fr];
#pragma unroll
        for (int n = 0; n < 8; ++n) {
            f32x4 acc = (f32x4){0.f, 0.f, 0.f, 0.f};
#pragma unroll
            for (int kk = 0; kk < 2; ++kk) { const bf16x8 bb = *(const LAS bf16x8*)(VT + (n * 16 + fr) * 72 + kk * 32 + fq * 8); acc = __builtin_amdgcn_mfma_f32_16x16x32_bf16(af[kk], bb, acc, 0, 0, 0); }
#pragma unroll
            for (int jj = 0; jj < 4; ++jj) S[n][jj] = gsc[jj] * S[n][jj] + sc[jj] * acc[jj];
        }
        if (PASS == 1) {
#pragma unroll
            for (int jj = 0; jj < 4; ++jj) Gt[jj] *= gsc[jj];
        }
    }
    if (PASS == 2) {
        __syncthreads();
        LAS float* OS = BC;
        const int t2 = tid >> 3, e16 = (tid & 7) * 16;
        f32x4 ov[4]; float ss = 0.f;
#pragma unroll
        for (int q = 0; q < 4; ++q) { ov[q] = *(const LAS f32x4*)(OS + t2 * 128 + e16 + q * 4); ss += (ov[q][0] * ov[q][0] + ov[q][1] * ov[q][1]) + (ov[q][2] * ov[q][2] + ov[q][3] * ov[q][3]); }
        ss += __shfl_xor(ss, 1); ss += __shfl_xor(ss, 2); ss += __shfl_xor(ss, 4);
        const float rstd = rsqrtf(ss * (1.0f / 128.0f) + EPS);
        const float* gn = p.in[12] + j * 512 + h * 128 + e16;
        bf16_t* yp = Y + tiled(rowbase + t2, 512 + h * 128 + e16, 1024);
#pragma unroll
        for (int hlf = 0; hlf < 2; ++hlf) {
            const u32x4 gv = gpre[hlf];
            const f32x4 n0v = *(const f32x4*)(gn + hlf * 8), n1v = *(const f32x4*)(gn + hlf * 8 + 4);
            u32x4 o;
#pragma unroll
            for (int q = 0; q < 4; ++q) {
                const float o0 = ov[hlf * 2 + (q >> 1)][(q & 1) * 2], o1 = ov[hlf * 2 + (q >> 1)][(q & 1) * 2 + 1];
                const float g0 = (q < 2) ? n0v[2 * q] : n1v[2 * q - 4], g1 = (q < 2) ? n0v[2 * q + 1] : n1v[2 * q - 3];
                o[q] = cvt_pk_bf16(o0 * rstd * g0 * silu_(bf_lo(gv[q])), o1 * rstd * g1 * silu_(bf_hi(gv[q])));
            }
            *(u32x4*)(yp + hlf * 8) = o;
        }
        __syncthreads();
    }
}
template <int PASS>
__device__ __forceinline__ void hgrn2_run(LAS unsigned char* lds, const Params& p, int j, int bid, int G, int nitems) {
    f32x4 S[8]; float Gt[4]; HcPre nxt;
    const int nsteps = nitems * 8;
    if (nsteps <= 0) return;
    hgrn2_load<PASS>(p, bid, 0, nxt);
#pragma unroll 1
    for (int step = 0; step < nsteps; ++step) {
        const int item = bid + (step >> 3) * G, c = step & 7;
        const HcPre cur = nxt;
        if (step + 1 < nsteps) hgrn2_load<PASS>(p, bid + ((step + 1) >> 3) * G, (step + 1) & 7, nxt);
        if (c == 0) hgrn2_init<PASS>(p, item, S, Gt);
        hgrn2_chunk<PASS>(lds, p, j, item, c, cur, S, Gt);
        if (PASS == 1 && c == 7) hgrn2_finish(p, item, S, Gt);
    }
    __syncthreads();
}

struct SguPre { u32x4 vv[4]; u32x2 uv[8]; };
__device__ __forceinline__ void sgu_load(const Params& p, int item, SguPre& r) {
    int tid = threadIdx.x; asm volatile("" : "+v"(tid));
    const int lane = tid & 63, w = __builtin_amdgcn_readfirstlane(tid >> 6), fr = lane & 15, fq = lane >> 4;
    const int g = item & 3, n = (item >> 2) & 31, b = item >> 7;
    const bf16_t* PROJ = (const bf16_t*)(p.ws + WS_BIG);
    const size_t rowbase = (size_t)b * SEQ + n * 128;
    const bf16_t* vp = PROJ + proj_off(rowbase + (tid >> 2), 1536) + 512 + g * 128 + (tid & 3) * 32;
#pragma unroll
    for (int i = 0; i < 4; ++i) r.vv[i] = *(const u32x4*)(vp + i * 8);
    const bf16_t* up = PROJ + proj_off(rowbase + w * 16 + fr, 1536) + g * 128 + fq * 4;
#pragma unroll
    for (int q = 0; q < 8; ++q) r.uv[q] = *(const u32x2*)(up + q * 16);
}
__device__ __forceinline__ void sgu_weights(LAS unsigned char* lds, const Params& p, int j, int g) {
    int tid = threadIdx.x; asm volatile("" : "+v"(tid));
    LAS bf16_t* WL = (LAS bf16_t*)(lds + 69632);
    const bf16_t* Wm = (const bf16_t*)(p.ws + WS_SMALL + SM_SGUW) + (size_t)(j * 4 + g) * 16384;
#pragma unroll
    for (int i = 0; i < 4; ++i) { const int idx = tid + i * 512; *(LAS u32x4*)(WL + (idx >> 4) * 136 + (idx & 15) * 8) = *(const u32x4*)(Wm + (idx >> 4) * 128 + (idx & 15) * 8); }
}
__device__ __forceinline__ void sgu_item(LAS unsigned char* lds, const Params& p, int j, int item, const SguPre& pre) {
    int tid = threadIdx.x; asm volatile("" : "+v"(tid));
    const int lane = tid & 63, w = __builtin_amdgcn_readfirstlane(tid >> 6), fr = lane & 15, fq = lane >> 4;
    const int g = item & 3, n = (item >> 2) & 31, b = item >> 7;
    bf16_t* Y = (bf16_t*)(p.ws + WS_Y);
    const size_t rowbase = (size_t)b * SEQ + n * 128;
    LAS bf16_t* VT = (LAS bf16_t*)lds;
    LAS bf16_t* WL = (LAS bf16_t*)(lds + 69632);
    const int tC = w * 16 + fr;
    u32x2 uv[8];
#pragma unroll
    for (int q = 0; q < 8; ++q) uv[q] = pre.uv[q];
    {
        const int s = tid >> 2, qtr = tid & 3;
        float v[32]; float sum = 0.f;
#pragma unroll
        for (int i = 0; i < 4; ++i) { const u32x4 vv = pre.vv[i];
#pragma unroll
            for (int q = 0; q < 4; ++q) { v[i * 8 + 2 * q] = bf_lo(vv[q]); v[i * 8 + 2 * q + 1] = bf_hi(vv[q]); sum += v[i * 8 + 2 * q] + v[i * 8 + 2 * q + 1]; } }
        sum += __shfl_xor(sum, 1); sum += __shfl_xor(sum, 2);
        const float mu = sum * (1.0f / 128.0f); float var = 0.f;
#pragma unroll
        for (int i = 0; i < 32; ++i) { v[i] -= mu; var += v[i] * v[i]; }
        var += __shfl_xor(var, 1); var += __shfl_xor(var, 2);
        const float rstd = rsqrtf(var * (1.0f / 128.0f) + EPS);
        LAS bf16_t* VN = (LAS bf16_t*)(lds + 34816);
#pragma unroll
        for (int i = 0; i < 4; ++i) { u32x4 o;
#pragma unroll
            for (int q = 0; q < 4; ++q) o[q] = cvt_pk_bf16(v[i * 8 + 2 * q] * rstd, v[i * 8 + 2 * q + 1] * rstd);
            *(LAS u32x4*)(VN + s * 136 + qtr * 32 + i * 8) = o; }
    }
    __syncthreads();
    {
        LAS const bf16_t* VN = (LAS const bf16_t*)(lds + 34816);
        const int c = tid & 127, sq = tid >> 7;
        bf16_t vq[32];
#pragma unroll
        for (int i = 0; i < 32; ++i) vq[i] = VN[(sq * 32 + i) * 136 + c];
#pragma unroll
        for (int i = 0; i < 4; ++i) { u32x4 o;
#pragma unroll
            for (int q = 0; q < 4; ++q) o[q] = (unsigned)vq[i * 8 + 2 * q] | ((unsigned)vq[i * 8 + 2 * q + 1] << 16);
            *(LAS u32x4*)(VT + c * 136 + sq * 32 + i * 8) = o; }
    }
    __syncthreads();
    {
        f32x4 acc[8];
#pragma unroll
        for (int q = 0; q < 8; ++q) acc[q] = (f32x4){0.f, 0.f, 0.f, 0.f};
        const int kmax = w >> 1;
#pragma unroll
        for (int kk = 0; kk < 4; ++kk) {
            if (kk <= kmax) {
                const bf16x8 wf = *(const LAS bf16x8*)(WL + (w * 16 + fr) * 136 + kk * 32 + fq * 8);
#pragma unroll
                for (int q = 0; q < 8; ++q) { const bf16x8 vf = *(const LAS bf16x8*)(VT + (q * 16 + fr) * 136 + kk * 32 + fq * 8); acc[q] = __builtin_amdgcn_mfma_f32_16x16x32_bf16(vf, wf, acc[q], 0, 0, 0); }
            }
        }
        const float bias = p.in[16][(size_t)(j * 4 + g) * 128 + tC];
        bf16_t* yp = Y + tiled(rowbase + tC, g * 128 + fq * 4, 1024);
#pragma unroll
        for (int q = 0; q < 8; ++q) {
            u32x2 o; o.x = cvt_pk_bf16(bf_lo(uv[q].x) * (acc[q][0] + bias), bf_hi(uv[q].x) * (acc[q][1] + bias)); o.y = cvt_pk_bf16(bf_lo(uv[q].y) * (acc[q][2] + bias), bf_hi(uv[q].y) * (acc[q][3] + bias));
            *(u32x2*)(yp + (q >> 2) * 16384 + (q & 3) * 16) = o;
        }
    }
    __syncthreads();
}

struct PoolPre { u32x4 pl[5]; u32x4 wt[4]; };
__device__ __forceinline__ void pool_load(const Params& p, int j, int item, PoolPre& r) {
    int tid = threadIdx.x; asm volatile("" : "+v"(tid));
    const int gi = item & 3, tile = (item >> 2) & 31, b = item >> 7;
    const bf16_t* PROJ = (const bf16_t*)(p.ws + WS_BIG);
    const int t0 = tile * 128;
    const bf16_t* PWT = (const bf16_t*)(p.ws + WS_SMALL + SM_PWT) + (size_t)(j * 4 + gi) * 16384;
#pragma unroll
    for (int i = 0; i < 4; ++i) { const int idx = tid + i * 512; r.wt[i] = *(const u32x4*)(PWT + (idx >> 4) * 128 + (idx & 15) * 8); }
#pragma unroll
    for (int i = 0; i < 5; ++i) {
        const int idx = tid + i * 512; const int rr = idx >> 4, c8 = (idx & 15) * 8; const int ts = t0 - 16 + rr;
        u32x4 vv = (u32x4){0u, 0u, 0u, 0u};
        if (idx < 144 * 16 && ts >= 0) vv = *(const u32x4*)(PROJ + proj_off((size_t)b * SEQ + ts, 1536) + 1024 + gi * 128 + c8);
        r.pl[i] = vv;
    }
}
__device__ __forceinline__ void pool_item(LAS unsigned char* lds, const Params& p, int j, int item, const PoolPre& pre) {
    int tid = threadIdx.x; asm volatile("" : "+v"(tid));
    const int lane = tid & 63, w = __builtin_amdgcn_readfirstlane(tid >> 6), fr = lane & 15, fq = lane >> 4;
    const int gi = item & 3, tile = (item >> 2) & 31, b = item >> 7;
    bf16_t* Y = (bf16_t*)(p.ws + WS_Y);
    const int t0 = tile * 128;
    const size_t rowbase = (size_t)b * SEQ + t0;
    LAS float* PL = (LAS float*)lds;
    LAS bf16_t* PA = (LAS bf16_t*)(lds + 73728);
    LAS bf16_t* PWL = (LAS bf16_t*)(lds + 108544);
    {
#pragma unroll
        for (int i = 0; i < 5; ++i) {
            const int idx = tid + i * 512;
            if (idx < 144 * 16) {
                const int rr = idx >> 4, c8 = (idx & 15) * 8; const u32x4 vv = pre.pl[i];
                *(LAS f32x4*)(PL + rr * 128 + c8) = (f32x4){bf_lo(vv[0]), bf_hi(vv[0]), bf_lo(vv[1]), bf_hi(vv[1])};
                *(LAS f32x4*)(PL + rr * 128 + c8 + 4) = (f32x4){bf_lo(vv[2]), bf_hi(vv[2]), bf_lo(vv[3]), bf_hi(vv[3])};
            }
        }
#pragma unroll
        for (int i = 0; i < 4; ++i) { const int idx = tid + i * 512; *(LAS u32x4*)(PWL + (idx >> 4) * 136 + (idx & 15) * 8) = pre.wt[i]; }
    }
    __syncthreads();
    {
        const int tg = tid >> 4, c8 = (tid & 15) * 8; const int win = 2 << gi;
        const int tf = tg * 4;
        f32x4 s0 = (f32x4){0.f, 0.f, 0.f, 0.f}, s1 = (f32x4){0.f, 0.f, 0.f, 0.f};
        for (int k = 0; k < win; ++k) { const LAS float* rp = PL + (tf + 16 - k) * 128 + c8; s0 += *(const LAS f32x4*)rp; s1 += *(const LAS f32x4*)(rp + 4); }
#pragma unroll
        for (int i = 0; i < 4; ++i) {
            const int t = tf + i;
            const LAS float* cp = PL + (t + 16) * 128 + c8;
            const f32x4 c0 = *(const LAS f32x4*)cp, c1 = *(const LAS f32x4*)(cp + 4);
            if (i > 0) { const LAS float* op = PL + (t + 16 - win) * 128 + c8; s0 += c0 - *(const LAS f32x4*)op; s1 += c1 - *(const LAS f32x4*)(op + 4); }
            const int tabs = t0 + t; const int cnt = (tabs + 1 < win) ? tabs + 1 : win;
            const float inv = rcp_((float)cnt);
            const f32x4 a = s0 * inv - c0, bq = s1 * inv - c1;
            u32x4 o; o.x = cvt_pk_bf16(a[0], a[1]); o.y = cvt_pk_bf16(a[2], a[3]); o.z = cvt_pk_bf16(bq[0], bq[1]); o.w = cvt_pk_bf16(bq[2], bq[3]);
            *(LAS u32x4*)(PA + t * 136 + c8) = o;
        }
    }
    __syncthreads();
    {
        f32x4 acc[8];
#pragma unroll
        for (int q = 0; q < 8; ++q) acc[q] = (f32x4){0.f, 0.f, 0.f, 0.f};
#pragma unroll
        for (int kk = 0; kk < 4; ++kk) {
            const bf16x8 pf = *(const LAS bf16x8*)(PA + (w * 16 + fr) * 136 + kk * 32 + fq * 8);
#pragma unroll
            for (int q = 0; q < 8; ++q) { const bf16x8 wf = *(const LAS bf16x8*)(PWL + (q * 16 + fr) * 136 + kk * 32 + fq * 8); acc[q] = __builtin_amdgcn_mfma_f32_16x16x32_bf16(wf, pf, acc[q], 0, 0, 0); }
        }
        const int t = w * 16 + fr;
        bf16_t* yp = Y + tiled(rowbase + t, 512 + gi * 128 + fq * 4, 1024);
#pragma unroll
        for (int q = 0; q < 8; ++q) { u32x2 o; o.x = cvt_pk_bf16(acc[q][0], acc[q][1]); o.y = cvt_pk_bf16(acc[q][2], acc[q][3]); *(u32x2*)(yp + (q >> 2) * 16384 + (q & 3) * 16) = o; }
    }
    __syncthreads();
}

__device__ __forceinline__ void zero_y(const Params& p) {
    int tid = threadIdx.x; asm volatile("" : "+v"(tid));
    u32x4* yz = (u32x4*)(p.ws + WS_Y);
    for (size_t i = (size_t)blockIdx.x * NTHR + tid; i < (size_t)MTOK * 128; i += (size_t)gridDim.x * NTHR) yz[i] = (u32x4){0u, 0u, 0u, 0u};
}
__device__ __forceinline__ void final_norm(const Params& p) {
    int tid = threadIdx.x; asm volatile("" : "+v"(tid));
    const int lane = tid & 63, wave = tid >> 6;
    const int gw = blockIdx.x * 8 + wave, NGW = gridDim.x * 8;
    const float* rowss = (const float*)(p.ws + WS_ROWSS); const float* gain = p.in[22];
    f32x4 gv[4];
#pragma unroll
    for (int q = 0; q < 4; ++q) gv[q] = *((const f32x4*)gain + lane + 64 * q);
    for (int row = gw; row < MTOK; row += 2 * NGW) {
        const int row2 = row + NGW;
        f32x4* hr = (f32x4*)(p.out + (size_t)row * DM) + lane; f32x4* hr2 = (f32x4*)(p.out + (size_t)row2 * DM) + lane;
        f32x4 v[4], v2[4];
#pragma unroll
        for (int q = 0; q < 4; ++q) { v[q] = hr[64 * q]; v2[q] = hr2[64 * q]; }
        const f32x4* sp = (const f32x4*)(rowss + (size_t)row * 16); const f32x4* sp2 = (const f32x4*)(rowss + (size_t)row2 * 16);
        const f32x4 st = (sp[0] + sp[1]) + (sp[2] + sp[3]), st2 = (sp2[0] + sp2[1]) + (sp2[2] + sp2[3]);
        const float rstd = rsqrtf(((st[0] + st[1]) + (st[2] + st[3])) * (1.0f / 1024.0f) + EPS);
        const float rstd2 = rsqrtf(((st2[0] + st2[1]) + (st2[2] + st2[3])) * (1.0f / 1024.0f) + EPS);
#pragma unroll
        for (int q = 0; q < 4; ++q) { hr[64 * q] = v[q] * rstd * gv[q]; hr2[64 * q] = v2[q] * rstd2 * gv[q]; }
    }
}

#define XB_TMO      128
#define XB_XCNT(j)  (256  + 64 * (j))
#define XB_XSUB(j)  (1280 + 64 * (j))
#define XB_XGEN(j)  (2304 + 64 * (j))
#define XB_TOP      3328
#define XB_TOPGEN   3392
#define XCD_BAR_WORDS 3456
#define XB_SPIN_CAP (1u << 18)
__device__ __forceinline__ unsigned xb_ld(unsigned* p)              { return __hip_atomic_load(p, __ATOMIC_RELAXED, __HIP_MEMORY_SCOPE_AGENT); }
__device__ __forceinline__ unsigned xb_add(unsigned* p, unsigned v) { return __hip_atomic_fetch_add(p, v, __ATOMIC_RELAXED, __HIP_MEMORY_SCOPE_AGENT); }
__device__ __forceinline__ unsigned xb_xcc_id() { return (unsigned)__builtin_amdgcn_s_getreg((3 << 11) | 20) & 0xFu; }
#define XB_SPIN(cond, bar) do { unsigned _sp = 0; while (cond) { __builtin_amdgcn_s_sleep(1); \
    if ((++_sp & 255u) == 0u) { if (xb_ld(&(bar)[XB_TMO])) break; if (_sp > XB_SPIN_CAP) { atomicAdd(&(bar)[XB_TMO], 1u); break; } } } } while (0)
struct XcdBarrier { unsigned* bar; unsigned x; volatile LAS unsigned* st; };
__device__ __forceinline__ XcdBarrier xcd_barrier_post(unsigned* bar, volatile LAS unsigned* st) {
    XcdBarrier b; b.bar = bar; b.x = xb_xcc_id(); b.st = st;
    if (threadIdx.x == 0) (void)xb_add(&bar[XB_XCNT(b.x)], 1u);
    return b;
}
__device__ __forceinline__ void xcd_barrier_complete(unsigned* bar, unsigned x, unsigned& nloc, unsigned& nx) {
    const unsigned G = gridDim.x * gridDim.y * gridDim.z;
    unsigned sum, cnt, mine, sp = 0u;
    for (;;) {
        sum = 0u; cnt = 0u; mine = 0u;
#pragma unroll
        for (unsigned j = 0; j < 16; ++j) { const unsigned c = xb_ld(&bar[XB_XCNT(j)]); sum += c; cnt += (c > 0u) ? 1u : 0u; mine = (j == x) ? c : mine; }
        if (sum == G) break;
        __builtin_amdgcn_s_sleep(1);
        if ((++sp & 255u) == 0u) { if (xb_ld(&bar[XB_TMO])) break; if (sp > XB_SPIN_CAP) { atomicAdd(&bar[XB_TMO], 1u); break; } }
    }
    nloc = mine > 0u ? mine : 1u; nx = cnt > 0u ? cnt : 1u;
}
__device__ __forceinline__ void xcd_barrier(const XcdBarrier& b) {
    asm volatile("s_waitcnt vmcnt(0)" ::: "memory");
    __syncthreads();
    if (threadIdx.x == 0) {
        unsigned* bar = b.bar;
        __builtin_amdgcn_s_waitcnt(0);
        unsigned nloc = b.st[0], nx = b.st[1];
        if (nloc == 0u) { xcd_barrier_complete(bar, b.x, nloc, nx); b.st[0] = nloc; b.st[1] = nx; }
        const unsigned old = xb_add(&bar[XB_XSUB(b.x)], 1u);
        const unsigned gen = old / nloc;
        if (old + 1u == (gen + 1u) * nloc) {
            __builtin_amdgcn_fence(__ATOMIC_RELEASE, "agent");
            asm volatile("s_waitcnt vmcnt(0)" ::: "memory");
            const unsigned og = xb_add(&bar[XB_TOP], 1u);
            const unsigned tg = og / nx;
            if (og + 1u == (tg + 1u) * nx) xb_add(&bar[XB_TOPGEN], 1u);
            else XB_SPIN(xb_ld(&bar[XB_TOPGEN]) == tg, bar);
            __builtin_amdgcn_fence(__ATOMIC_ACQUIRE, "agent");
            xb_add(&bar[XB_XGEN(b.x)], 1u);
            asm volatile("s_waitcnt vmcnt(0)" ::: "memory");
        } else {
            XB_SPIN(xb_ld(&bar[XB_XGEN(b.x)]) == gen, bar);
            __builtin_amdgcn_fence(__ATOMIC_ACQUIRE, "agent");
            asm volatile("s_waitcnt vmcnt(0)" ::: "memory");
        }
    }
    __syncthreads();
}

__device__ __forceinline__ void xcd_local_barrier(const XcdBarrier& b) {
    asm volatile("s_waitcnt vmcnt(0)" ::: "memory");
    __syncthreads();
    if (threadIdx.x == 0) {
        unsigned* bar = b.bar;
        __builtin_amdgcn_s_waitcnt(0);
        const unsigned nloc = b.st[0];
        const unsigned old = xb_add(&bar[XB_XSUB(b.x)], 1u);
        const unsigned gen = old / nloc;
        if (old + 1u == (gen + 1u) * nloc) xb_add(&bar[XB_XGEN(b.x)], 1u);
        else XB_SPIN(xb_ld(&bar[XB_XGEN(b.x)]) == gen, bar);
        __builtin_amdgcn_fence(__ATOMIC_ACQUIRE, "agent");
        asm volatile("s_waitcnt vmcnt(0)" ::: "memory");
    }
    __syncthreads();
}

__global__ void __launch_bounds__(NTHR, 2) fwd_megakernel(Params p) {
    extern __shared__ __attribute__((aligned(16))) unsigned char lds_raw[];
    LAS unsigned char* lds = (LAS unsigned char*)lds_raw;
    const int G = gridDim.x, bid = blockIdx.x;
    bf16_t* WTb = (bf16_t*)(p.ws + WS_WT);
    bf16_t* HB = (bf16_t*)(p.ws + WS_HB); bf16_t* Y = (bf16_t*)(p.ws + WS_Y); bf16_t* BIG = (bf16_t*)(p.ws + WS_BIG);
    float* rowss = (float*)(p.ws + WS_ROWSS);

    volatile LAS unsigned* xst = (volatile LAS unsigned*)(lds + LDS_BYTES - 64);
    if (threadIdx.x < 8) xst[threadIdx.x] = 0u;
    __syncthreads();
    XcdBarrier xbar; xbar.bar = (unsigned*)(p.ws + WS_BAR); xbar.st = xst; xbar.x = xb_xcc_id();
    if (threadIdx.x == 0) xst[2] = xb_add(&xbar.bar[XB_XCNT(xbar.x)], 1u);
    for (int rep = 0; rep < DBG_REP_P0; ++rep) phase0(lds, p);
    cg::this_grid().sync();
    if (threadIdx.x == 0) {
        bool okc = (G % 8) == 0;
        for (unsigned jx = 0; jx < 16; ++jx) { const unsigned cx = xb_ld(&xbar.bar[XB_XCNT(jx)]); okc = okc && (cx == (jx < 8 ? (unsigned)G / 8u : 0u)); }
        xst[4] = okc ? (xst[2] * 8u + xbar.x) : (unsigned)bid; xst[5] = okc ? 1u : 0u;
    }
    __syncthreads();
    const int vid = __builtin_amdgcn_readfirstlane((int)xst[4]);
    const bool xlocal = USE_LOCAL_BAR && (__builtin_amdgcn_readfirstlane((int)xst[5]) != 0);
    const int NX = ((G & 7) == 0) ? 8 : 1, xv = vid % NX, rk = vid / NX, RK = G / NX;
#define SEAM() do { if (xlocal) xcd_local_barrier(xbar); else xcd_barrier(xbar); } while (0)
#define GRID_SYNC() xcd_barrier(xbar)
#pragma unroll 1
    for (int layer = 0; layer < 4; ++layer) {
        const int j = layer >> 1;
        const bool even = (layer & 1) == 0;
        if (even) {
            pg8::Gemm g{HB, WTb + OFF_INE + (size_t)j * 3145728, MTOK, 3072, 1024}; pg8::StaticOrder S; int vq1 = vid, Gq1 = G; asm volatile("" : "+s"(vq1), "+s"(Gq1)); S.init(MTOK, 3072, Gq1, vq1, 0);
            pg8::EpiIn<0> E{BIG, 3072, rowss};
            pg8::gemm_phase(lds, g, S, E);
        } else {
            pg8::Gemm g{HB, WTb + OFF_INO + (size_t)j * 1572864, MTOK, 1536, 1024}; pg8::StaticOrder S; int vq2 = vid, Gq2 = G; asm volatile("" : "+s"(vq2), "+s"(Gq2)); S.init(MTOK, 1536, Gq2, vq2, 0);
            pg8::EpiIn<1> E{BIG, 1536, rowss};
            pg8::gemm_phase(lds, g, S, E);
        }
        if (layer == 0) GRID_SYNC(); else SEAM();
        if (even) {
            for (int i = rk; i < 256 / NX; i += RK) lru_pass<1>(lds, p, j, xv * (256 / NX) + i);
            hgrn2_run<1>(lds, p, j, xv * (512 / NX) + rk, RK, (512 / NX - rk + RK - 1) / RK);
            SEAM();
            for (int i = rk; i < 256 / NX; i += RK) lru_pass<2>(lds, p, j, xv * (256 / NX) + i);
            hgrn2_run<2>(lds, p, j, xv * (512 / NX) + rk, RK, (512 / NX - rk + RK - 1) / RK);
        } else {
            if (rk < 2048 / NX) {
                const int sbase = xv * (2048 / NX);
                if ((RK & 3) == 0) sgu_weights(lds, p, j, (sbase + rk) & 3);
                SguPre snx; sgu_load(p, sbase + rk, snx);
                for (int i = rk; i < 2048 / NX; i += RK) {
                    const SguPre scur = snx;
                    if ((RK & 3) != 0) { __syncthreads(); sgu_weights(lds, p, j, (sbase + i) & 3); }
                    if (i + RK < 2048 / NX) sgu_load(p, sbase + i + RK, snx);
                    sgu_item(lds, p, j, sbase + i, scur);
                }
            }
            if (rk < 2048 / NX) {
                const int pbase = xv * (2048 / NX);
                PoolPre pnx; pool_load(p, j, pbase + (rk & ~3) + (rk & 3), pnx);
                for (int i = rk, k = 0; i < 2048 / NX; i += RK, ++k) {
                    const PoolPre pcur = pnx;
                    const int i2 = i + RK;
                    if (i2 < 2048 / NX) pool_load(p, j, pbase + (i2 & ~3) + ((i2 + k + 1) & 3), pnx);
                    pool_item(lds, p, j, pbase + (i & ~3) + ((i + k) & 3), pcur);
                }
            }
        }
        SEAM();
        {
            const bf16_t* Wt = even ? WTb + OFF_OUTE + (size_t)j * 1048576 : WTb + OFF_OUTO + (size_t)j * 1048576;
            pg8::Gemm g{Y, Wt, MTOK, 1024, 1024}; pg8::StaticOrder S; int vq3 = vid, Gq3 = G; asm volatile("" : "+s"(vq3), "+s"(Gq3)); S.init(MTOK, 1024, Gq3, vq3, 1);
            pg8::EpiRes E{layer == 0 ? p.in[0] : (const float*)p.out, p.out, HB, rowss};
            pg8::gemm_phase(lds, g, S, E);
        }
        SEAM();
        {
            pg8::Gemm g{HB, WTb + OFF_FIN + (size_t)layer * 4194304, MTOK, 4096, 1024}; pg8::StaticOrder S; int vq4 = vid, Gq4 = G; asm volatile("" : "+s"(vq4), "+s"(Gq4)); S.init(MTOK, 4096, Gq4, vq4, 0);
            pg8::EpiIn<2> E{BIG, 4096, rowss};
            pg8::gemm_phase(lds, g, S, E);
        }
        SEAM();
        {
            pg8::Gemm g{BIG, WTb + OFF_FOUT + (size_t)layer * 4194304, MTOK, 1024, 4096}; pg8::StaticOrder S; int vq5 = vid, Gq5 = G; asm volatile("" : "+s"(vq5), "+s"(Gq5)); S.init(MTOK, 1024, Gq5, vq5, 1);
            pg8::EpiRes E{(const float*)p.out, p.out, HB, rowss};
            pg8::gemm_phase(lds, g, S, E);
        }
        if (layer == 3) GRID_SYNC(); else SEAM();
    }
    for (int rep = 0; rep < DBG_EXTRA_SYNCS; ++rep) GRID_SYNC();
    final_norm(p);
}

extern "C" void kernel_launch(void* const* d_in, const int* in_sizes, int n_in, void* d_out, int out_size, void* d_ws, size_t ws_size, hipStream_t stream) {
    static int grid_blocks = 0;
    if (!grid_blocks) {
        int dev = 0, cus = 0, per_cu = 0;
        (void)hipGetDevice(&dev);
        (void)hipDeviceGetAttribute(&cus, hipDeviceAttributeMultiprocessorCount, dev);
        (void)hipFuncSetAttribute((const void*)fwd_megakernel, hipFuncAttributeMaxDynamicSharedMemorySize, LDS_BYTES);
        (void)hipOccupancyMaxActiveBlocksPerMultiprocessor(&per_cu, (const void*)fwd_megakernel, NTHR, LDS_BYTES);
        (void)hipGetLastError();
        grid_blocks = cus > 0 ? cus : 256;
        if (n_in != 23 || out_size != MTOK * DM || ws_size < (size_t)868 * MiB) fprintf(stderr, "kernel_launch: unexpected shapes n_in %d out %d ws %zu\n", n_in, out_size, ws_size);
    }
    Params p{};
    for (int i = 0; i < 23; ++i) p.in[i] = (const float*)d_in[i];
    p.out = (float*)d_out; p.ws = (unsigned char*)d_ws;
    (void)hipMemsetAsync((unsigned char*)d_ws + WS_BAR, 0, 16384, stream);
    void* args[] = {&p};
    hipError_t e = hipLaunchCooperativeKernel((void*)fwd_megakernel, dim3(grid_blocks), dim3(NTHR), args, LDS_BYTES, stream);
    if (e != hipSuccess) fprintf(stderr, "cooperative launch failed: %s (grid %d)\n", hipGetErrorString(e), grid_blocks);
}
```

```cpp
#include <hip/hip_runtime.h>
#include <hip/hip_cooperative_groups.h>
#include <cstdio>
namespace cg = cooperative_groups;

#define LAS __attribute__((address_space(3)))
typedef unsigned short bf16_t;
typedef short bf16x8 __attribute__((ext_vector_type(8)));
typedef float f32x4 __attribute__((ext_vector_type(4)));
typedef unsigned u32x4 __attribute__((ext_vector_type(4)));
typedef unsigned u32x2 __attribute__((ext_vector_type(2)));

constexpr int MTOK = 65536, DM = 1024, SEQ = 4096;
constexpr float EPS = 1e-6f;
constexpr int LDS_BYTES = 155648;
#define DBG_REP_EVEN 1
#define DBG_REP_ODD 1
#define DBG_REP_FFNIN 1
#define DBG_REP_P0 1
#define DBG_EPI2 0
#define DBG_EXTRA_SYNCS 0
#define USE_LOCAL_BAR 1
#define DBG_SKIP_EVEN 0
#define DBG_SKIP_LRU 0
#define DBG_SKIP_HGRN 0
#define DBG_SKIP_ODD 0
constexpr int NTHR = 512;

constexpr size_t MiB = 1u << 20;
constexpr size_t WS_WT = 0;
constexpr size_t WS_SMALL = 90 * MiB;
constexpr size_t WS_BAR = 91 * MiB;
constexpr size_t WS_ROWSS = 92 * MiB;
constexpr size_t WS_LRUC = 96 * MiB;
constexpr size_t WS_HGG = 98 * MiB;
constexpr size_t WS_HB = 100 * MiB;
constexpr size_t WS_Y = 228 * MiB;
constexpr size_t WS_BIG = 356 * MiB;
constexpr size_t WS_ST = 868 * MiB;
constexpr size_t OFF_INE = 0, OFF_OUTE = 6291456, OFF_INO = 8388608, OFF_OUTO = 11534336, OFF_FIN = 13631488, OFF_FOUT = 30408704;
constexpr size_t SM_WAT = 0, SM_WXT = 256 * 1024, SM_SGUW = 512 * 1024, SM_PWT = 768 * 1024;

struct Params { const float* in[23]; float* out; unsigned char* ws; };

typedef float f32x2_ __attribute__((ext_vector_type(2)));
typedef __bf16 bf16x2_ __attribute__((ext_vector_type(2)));
__device__ __forceinline__ unsigned cvt_pk_bf16(float lo, float hi) { f32x2_ v = {lo, hi}; bf16x2_ r = __builtin_convertvector(v, bf16x2_); return __builtin_bit_cast(unsigned, r); }
__device__ __forceinline__ float bf_lo(unsigned w) { return __uint_as_float(w << 16); }
__device__ __forceinline__ float bf_hi(unsigned w) { return __uint_as_float(w & 0xffff0000u); }
__device__ __forceinline__ float bf2f(bf16_t b) { return __uint_as_float(((unsigned)b) << 16); }
__device__ __forceinline__ bf16_t f2bf(float f) { return (bf16_t)(cvt_pk_bf16(f, 0.f) & 0xffffu); }
__device__ __forceinline__ float rcp_(float x) { return __builtin_amdgcn_rcpf(x); }
__device__ __forceinline__ float sigmoid_(float x) { return rcp_(1.0f + __expf(-x)); }
__device__ __forceinline__ float gelu_tanh(float x) { const float u = 0.7978845608f * (x + 0.044715f * x * x * x); return x * rcp_(1.0f + __expf(-2.0f * u)); }
__device__ __forceinline__ float silu_(float x) { return x * rcp_(1.0f + __expf(-x)); }
__device__ __forceinline__ size_t tiled(size_t row, int col, int K) { return ((row >> 8) * (size_t)K + (size_t)(col >> 6) * 64) * 256 + ((row & 255) << 6) + (size_t)(col & 63); }
__device__ __forceinline__ size_t proj_off(size_t row, int ldc) { return (row >> 13) * (size_t)33554432 + (row & 8191) * (size_t)ldc; }
#define LDS_WAIT() asm volatile("s_waitcnt lgkmcnt(0)" ::: "memory")

namespace pg8 {
constexpr int BM = 256, BK = 64, HALF = 128, HTB = HALF * BK * 2, STAGE_BYTES = 8 * HTB, NXCD = 8, WGM = 4;
__host__ __device__ __forceinline__ int lds_byte(int r, int c) { const int st = (r >> 4) * 2 + (c >> 5), rr = r & 15, cc = c & 31, ob = rr * 64 + cc * 2; return st * 1024 + (ob ^ (((ob >> 9) & 1) << 5)); }
__host__ __device__ __forceinline__ void stage_rc(int b, int& R, int& C) { const int st = b / 1024, sb = b % 1024, swz = sb ^ (((sb >> 9) & 1) << 5); R = (st >> 1) * 16 + swz / 64; C = (st & 1) * 32 + (swz % 64) / 2; }
__host__ __device__ __forceinline__ int perm32(int rho) { const int n = rho >> 4, i = rho & 15; return 8 * (i >> 2) + 4 * n + (i & 3); }
struct Unit { int pm, pn; };
struct Gemm { const bf16_t* A; const bf16_t* Bt; int M, N, K; };
struct StaticOrder {
    int nM, nN, nwg, G, c, rev;
    __device__ void init(int M, int N, int G_, int c_, int rev_ = 0) { nM = M / BM; nN = N / BM; nwg = nM * nN; G = G_; c = c_; rev = rev_; }
    __device__ bool next(int i, Unit& u) const {
        const int nround = (nwg + G - 1) / G; if (i >= nround) return false;
        const long L = (long)(rev ? (nround - 1 - i) : i) * G + c; if (L >= nwg) return false;
        int wgid = (int)L; { const int q = nwg / NXCD, r = nwg % NXCD, xcd = wgid % NXCD, off = wgid / NXCD; wgid = (xcd < r ? xcd * (q + 1) : r * (q + 1) + (xcd - r) * q) + off; }
        const int nig = WGM * nN, gid = wgid / nig, fm = gid * WGM, gsz = (nM - fm) < WGM ? (nM - fm) : WGM;
        u.pm = fm + ((wgid % nig) % gsz); u.pn = (wgid % nig) / gsz; return true;
    }
};

template <int ACT> struct EpiIn {
    static constexpr bool PERM = true, PRE = true;
    bf16_t* O; int ldc; const float* rowss;
    __device__ __forceinline__ void operator()(const f32x4 (&acc)[2][2][4][2], const Unit& u, int wr, int wc, int fr, int fq, const LAS float* RS) const {
        const int row0 = u.pm * BM + wr * 64 + fr, col0 = u.pn * BM + wc * 32 + 8 * fq;
        const bool do_gelu = (ACT == 1) && (u.pn < 4);
        float rs[8];
#pragma unroll
        for (int i = 0; i < 8; ++i) rs[i] = RS[(i >> 2) * HALF + wr * 64 + (i & 3) * 16 + fr];
#pragma unroll
        for (int ai = 0; ai < 2; ++ai)
#pragma unroll
            for (int m = 0; m < 4; ++m) {
                const int row = row0 + ai * HALF + m * 16;
                const float rstd = rs[ai * 4 + m];
                bf16_t* rowp = (ACT == 2) ? O + tiled((size_t)row, col0, ldc) : O + proj_off((size_t)row, ldc) + col0;
#pragma unroll
                for (int bj = 0; bj < 2; ++bj) {
                    f32x4 v0 = acc[ai][bj][m][0] * rstd, v1 = acc[ai][bj][m][1] * rstd;
                    if (ACT == 1) { if (do_gelu) {
#pragma unroll
                        for (int q = 0; q < 4; ++q) { v0[q] = gelu_tanh(v0[q]); v1[q] = gelu_tanh(v1[q]); } } }
                    if (ACT == 2) {
#pragma unroll
                        for (int q = 0; q < 4; ++q) { const float a = fmaxf(v0[q], 0.f), b = fmaxf(v1[q], 0.f); v0[q] = a * a; v1[q] = b * b; } }
                    u32x4 w; w.x = cvt_pk_bf16(v0[0], v0[1]); w.y = cvt_pk_bf16(v0[2], v0[3]); w.z = cvt_pk_bf16(v1[0], v1[1]); w.w = cvt_pk_bf16(v1[2], v1[3]);
                    *(u32x4*)(rowp + bj * ((ACT == 2) ? HALF * 256 : HALF)) = w;
                }
            }
    }
};
struct EpiRes {
    static constexpr bool PERM = true, PRE = false;
    const float* res; float* H; bf16_t* HB; float* rowss;
    __device__ __forceinline__ void operator()(const f32x4 (&acc)[2][2][4][2], const Unit& u, int wr, int wc, int fr, int fq, const LAS float*) const {
        const int row0 = u.pm * BM + wr * 64 + fr, col0 = u.pn * BM + wc * 32 + 8 * fq;
#pragma unroll
        for (int ai = 0; ai < 2; ++ai) {
            f32x4 r[4][4];
#pragma unroll
            for (int m = 0; m < 4; ++m) {
                const size_t off = (size_t)(row0 + ai * HALF + m * 16) * DM + col0;
#pragma unroll
                for (int q = 0; q < 4; ++q) r[m][q] = *(const f32x4*)(res + off + (q >> 1) * HALF + (q & 1) * 4);
            }
#pragma unroll
            for (int m = 0; m < 4; ++m) {
                const int row = row0 + ai * HALF + m * 16;
                const size_t off = (size_t)row * DM + col0;
                float ss = 0.f;
#pragma unroll
                for (int bj = 0; bj < 2; ++bj) {
                    const f32x4 v0 = r[m][bj * 2] + acc[ai][bj][m][0], v1 = r[m][bj * 2 + 1] + acc[ai][bj][m][1];
                    *(f32x4*)(H + off + bj * HALF) = v0; *(f32x4*)(H + off + bj * HALF + 4) = v1;
                    ss += ((v0[0] * v0[0] + v0[1] * v0[1]) + (v0[2] * v0[2] + v0[3] * v0[3])) + ((v1[0] * v1[0] + v1[1] * v1[1]) + (v1[2] * v1[2] + v1[3] * v1[3]));
                    u32x4 w; w.x = cvt_pk_bf16(v0[0], v0[1]); w.y = cvt_pk_bf16(v0[2], v0[3]); w.z = cvt_pk_bf16(v1[0], v1[1]); w.w = cvt_pk_bf16(v1[2], v1[3]);
                    *(u32x4*)(HB + tiled((size_t)row, col0 + bj * HALF, DM)) = w;
                }
                ss += __shfl_xor(ss, 16); ss += __shfl_xor(ss, 32);
                if (fq == 0) rowss[(size_t)row * 16 + u.pn * 4 + wc] = ss;
            }
        }
    }
};

template <class Epi, class Sched>
__device__ __forceinline__ void gemm_phase(LAS unsigned char* lds, const Gemm g, const Sched& S, const Epi& E) {
    int tid = threadIdx.x; asm volatile("" : "+v"(tid));
    const int wid = __builtin_amdgcn_readfirstlane(tid >> 6), lane = tid & 63, wr = wid >> 2, wc = wid & 3, fr = lane & 15, fq = lane >> 4;
    const int K = g.K, nt = K / BK;
    unsigned voffA[2], voffB[2];
#pragma unroll
    for (int i = 0; i < 2; ++i) { int R, C; stage_rc(tid * 16 + i * 8192, R, C); const int Rb = Epi::PERM ? ((R & ~31) + perm32(R & 31)) : R;
        voffA[i] = (unsigned)(R * BK + C) * 2u; voffB[i] = (unsigned)(Rb * K + C) * 2u; }
    const size_t kstep = (size_t)(BK * 2);
    const size_t hstep = (size_t)HALF * K * 2;
    const size_t tstep = 2 * hstep;
    const size_t kstepA = (size_t)BM * BK * 2, hstepA = (size_t)HALF * BK * 2;
    const unsigned ldsw = (unsigned)wid * 1024u;
    const int aoff = lds_byte(wr * 64 + fr, fq * 8), boff = lds_byte(wc * 32 + fr, fq * 8);
    LAS float* RS = (LAS float*)(lds + STAGE_BYTES);
#define PG8_SA(b, h) (((b) * 2 + (h)) * HTB)
#define PG8_SB(b, h) ((4 + (b) * 2 + (h)) * HTB)
#define PG8_STAGE(bufoff, gbase, voff) do { _Pragma("unroll") for (int _i = 0; _i < 2; ++_i) \
        __builtin_amdgcn_global_load_lds((const unsigned*)((const char*)(gbase) + (voff)[_i]), (LAS unsigned*)(lds + (bufoff) + ldsw + _i * 8192), 16, 0, 0); } while (0)
#define PG8_LDA(dst, b, h) do { _Pragma("unroll") for (int m = 0; m < 4; ++m) _Pragma("unroll") for (int k = 0; k < 2; ++k) dst[m][k] = *(const LAS bf16x8*)(lds + PG8_SA(b, h) + aoff + m * 2048 + k * 1024); } while (0)
#define PG8_LDB(dst, b, h) do { _Pragma("unroll") for (int n = 0; n < 2; ++n) _Pragma("unroll") for (int k = 0; k < 2; ++k) dst[n][k] = *(const LAS bf16x8*)(lds + PG8_SB(b, h) + boff + n * 2048 + k * 1024); } while (0)
#define PG8_MMA(ai, bj, At, Bt) do { __builtin_amdgcn_s_setprio(1); _Pragma("unroll") for (int m = 0; m < 4; ++m) _Pragma("unroll") for (int n = 0; n < 2; ++n) _Pragma("unroll") for (int k = 0; k < 2; ++k) \
        acc[ai][bj][m][n] = __builtin_amdgcn_mfma_f32_16x16x32_bf16(Bt[n][k], At[m][k], acc[ai][bj][m][n], 0, 0, 0); __builtin_amdgcn_s_setprio(0); } while (0)
#define PG8_WAIT_V(n) asm volatile("s_waitcnt vmcnt(" #n ")" ::: "memory")
#define PG8_WAIT_L(n) asm volatile("s_waitcnt lgkmcnt(" #n ")" ::: "memory")
#define PG8_BAR __builtin_amdgcn_s_barrier()
#define PG8_SCHED __builtin_amdgcn_sched_barrier(0)
    Unit cur, nxt; int ui = 0;
    if (!S.next(0, cur)) return;
    f32x4 acc[2][2][4][2];
#pragma unroll
    for (int a = 0; a < 2; ++a)
#pragma unroll
        for (int b = 0; b < 2; ++b)
#pragma unroll
            for (int m = 0; m < 4; ++m)
#pragma unroll
                for (int n = 0; n < 2; ++n) acc[a][b][m][n] = (f32x4){0.f, 0.f, 0.f, 0.f};
    bf16x8 At[4][2], B0[2][2], B1[2][2];
    const char* cA = (const char*)g.A + (size_t)cur.pm * tstep; const char* cB = (const char*)g.Bt + (size_t)cur.pn * tstep;
    PG8_STAGE(PG8_SB(0, 0), cB, voffB); PG8_STAGE(PG8_SA(0, 0), cA, voffA); PG8_STAGE(PG8_SB(0, 1), cB + hstep, voffB); PG8_STAGE(PG8_SA(0, 1), cA + hstepA, voffA);
    if (wr == 1) PG8_BAR;
    PG8_WAIT_V(4); PG8_BAR;
    PG8_STAGE(PG8_SB(1, 0), cB + kstep, voffB); PG8_STAGE(PG8_SA(1, 0), cA + kstepA, voffA); PG8_STAGE(PG8_SB(1, 1), cB + hstep + kstep, voffB);
    PG8_WAIT_V(6); PG8_BAR;
    for (;;) {
        const bool has_next = S.next(ui + 1, nxt);
        const char* nA = has_next ? (const char*)g.A + (size_t)nxt.pm * tstep : cA; const char* nB = has_next ? (const char*)g.Bt + (size_t)nxt.pn * tstep : cB;
        for (int t = 0; t < nt; t += 2) {
            const bool last = (t == nt - 2);
            const char* a1 = cA + (size_t)(t + 1) * kstepA;
            const char* a2 = last ? nA : cA + (size_t)(t + 2) * kstepA; const char* b2 = last ? nB : cB + (size_t)(t + 2) * kstep;
            const char* a3 = a2 + kstepA; const char* b3 = b2 + kstep;
            f32x4 rsA;
            if constexpr (Epi::PRE) { if (t <= 2) { const float* rp = E.rowss + (size_t)(cur.pm * BM + (t >> 1) * HALF + (tid >> 2)) * 16 + (tid & 3) * 4;
                asm volatile("global_load_dwordx4 %0, %1, off" : "=&v"(rsA) : "v"(rp) : "memory"); } }
            PG8_LDB(B0, 0, 0); PG8_SCHED; PG8_LDA(At, 0, 0); PG8_STAGE(PG8_SA(1, 1), a1 + hstepA, voffA);
            PG8_WAIT_L(8); PG8_BAR; PG8_WAIT_L(0); PG8_MMA(0, 0, At, B0); PG8_BAR; PG8_SCHED;
            PG8_LDB(B1, 0, 1); PG8_STAGE(PG8_SB(0, 0), b2, voffB);
            PG8_BAR; PG8_WAIT_L(0); PG8_MMA(0, 1, At, B1); PG8_BAR;
            PG8_LDA(At, 0, 1); PG8_STAGE(PG8_SA(0, 0), a2, voffA);
            PG8_BAR; PG8_WAIT_L(0); PG8_MMA(1, 0, At, B0); PG8_BAR; PG8_SCHED;
            PG8_STAGE(PG8_SB(0, 1), b2 + hstep, voffB);
            PG8_WAIT_V(6); PG8_BAR; PG8_MMA(1, 1, At, B1); PG8_BAR;
            if constexpr (Epi::PRE) { if (t <= 2) { asm volatile("s_waitcnt vmcnt(8)" : "+v"(rsA) :: "memory"); float sq = (rsA[0] + rsA[1]) + (rsA[2] + rsA[3]); sq += __shfl_xor(sq, 1); sq += __shfl_xor(sq, 2);
                if (!(tid & 3)) RS[(t >> 1) * HALF + (tid >> 2)] = rsqrtf(sq * (1.0f / 1024.0f) + EPS); } }
            PG8_LDB(B0, 1, 0); PG8_SCHED; PG8_LDA(At, 1, 0); PG8_STAGE(PG8_SA(0, 1), a2 + hstepA, voffA);
            PG8_WAIT_L(8); PG8_BAR; PG8_WAIT_L(0); PG8_MMA(0, 0, At, B0); PG8_BAR; PG8_SCHED;
            PG8_LDB(B1, 1, 1); PG8_STAGE(PG8_SB(1, 0), b3, voffB);
            PG8_BAR; PG8_WAIT_L(0); PG8_MMA(0, 1, At, B1); PG8_BAR;
            PG8_LDA(At, 1, 1); PG8_STAGE(PG8_SA(1, 0), a3, voffA);
            PG8_BAR; PG8_WAIT_L(0); PG8_MMA(1, 0, At, B0); PG8_BAR; PG8_SCHED;
            PG8_STAGE(PG8_SB(1, 1), b3 + hstep, voffB);
            PG8_WAIT_V(6); PG8_BAR; PG8_MMA(1, 1, At, B1); PG8_BAR;
        }
        E(acc, cur, wr, wc, fr, fq, RS);
        if (!has_next) break;
#pragma unroll
        for (int a = 0; a < 2; ++a)
#pragma unroll
            for (int b = 0; b < 2; ++b)
#pragma unroll
                for (int m = 0; m < 4; ++m)
#pragma unroll
                    for (int n = 0; n < 2; ++n) acc[a][b][m][n] = (f32x4){0.f, 0.f, 0.f, 0.f};
        cur = nxt; cA = nA; cB = nB; ++ui;
    }
    PG8_WAIT_V(0);
    if (wr == 0) PG8_BAR;
    PG8_BAR;
#undef PG8_SA
#undef PG8_SB
#undef PG8_STAGE
#undef PG8_LDA
#undef PG8_LDB
#undef PG8_MMA
#undef PG8_WAIT_V
#undef PG8_WAIT_L
#undef PG8_BAR
#undef PG8_SCHED
}
}

__device__ __forceinline__ void transpose_item(const float* W, int K, int N, bf16_t* WT, const float* kscale, LAS float* scr, int item, int lane) {
    const int nblk = N / 32, kb = item / nblk, nb = item % nblk, k0 = 64 * kb, n0 = 32 * nb;
    float wv[32];
#pragma unroll
    for (int i = 0; i < 32; ++i) wv[i] = W[(size_t)(k0 + 2 * i + (lane >> 5)) * N + n0 + (lane & 31)];
#pragma unroll
    for (int i = 0; i < 32; ++i) { const int kk = 2 * i + (lane >> 5); const float s = kscale ? kscale[k0 + kk] : 1.0f; scr[kk * 33 + (lane & 31)] = wv[i] * s; }
    LDS_WAIT();
    const int c = lane & 7;
#pragma unroll
    for (int j = 0; j < 4; ++j) { const int n = (lane >> 3) + 8 * j; const LAS float* s = scr + (8 * c) * 33 + n;
        u32x4 o; o.x = cvt_pk_bf16(s[0 * 33], s[1 * 33]); o.y = cvt_pk_bf16(s[2 * 33], s[3 * 33]); o.z = cvt_pk_bf16(s[4 * 33], s[5 * 33]); o.w = cvt_pk_bf16(s[6 * 33], s[7 * 33]);
        *(u32x4*)(WT + (size_t)(n0 + n) * K + k0 + 8 * c) = o; }
    LDS_WAIT();
}

__device__ __forceinline__ void phase0(LAS unsigned char* lds, const Params& p) {
    int tid = threadIdx.x; asm volatile("" : "+v"(tid));
    const int lane = tid & 63, wave = tid >> 6;
    const int gw = blockIdx.x * 8 + wave, NGW = gridDim.x * 8;
    LAS float* scr = (LAS float*)(lds + wave * 8704);
    bf16_t* WTb = (bf16_t*)(p.ws + WS_WT);
#pragma unroll 1
    for (int mat = 0; mat < 16; ++mat) {
        const float* W; int K, N; bf16_t* WT; const float* ks = nullptr;
        if (mat < 2)       { W = p.in[3] + (size_t)mat * 1024 * 3072; K = 1024; N = 3072; WT = WTb + OFF_INE + (size_t)mat * 3145728; ks = p.in[1] + (2 * mat) * 1024; }
        else if (mat < 4)  { const int j = mat - 2; W = p.in[13] + (size_t)j * 1048576; K = 1024; N = 1024; WT = WTb + OFF_OUTE + (size_t)j * 1048576; }
        else if (mat < 6)  { const int j = mat - 4; W = p.in[14] + (size_t)j * 1024 * 1536; K = 1024; N = 1536; WT = WTb + OFF_INO + (size_t)j * 1572864; ks = p.in[1] + (2 * j + 1) * 1024; }
        else if (mat < 8)  { const int j = mat - 6; W = p.in[19] + (size_t)j * 1048576; K = 1024; N = 1024; WT = WTb + OFF_OUTO + (size_t)j * 1048576; }
        else if (mat < 12) { const int l = mat - 8; W = p.in[20] + (size_t)l * 4194304; K = 1024; N = 4096; WT = WTb + OFF_FIN + (size_t)l * 4194304; ks = p.in[2] + l * 1024; }
        else               { const int l = mat - 12; W = p.in[21] + (size_t)l * 4194304; K = 4096; N = 1024; WT = WTb + OFF_FOUT + (size_t)l * 4194304; }
        const int nitems = (K / 64) * (N / 32);
        for (int it = gw; it < nitems; it += NGW) transpose_item(W, K, N, WT, ks, scr, it, lane);
    }
    {
        const size_t gtid = (size_t)blockIdx.x * NTHR + tid, gsz = (size_t)gridDim.x * NTHR;
        bf16_t* WaT = (bf16_t*)(p.ws + WS_SMALL + SM_WAT); bf16_t* WxT = (bf16_t*)(p.ws + WS_SMALL + SM_WXT);
        bf16_t* SW = (bf16_t*)(p.ws + WS_SMALL + SM_SGUW); bf16_t* PWT = (bf16_t*)(p.ws + WS_SMALL + SM_PWT);
        for (size_t i = gtid; i < 131072; i += gsz) {
            const int ii = i & 63, jo = (i >> 6) & 63; const size_t lh = i >> 12;
            if (i < 65536) { WaT[i] = f2bf(p.in[6][lh * 4096 + ii * 64 + jo]);
            WxT[i] = f2bf(p.in[8][lh * 4096 + ii * 64 + jo]); }
            const int s = i & 127, t = (i >> 7) & 127;
            SW[i] = f2bf(s <= t ? p.in[15][i] : 0.f);
            const int c = i & 127, d = (i >> 7) & 127; const size_t lg = i >> 14; const size_t l = lg >> 2, gi = lg & 3;
            PWT[i] = f2bf(p.in[17][lg * 16384 + c * 128 + d] * p.in[18][l * 512 + gi * 128 + d]);
        }
    }
    {
        const float* x = p.in[0]; bf16_t* HB = (bf16_t*)(p.ws + WS_HB); float* rowss = (float*)(p.ws + WS_ROWSS);
        for (int row = gw; row < MTOK; row += 2 * NGW) {
            const int row2 = row + NGW;
            const f32x4* xr = (const f32x4*)(x + (size_t)row * DM) + lane;
            const f32x4* xr2 = (const f32x4*)(x + (size_t)row2 * DM) + lane;
            f32x4 v[4], v2[4]; float s = 0.f, s2 = 0.f;
#pragma unroll
            for (int j = 0; j < 4; ++j) { v[j] = xr[64 * j]; v2[j] = xr2[64 * j]; }
#pragma unroll
            for (int j = 0; j < 4; ++j) { s += (v[j][0] * v[j][0] + v[j][1] * v[j][1]) + (v[j][2] * v[j][2] + v[j][3] * v[j][3]); s2 += (v2[j][0] * v2[j][0] + v2[j][1] * v2[j][1]) + (v2[j][2] * v2[j][2] + v2[j][3] * v2[j][3]); }
#pragma unroll
            for (int o = 1; o < 64; o <<= 1) { s += __shfl_xor(s, o); s2 += __shfl_xor(s2, o); }
            u32x2* o8 = (u32x2*)(HB + tiled((size_t)row, 4 * lane, DM)); u32x2* o82 = (u32x2*)(HB + tiled((size_t)row2, 4 * lane, DM));
#pragma unroll
            for (int j = 0; j < 4; ++j) { u32x2 w; w.x = cvt_pk_bf16(v[j][0], v[j][1]); w.y = cvt_pk_bf16(v[j][2], v[j][3]); o8[16384 * j] = w;
                u32x2 w2; w2.x = cvt_pk_bf16(v2[j][0], v2[j][1]); w2.y = cvt_pk_bf16(v2[j][2], v2[j][3]); o82[16384 * j] = w2; }
            if (lane < 16) { rowss[(size_t)row * 16 + lane] = (lane == 0) ? s : 0.f; rowss[(size_t)row2 * 16 + lane] = (lane == 0) ? s2 : 0.f; }
        }
    }
}

template <int PASS>
__device__ __forceinline__ void lru_pass(LAS unsigned char* lds, const Params& p, int j, int item) {
    int tid = threadIdx.x; asm volatile("" : "+v"(tid));
    const int lane = tid & 63, w = __builtin_amdgcn_readfirstlane(tid >> 6), fr = lane & 15, fq = lane >> 4;
    const int b = item >> 4, seg = item & 15;
    const bf16_t* PROJ = (const bf16_t*)(p.ws + WS_BIG);
    bf16_t* Y = (bf16_t*)(p.ws + WS_Y);
    float* Pbuf = (float*)(p.ws + WS_LRUC); float* Hbuf = Pbuf + 256 * 512;
    LAS bf16_t* U = (LAS bf16_t*)lds;
    LAS bf16_t* HS = (LAS bf16_t*)(lds + 66560);
    const bf16_t* WaT = (const bf16_t*)(p.ws + WS_SMALL + SM_WAT) + (size_t)(j * 8 + w) * 4096;
    const bf16_t* WxT = (const bf16_t*)(p.ws + WS_SMALL + SM_WXT) + (size_t)(j * 8 + w) * 4096;
    bf16x8 Ba[4][2], Bx[4][2];
#pragma unroll
    for (int n = 0; n < 4; ++n)
#pragma unroll
        for (int kk = 0; kk < 2; ++kk) { Ba[n][kk] = *(const bf16x8*)(WaT + (n * 16 + fr) * 64 + kk * 32 + fq * 8); Bx[n][kk] = *(const bf16x8*)(WxT + (n * 16 + fr) * 64 + kk * 32 + fq * 8); }
    float ba[4], bx[4], sp[4], h[4], P[4];
#pragma unroll
    for (int n = 0; n < 4; ++n) {
        const int c = w * 64 + n * 16 + fr;
        ba[n] = p.in[7][j * 512 + c]; bx[n] = p.in[9][j * 512 + c];
        const float lam = p.in[10][j * 512 + c];
        sp[n] = 8.0f * 1.44269504f * log1pf(__expf(-lam));
        float hh = 0.f;
        if (PASS == 2) {
            float pq[15], hq[15];
#pragma unroll
            for (int s = 0; s < 15; ++s) { pq[s] = Pbuf[(size_t)(b * 16 + s) * 512 + c]; hq[s] = Hbuf[(size_t)(b * 16 + s) * 512 + c]; }
#pragma unroll
            for (int s = 0; s < 15; ++s) hh = (s < seg) ? pq[s] * hh + hq[s] : hh;
        }
        h[n] = hh; P[n] = 1.0f;
    }
    const int c8 = (tid & 63) * 8, tg = tid >> 6;
    LAS float* CW = (LAS float*)(lds + 133120);
    {
        const float* src = (tid < 128 * 4) ? p.in[4] + (size_t)j * 2048 : p.in[4];
        *(LAS f32x4*)(CW + tid * 4) = *(const f32x4*)(src + tid * 4);
        if (tid < 128) *(LAS f32x4*)(CW + 2048 + tid * 4) = *(const f32x4*)(p.in[5] + j * 512 + tid * 4);
    }
    __syncthreads();
#pragma unroll 1
    for (int sub = 0; sub < 4; ++sub) {
        const int t0 = seg * 256 + sub * 64;
        const size_t rowbase = (size_t)b * SEQ + t0;

        {
            float cw[4][8], cb[8];
#pragma unroll
            for (int k = 0; k < 4; ++k) { const f32x4 a = *(const LAS f32x4*)(CW + k * 512 + c8), bq = *(const LAS f32x4*)(CW + k * 512 + c8 + 4);
#pragma unroll
                for (int q = 0; q < 4; ++q) { cw[k][q] = a[q]; cw[k][4 + q] = bq[q]; } }
            { const f32x4 a = *(const LAS f32x4*)(CW + 2048 + c8), bq = *(const LAS f32x4*)(CW + 2048 + c8 + 4);
#pragma unroll
                for (int q = 0; q < 4; ++q) { cb[q] = a[q]; cb[4 + q] = bq[q]; } }
            u32x4 xw[4];
#pragma unroll
            for (int k = 0; k < 3; ++k) { const int tl = tg * 8 - 3 + k; xw[k] = (t0 + tl >= 0) ? *(const u32x4*)(PROJ + proj_off(rowbase + tl, 3072) + c8) : (u32x4){0u, 0u, 0u, 0u}; }
#pragma unroll
            for (int i = 0; i < 8; ++i) {
                const int tl = tg * 8 + i;
                xw[3] = *(const u32x4*)(PROJ + proj_off(rowbase + tl, 3072) + c8);
                float uo[8];
#pragma unroll
                for (int q = 0; q < 4; ++q) {
                    float lo = cb[2 * q], hi = cb[2 * q + 1];
#pragma unroll
                    for (int k = 0; k < 4; ++k) { lo += cw[k][2 * q] * bf_lo(xw[k][q]); hi += cw[k][2 * q + 1] * bf_hi(xw[k][q]); }
                    uo[2 * q] = lo; uo[2 * q + 1] = hi;
                }
                u32x4 o; o.x = cvt_pk_bf16(uo[0], uo[1]); o.y = cvt_pk_bf16(uo[2], uo[3]); o.z = cvt_pk_bf16(uo[4], uo[5]); o.w = cvt_pk_bf16(uo[6], uo[7]);
                *(LAS u32x4*)(U + tl * 520 + c8) = o;
                xw[0] = xw[1]; xw[1] = xw[2]; xw[2] = xw[3];
            }
        }
        __syncthreads();
#pragma unroll 1
        for (int tt = 0; tt < 4; ++tt) {
            bf16x8 a0 = *(const LAS bf16x8*)(U + (tt * 16 + fr) * 520 + w * 64 + fq * 8);
            bf16x8 a1 = *(const LAS bf16x8*)(U + (tt * 16 + fr) * 520 + w * 64 + 32 + fq * 8);
#pragma unroll
            for (int n = 0; n < 4; ++n) {
                f32x4 ar = (f32x4){ba[n], ba[n], ba[n], ba[n]}, ai = (f32x4){bx[n], bx[n], bx[n], bx[n]};
                ar = __builtin_amdgcn_mfma_f32_16x16x32_bf16(a0, Ba[n][0], ar, 0, 0, 0); ar = __builtin_amdgcn_mfma_f32_16x16x32_bf16(a1, Ba[n][1], ar, 0, 0, 0);
                ai = __builtin_amdgcn_mfma_f32_16x16x32_bf16(a0, Bx[n][0], ai, 0, 0, 0); ai = __builtin_amdgcn_mfma_f32_16x16x32_bf16(a1, Bx[n][1], ai, 0, 0, 0);
                const int c = w * 64 + n * 16 + fr;
                float av[4], bv[4];
#pragma unroll
                for (int jj = 0; jj < 4; ++jj) {
                    const int t = tt * 16 + fq * 4 + jj;
                    const float u = bf2f(U[t * 520 + c]);
                    const float r = sigmoid_(ar[jj]), ig = sigmoid_(ai[jj]);
                    const float a = __builtin_amdgcn_exp2f(-r * sp[n]);
                    const float beta = __builtin_amdgcn_sqrtf(fmaxf(1.0f - a * a, 0.f));
                    av[jj] = a; bv[jj] = beta * ig * u;
                }
                const float A4 = (av[0] * av[1]) * (av[2] * av[3]);
                const float B4 = ((bv[0] * av[1] + bv[1]) * av[2] + bv[2]) * av[3] + bv[3];
                float hs = h[n];
#pragma unroll
                for (int g = 0; g < 4; ++g) {
                    const float he = A4 * hs + B4;
                    const float nx = __shfl(he, fr + 16 * g);
                    if (fq > g) hs = nx;
                    if (g == 3) h[n] = nx;
                }
                if (PASS == 1) { float pp = A4; pp *= __shfl_xor(pp, 16); pp *= __shfl_xor(pp, 32); P[n] *= pp; }
                if (PASS == 2) {
                    float xh = hs;
#pragma unroll
                    for (int jj = 0; jj < 4; ++jj) { xh = av[jj] * xh + bv[jj]; HS[(tt * 16 + fq * 4 + jj) * 520 + c] = f2bf(xh); }
                }
            }
        }
        if (PASS == 2) {
            __syncthreads();
            u32x4 gpre[8];
#pragma unroll
            for (int i = 0; i < 8; ++i) gpre[i] = *(const u32x4*)(PROJ + proj_off(rowbase + tg * 8 + i, 3072) + 512 + c8);
#pragma unroll
            for (int i = 0; i < 8; ++i) {
                const int tl = tg * 8 + i;
                const u32x4 hv = *(const LAS u32x4*)(HS + tl * 520 + c8);
                const u32x4 gv = gpre[i];
                u32x4 o;
#pragma unroll
                for (int q = 0; q < 4; ++q) o[q] = cvt_pk_bf16(bf_lo(hv[q]) * gelu_tanh(bf_lo(gv[q])), bf_hi(hv[q]) * gelu_tanh(bf_hi(gv[q])));
                *(u32x4*)(Y + tiled(rowbase + tl, c8, 1024)) = o;
            }
        }
        __syncthreads();
    }
    if (PASS == 1) {
        if (fq == 0) {
#pragma unroll
            for (int n = 0; n < 4; ++n) { const int c = w * 64 + n * 16 + fr; Pbuf[(size_t)item * 512 + c] = P[n]; Hbuf[(size_t)item * 512 + c] = h[n]; }
        }
    }
}


__device__ __forceinline__ void hgrn_bcum2(LAS float* BC, LAS float* PT, const u32x4 (&zv)[2], const float (&lb)[8], int tid, float (&kout)[2][8]) {
    {
        const int d8 = (tid & 15) * 8, t = tid >> 4;
#pragma unroll
        for (int rr = 0; rr < 2; ++rr) {
            const int tr = t + rr * 32;
            float lf[8];
#pragma unroll
            for (int q = 0; q < 4; ++q) {
                const float z0 = bf_lo(zv[rr][q]), z1 = bf_hi(zv[rr][q]);
                const float k0 = (1.0f - lb[2 * q]) * sigmoid_(-z0), k1 = (1.0f - lb[2 * q + 1]) * sigmoid_(-z1);
                kout[rr][2 * q] = k0; kout[rr][2 * q + 1] = k1;
                lf[2 * q] = __logf(fmaxf(1.0f - k0, 1e-20f));
                lf[2 * q + 1] = __logf(fmaxf(1.0f - k1, 1e-20f));
            }
            *(LAS f32x4*)(BC + tr * 128 + d8) = (f32x4){lf[0], lf[1], lf[2], lf[3]};
            *(LAS f32x4*)(BC + tr * 128 + d8 + 4) = (f32x4){lf[4], lf[5], lf[6], lf[7]};
        }
    }
    __syncthreads();
    const int d = tid & 127, part = tid >> 7;
    {
        float a = 0.f;
#pragma unroll
        for (int i = 0; i < 16; ++i) { const int t = part * 16 + i; a += BC[t * 128 + d]; BC[t * 128 + d] = a; }
        PT[part * 128 + d] = a;
    }
    __syncthreads();
}
struct HcPre { u32x4 zv[2], vv[2], qv[2], gp[2]; };
template <int PASS>
__device__ __forceinline__ void hgrn2_load(const Params& p, int item, int c, HcPre& r) {
    int tid = threadIdx.x; asm volatile("" : "+v"(tid));
    const int bh = item >> 3, sup = item & 7, b = bh >> 2, h = bh & 3;
    const bf16_t* PROJ = (const bf16_t*)(p.ws + WS_BIG);
    const size_t rowbase = (size_t)b * SEQ + (size_t)(sup * 8 + c) * 64;
    const int d8 = (tid & 15) * 8, t = tid >> 4;
#pragma unroll
    for (int rr = 0; rr < 2; ++rr) {
        r.zv[rr] = *(const u32x4*)(PROJ + proj_off(rowbase + t + rr * 32, 3072) + 1536 + h * 128 + d8);
        r.vv[rr] = *(const u32x4*)(PROJ + proj_off(rowbase + t + rr * 32, 3072) + 2048 + h * 128 + d8);
        if (PASS == 2) r.qv[rr] = *(const u32x4*)(PROJ + proj_off(rowbase + t + rr * 32, 3072) + 1024 + h * 128 + d8);
    }
    if (PASS == 2) {
        const bf16_t* gp = PROJ + proj_off(rowbase + (tid >> 3), 3072) + 2560 + h * 128 + (tid & 7) * 16;
        r.gp[0] = *(const u32x4*)gp; r.gp[1] = *(const u32x4*)(gp + 8);
    }
}
template <int PASS>
__device__ __forceinline__ void hgrn2_init(const Params& p, int item, f32x4 (&S)[8], float (&Gt)[4]) {
    int tid = threadIdx.x; asm volatile("" : "+v"(tid));
    const int lane = tid & 63, w = __builtin_amdgcn_readfirstlane(tid >> 6), fq = lane >> 4;
#pragma unroll
    for (int n = 0; n < 8; ++n) S[n] = (f32x4){0.f, 0.f, 0.f, 0.f};
#pragma unroll
    for (int jj = 0; jj < 4; ++jj) Gt[jj] = 1.0f;
    if (PASS == 2) {
        const int bh = item >> 3, sup = item & 7;
        const float* SUMb = (const float*)(p.ws + WS_ST); const float* GTb = (const float*)(p.ws + WS_HGG);
        for (int s2 = 0; s2 < sup; ++s2) {
            const size_t it2 = (size_t)bh * 8 + s2;
            const f32x4 g4 = *(const f32x4*)(GTb + it2 * 128 + w * 16 + fq * 4);
#pragma unroll
            for (int n = 0; n < 8; ++n) { const f32x4 T = *(const f32x4*)(SUMb + it2 * 16384 + (size_t)((n * 8 + w) * 64 + lane) * 4); S[n] = g4 * S[n] + T; }
        }
    }
}
__device__ __forceinline__ void hgrn2_finish(const Params& p, int item, const f32x4 (&S)[8], const float (&Gt)[4]) {
    int tid = threadIdx.x; asm volatile("" : "+v"(tid));
    const int lane = tid & 63, w = __builtin_amdgcn_readfirstlane(tid >> 6), fr = lane & 15, fq = lane >> 4;
    float* SUMb = (float*)(p.ws + WS_ST); float* GTb = (float*)(p.ws + WS_HGG);
#pragma unroll
    for (int n = 0; n < 8; ++n) *(f32x4*)(SUMb + (size_t)item * 16384 + (size_t)((n * 8 + w) * 64 + lane) * 4) = S[n];
    if (fr == 0) *(f32x4*)(GTb + (size_t)item * 128 + w * 16 + fq * 4) = (f32x4){Gt[0], Gt[1], Gt[2], Gt[3]};
}
template <int PASS>
__device__ __forceinline__ void hgrn2_chunk(LAS unsigned char* lds, const Params& p, int j, int item, int c, const HcPre& pre, f32x4 (&S)[8], float (&Gt)[4]) {
    int tid = threadIdx.x; asm volatile("" : "+v"(tid));
    const int lane = tid & 63, w = __builtin_amdgcn_readfirstlane(tid >> 6), fr = lane & 15, fq = lane >> 4;
    const int bh = item >> 3, sup = item & 7, b = bh >> 2, h = bh & 3;
    bf16_t* Y = (bf16_t*)(p.ws + WS_Y);
    const size_t rowbase = (size_t)b * SEQ + (size_t)(sup * 8 + c) * 64;
    LAS float* BC = (LAS float*)lds;
    LAS bf16_t* QA = (LAS bf16_t*)(lds + 32768);
    LAS bf16_t* KA = (LAS bf16_t*)(lds + 50176);
    LAS bf16_t* VT = (LAS bf16_t*)(lds + 67584);
    LAS bf16_t* SS = (LAS bf16_t*)(lds + 86016);
    LAS bf16_t* AT = (LAS bf16_t*)(lds + 120832);
    LAS float* PT = (LAS float*)(lds + 130048);
    LAS bf16_t* VN = SS;
    const float* lbl = p.in[11];
    const int d8 = (tid & 15) * 8, t = tid >> 4;
    u32x4 zv[2], vv[2], qv[2], gpre[2]; float lb[8];
#pragma unroll
    for (int rr = 0; rr < 2; ++rr) { zv[rr] = pre.zv[rr]; vv[rr] = pre.vv[rr]; if (PASS == 2) { qv[rr] = pre.qv[rr]; gpre[rr] = pre.gp[rr]; } }
    f32x4 gnv[4];
    if (PASS == 2) {
        const float* gn0 = p.in[12] + j * 512 + h * 128 + (tid & 7) * 16;
#pragma unroll
        for (int q = 0; q < 4; ++q) gnv[q] = *(const f32x4*)(gn0 + q * 4);
    }
#pragma unroll
    for (int q = 0; q < 8; ++q) { const int ch = h * 128 + d8 + q; lb[q] = (j == 0) ? 0.f : sigmoid_(lbl[512 + ch] - lbl[ch]); }
#pragma unroll
    for (int rr = 0; rr < 2; ++rr) *(LAS u32x4*)(VN + (t + rr * 32) * 136 + d8) = vv[rr];
    float kq[2][8];
    hgrn_bcum2(BC, PT, zv, lb, tid, kq);
    {
        float bref[8], c1[8], c2[8], c3[8];
        {
            const f32x4 pa0 = *(const LAS f32x4*)(PT + d8), pa1 = *(const LAS f32x4*)(PT + d8 + 4);
            const f32x4 pb0 = *(const LAS f32x4*)(PT + 128 + d8), pb1 = *(const LAS f32x4*)(PT + 128 + d8 + 4);
            const f32x4 pc0 = *(const LAS f32x4*)(PT + 256 + d8), pc1 = *(const LAS f32x4*)(PT + 256 + d8 + 4);
#pragma unroll
            for (int q = 0; q < 4; ++q) { c1[q] = pa0[q]; c1[4 + q] = pa1[q]; c2[q] = pa0[q] + pb0[q]; c2[4 + q] = pa1[q] + pb1[q]; c3[q] = c2[q] + pc0[q]; c3[4 + q] = c2[4 + q] + pc1[q]; }
        }
        const bool hi16 = (t >> 4) != 0;
#pragma unroll
        for (int q = 0; q < 8; ++q) bref[q] = BC[31 * 128 + d8 + q] + c1[q];
#pragma unroll
        for (int rr = 0; rr < 2; ++rr) {
            const int tr = t + rr * 32;
            float qa[8], ka[8];
#pragma unroll
            for (int q = 0; q < 8; ++q) {
                const float bc = BC[tr * 128 + d8 + q] + (rr == 0 ? (hi16 ? c1[q] : 0.f) : (hi16 ? c3[q] : c2[q]));
                const float dq = fminf(fmaxf(bc - bref[q], -80.f), 80.f);
                const float e1 = __expf(dq);
                if (PASS == 2) { const float qq = silu_((q & 1) ? bf_hi(qv[rr][q >> 1]) : bf_lo(qv[rr][q >> 1])); qa[q] = qq * e1; }
                ka[q] = kq[rr][q] * rcp_(e1);
            }
            u32x4 o;
            if (PASS == 2) {
#pragma unroll
                for (int q = 0; q < 4; ++q) o[q] = cvt_pk_bf16(qa[2 * q], qa[2 * q + 1]);
                *(LAS u32x4*)(QA + tr * 136 + d8) = o;
            }
#pragma unroll
            for (int q = 0; q < 4; ++q) o[q] = cvt_pk_bf16(ka[2 * q], ka[2 * q + 1]);
            *(LAS u32x4*)(KA + tr * 136 + d8) = o;
        }
        {
            const int e = tid & 127, tq = tid >> 7;
            bf16_t vq[16];
#pragma unroll
            for (int i = 0; i < 16; ++i) vq[i] = VN[(tq * 16 + i) * 136 + e];
            u32x4 p0, p1;
#pragma unroll
            for (int q = 0; q < 4; ++q) { p0[q] = (unsigned)vq[2 * q] | ((unsigned)vq[2 * q + 1] << 16); p1[q] = (unsigned)vq[8 + 2 * q] | ((unsigned)vq[8 + 2 * q + 1] << 16); }
            *(LAS u32x4*)(VT + e * 72 + tq * 16) = p0; *(LAS u32x4*)(VT + e * 72 + tq * 16 + 8) = p1;
        }
    }
    float gsc[4], sc[4], eb[4];
#pragma unroll
    for (int jj = 0; jj < 4; ++jj) { const int dd = w * 16 + fq * 4 + jj; const float p0 = PT[dd], br = BC[31 * 128 + dd] + p0, bl = BC[63 * 128 + dd] + ((p0 + PT[128 + dd]) + PT[256 + dd]); gsc[jj] = __expf(bl); sc[jj] = __expf(bl - br); eb[jj] = __expf(br); }
    __syncthreads();
    if (PASS == 2) {
#pragma unroll
        for (int n = 0; n < 8; ++n) { u32x2 o; o.x = cvt_pk_bf16(S[n][0] * eb[0], S[n][1] * eb[1]); o.y = cvt_pk_bf16(S[n][2] * eb[2], S[n][3] * eb[3]);
            *(LAS u32x2*)(SS + (n * 16 + fr) * 136 + w * 16 + fq * 4) = o; }
        {
            const int tt = w >> 1;
#pragma unroll
            for (int si = 0; si < 2; ++si) {
                const int ss = (w & 1) * 2 + si;
                f32x4 acc = (f32x4){0.f, 0.f, 0.f, 0.f};
                if (ss <= tt) {
#pragma unroll
                    for (int kk = 0; kk < 4; ++kk) {
                        const bf16x8 a = *(const LAS bf16x8*)(QA + (tt * 16 + fr) * 136 + kk * 32 + fq * 8);
                        const bf16x8 bb = *(const LAS bf16x8*)(KA + (ss * 16 + fr) * 136 + kk * 32 + fq * 8);
                        acc = __builtin_amdgcn_mfma_f32_16x16x32_bf16(a, bb, acc, 0, 0, 0);
                    }
                }
#pragma unroll
                for (int jj = 0; jj < 4; ++jj) {
                    const int tq2 = tt * 16 + fq * 4 + jj, sq2 = ss * 16 + fr;
                    const float v = (sq2 <= tq2) ? acc[jj] : 0.f;
                    AT[tq2 * 72 + sq2] = f2bf(v);
                }
            }
        }
        __syncthreads();
        {
            const int tt = w >> 1, n0 = (w & 1) * 4;
            f32x4 acc[4];
#pragma unroll
            for (int n = 0; n < 4; ++n) acc[n] = (f32x4){0.f, 0.f, 0.f, 0.f};
#pragma unroll
            for (int kk = 0; kk < 4; ++kk) {
                const bf16x8 a = *(const LAS bf16x8*)(QA + (tt * 16 + fr) * 136 + kk * 32 + fq * 8);
#pragma unroll
                for (int n = 0; n < 4; ++n) { const bf16x8 bb = *(const LAS bf16x8*)(SS + ((n0 + n) * 16 + fr) * 136 + kk * 32 + fq * 8); acc[n] = __builtin_amdgcn_mfma_f32_16x16x32_bf16(a, bb, acc[n], 0, 0, 0); }
            }
#pragma unroll
            for (int kk = 0; kk < 2; ++kk) {
                if (kk * 32 <= tt * 16 + 15) {
                    const bf16x8 a = *(const LAS bf16x8*)(AT + (tt * 16 + fr) * 72 + kk * 32 + fq * 8);
#pragma unroll
                    for (int n = 0; n < 4; ++n) { const bf16x8 bb = *(const LAS bf16x8*)(VT + ((n0 + n) * 16 + fr) * 72 + kk * 32 + fq * 8); acc[n] = __builtin_amdgcn_mfma_f32_16x16x32_bf16(a, bb, acc[n], 0, 0, 0); }
                }
            }
            LAS float* OS = BC;
#pragma unroll
            for (int n = 0; n < 4; ++n)
#pragma unroll
                for (int jj = 0; jj < 4; ++jj) OS[(tt * 16 + fq * 4 + jj) * 128 + (n0 + n) * 16 + fr] = acc[n][jj];
        }
    }
    {
        bf16x8 af[2];
#pragma unroll
        for (int kk = 0; kk < 2; ++kk)
#pragma unroll
            for (int i = 0; i < 8; ++i) af[kk][i] = (short)KA[(kk * 32 + fq * 8 + i) * 136 + w * 16 + fr];
#pragma unroll
        for (int n = 0; n < 8; ++n) {
            f32x4 acc = (f32x4){0.f, 0.f, 0.f, 0.f};
#pragma unroll
            for (int kk = 0; kk < 2; ++kk) { const bf16x8 bb = *(const LAS bf16x8*)(VT + (n * 16 + fr) * 72 + kk * 32 + fq * 8); acc = __builtin_amdgcn_mfma_f32_16x16x32_bf16(af[kk], bb, acc, 0, 0, 0); }
#pragma unroll
            for (int jj = 0; jj < 4; ++jj) S[n][jj] = gsc[jj] * S[n][jj] + sc[jj] * acc[jj];
        }
        if (PASS == 1) {
#pragma unroll
            for (int jj = 0; jj < 4; ++jj) Gt[jj] *= gsc[jj];
        }
    }
    if (PASS == 2) {
        __syncthreads();
        LAS float* OS = BC;
        const int t2 = tid >> 3, e16 = (tid & 7) * 16;
        f32x4 ov[4]; float ss = 0.f;
#pragma unroll
        for (int q = 0; q < 4; ++q) { ov[q] = *(const LAS f32x4*)(OS + t2 * 128 + e16 + q * 4); ss += (ov[q][0] * ov[q][0] + ov[q][1] * ov[q][1]) + (ov[q][2] * ov[q][2] + ov[q][3] * ov[q][3]); }
        ss += __shfl_xor(ss, 1); ss += __shfl_xor(ss, 2); ss += __shfl_xor(ss, 4);
        const float rstd = rsqrtf(ss * (1.0f / 128.0f) + EPS);
        bf16_t* yp = Y + tiled(rowbase + t2, 512 + h * 128 + e16, 1024);
#pragma unroll
        for (int hlf = 0; hlf < 2; ++hlf) {
            const u32x4 gv = gpre[hlf];
            const f32x4 n0v = gnv[hlf * 2], n1v = gnv[hlf * 2 + 1];
            u32x4 o;
#pragma unroll
            for (int q = 0; q < 4; ++q) {
                const float o0 = ov[hlf * 2 + (q >> 1)][(q & 1) * 2], o1 = ov[hlf * 2 + (q >> 1)][(q & 1) * 2 + 1];
                const float g0 = (q < 2) ? n0v[2 * q] : n1v[2 * q - 4], g1 = (q < 2) ? n0v[2 * q + 1] : n1v[2 * q - 3];
                o[q] = cvt_pk_bf16(o0 * rstd * g0 * silu_(bf_lo(gv[q])), o1 * rstd * g1 * silu_(bf_hi(gv[q])));
            }
            *(u32x4*)(yp + hlf * 8) = o;
        }
        __syncthreads();
    }
}
template <int PASS>
__device__ __forceinline__ void hgrn2_run(LAS unsigned char* lds, const Params& p, int j, int bid, int G, int nitems) {
    f32x4 S[8]; float Gt[4]; HcPre nxt;
    const int nsteps = nitems * 8;
    if (nsteps <= 0) return;
    hgrn2_load<PASS>(p, bid, 0, nxt);
#pragma unroll 1
    for (int step = 0; step < nsteps; ++step) {
        const bool mir = (G == 32) && (nitems == 2);
        const int k0 = step >> 3, k1 = (step + 1) >> 3;
        const int item = (mir && k0 == 1) ? ((bid & ~31) + 32 + ((bid & 31) ^ 7)) : bid + k0 * G, c = step & 7;
        const HcPre cur = nxt;
        if (step + 1 < nsteps) hgrn2_load<PASS>(p, (mir && k1 == 1) ? ((bid & ~31) + 32 + ((bid & 31) ^ 7)) : bid + k1 * G, (step + 1) & 7, nxt);
        if (c == 0) hgrn2_init<PASS>(p, item, S, Gt);
        hgrn2_chunk<PASS>(lds, p, j, item, c, cur, S, Gt);
        if (PASS == 1 && c == 7) hgrn2_finish(p, item, S, Gt);
    }
    __syncthreads();
}

struct SguPre { u32x4 vv[4]; u32x2 uv[8]; };
__device__ __forceinline__ void sgu_load(const Params& p, int item, SguPre& r) {
    int tid = threadIdx.x; asm volatile("" : "+v"(tid));
    const int lane = tid & 63, w = __builtin_amdgcn_readfirstlane(tid >> 6), fr = lane & 15, fq = lane >> 4;
    const int g = item & 3, n = (item >> 2) & 31, b = item >> 7;
    const bf16_t* PROJ = (const bf16_t*)(p.ws + WS_BIG);
    const size_t rowbase = (size_t)b * SEQ + n * 128;
    const bf16_t* vp = PROJ + proj_off(rowbase + (tid >> 2), 1536) + 512 + g * 128 + (tid & 3) * 32;
#pragma unroll
    for (int i = 0; i < 4; ++i) r.vv[i] = *(const u32x4*)(vp + i * 8);
    const bf16_t* up = PROJ + proj_off(rowbase + w * 16 + fr, 1536) + g * 128 + fq * 4;
#pragma unroll
    for (int q = 0; q < 8; ++q) r.uv[q] = *(const u32x2*)(up + q * 16);
}
__device__ __forceinline__ void sgu_weights(LAS unsigned char* lds, const Params& p, int j, int g) {
    int tid = threadIdx.x; asm volatile("" : "+v"(tid));
    LAS bf16_t* WL = (LAS bf16_t*)(lds + 69632);
    const bf16_t* Wm = (const bf16_t*)(p.ws + WS_SMALL + SM_SGUW) + (size_t)(j * 4 + g) * 16384;
#pragma unroll
    for (int i = 0; i < 4; ++i) { const int idx = tid + i * 512; *(LAS u32x4*)(WL + (idx >> 4) * 136 + (idx & 15) * 8) = *(const u32x4*)(Wm + (idx >> 4) * 128 + (idx & 15) * 8); }
}
__device__ __forceinline__ void sgu_item(LAS unsigned char* lds, const Params& p, int j, int item, const SguPre& pre) {
    int tid = threadIdx.x; asm volatile("" : "+v"(tid));
    const int lane = tid & 63, w = __builtin_amdgcn_readfirstlane(tid >> 6), fr = lane & 15, fq = lane >> 4;
    const int g = item & 3, n = (item >> 2) & 31, b = item >> 7;
    bf16_t* Y = (bf16_t*)(p.ws + WS_Y);
    const size_t rowbase = (size_t)b * SEQ + n * 128;
    LAS bf16_t* VT = (LAS bf16_t*)lds;
    LAS bf16_t* WL = (LAS bf16_t*)(lds + 69632);
    const int tC = w * 16 + fr;
    u32x2 uv[8];
#pragma unroll
    for (int q = 0; q < 8; ++q) uv[q] = pre.uv[q];
    {
        const int s = tid >> 2, qtr = tid & 3;
        float v[32]; float sum = 0.f;
#pragma unroll
        for (int i = 0; i < 4; ++i) { const u32x4 vv = pre.vv[i];
#pragma unroll
            for (int q = 0; q < 4; ++q) { v[i * 8 + 2 * q] = bf_lo(vv[q]); v[i * 8 + 2 * q + 1] = bf_hi(vv[q]); sum += v[i * 8 + 2 * q] + v[i * 8 + 2 * q + 1]; } }
        sum += __shfl_xor(sum, 1); sum += __shfl_xor(sum, 2);
        const float mu = sum * (1.0f / 128.0f); float var = 0.f;
#pragma unroll
        for (int i = 0; i < 32; ++i) { v[i] -= mu; var += v[i] * v[i]; }
        var += __shfl_xor(var, 1); var += __shfl_xor(var, 2);
        const float rstd = rsqrtf(var * (1.0f / 128.0f) + EPS);
        LAS bf16_t* VN = (LAS bf16_t*)(lds + 34816);
#pragma unroll
        for (int i = 0; i < 4; ++i) { u32x4 o;
#pragma unroll
            for (int q = 0; q < 4; ++q) o[q] = cvt_pk_bf16(v[i * 8 + 2 * q] * rstd, v[i * 8 + 2 * q + 1] * rstd);
            *(LAS u32x4*)(VN + s * 136 + qtr * 32 + i * 8) = o; }
    }
    __syncthreads();
    {
        LAS const bf16_t* VN = (LAS const bf16_t*)(lds + 34816);
        const int c = tid & 127, sq = tid >> 7;
        bf16_t vq[32];
#pragma unroll
        for (int i = 0; i < 32; ++i) vq[i] = VN[(sq * 32 + i) * 136 + c];
#pragma unroll
        for (int i = 0; i < 4; ++i) { u32x4 o;
#pragma unroll
            for (int q = 0; q < 4; ++q) o[q] = (unsigned)vq[i * 8 + 2 * q] | ((unsigned)vq[i * 8 + 2 * q + 1] << 16);
            *(LAS u32x4*)(VT + c * 136 + sq * 32 + i * 8) = o; }
    }
    __syncthreads();
    {
        f32x4 acc[8];
#pragma unroll
        for (int q = 0; q < 8; ++q) acc[q] = (f32x4){0.f, 0.f, 0.f, 0.f};
        const int kmax = w >> 1;
#pragma unroll
        for (int kk = 0; kk < 4; ++kk) {
            if (kk <= kmax) {
                const bf16x8 wf = *(const LAS bf16x8*)(WL + (w * 16 + fr) * 136 + kk * 32 + fq * 8);
#pragma unroll
                for (int q = 0; q < 8; ++q) { const bf16x8 vf = *(const LAS bf16x8*)(VT + (q * 16 + fr) * 136 + kk * 32 + fq * 8); acc[q] = __builtin_amdgcn_mfma_f32_16x16x32_bf16(vf, wf, acc[q], 0, 0, 0); }
            }
        }
        const float bias = p.in[16][(size_t)(j * 4 + g) * 128 + tC];
        bf16_t* yp = Y + tiled(rowbase + tC, g * 128 + fq * 4, 1024);
#pragma unroll
        for (int q = 0; q < 8; ++q) {
            u32x2 o; o.x = cvt_pk_bf16(bf_lo(uv[q].x) * (acc[q][0] + bias), bf_hi(uv[q].x) * (acc[q][1] + bias)); o.y = cvt_pk_bf16(bf_lo(uv[q].y) * (acc[q][2] + bias), bf_hi(uv[q].y) * (acc[q][3] + bias));
            *(u32x2*)(yp + (q >> 2) * 16384 + (q & 3) * 16) = o;
        }
    }
    __syncthreads();
}

struct PoolPre { u32x4 pl[5]; u32x4 wt[4]; };
__device__ __forceinline__ void pool_load(const Params& p, int j, int item, PoolPre& r) {
    int tid = threadIdx.x; asm volatile("" : "+v"(tid));
    const int gi = item & 3, tile = (item >> 2) & 31, b = item >> 7;
    const bf16_t* PROJ = (const bf16_t*)(p.ws + WS_BIG);
    const int t0 = tile * 128;
    const bf16_t* PWT = (const bf16_t*)(p.ws + WS_SMALL + SM_PWT) + (size_t)(j * 4 + gi) * 16384;
#pragma unroll
    for (int i = 0; i < 4; ++i) { const int idx = tid + i * 512; r.wt[i] = *(const u32x4*)(PWT + (idx >> 4) * 128 + (idx & 15) * 8); }
#pragma unroll
    for (int i = 0; i < 5; ++i) {
        const int idx = tid + i * 512; const int rr = idx >> 4, c8 = (idx & 15) * 8; const int ts = t0 - 16 + rr;
        u32x4 vv = (u32x4){0u, 0u, 0u, 0u};
        if (idx < 144 * 16 && ts >= 0) vv = *(const u32x4*)(PROJ + proj_off((size_t)b * SEQ + ts, 1536) + 1024 + gi * 128 + c8);
        r.pl[i] = vv;
    }
}
__device__ __forceinline__ void pool_item(LAS unsigned char* lds, const Params& p, int j, int item, const PoolPre& pre) {
    int tid = threadIdx.x; asm volatile("" : "+v"(tid));
    const int lane = tid & 63, w = __builtin_amdgcn_readfirstlane(tid >> 6), fr = lane & 15, fq = lane >> 4;
    const int gi = item & 3, tile = (item >> 2) & 31, b = item >> 7;
    bf16_t* Y = (bf16_t*)(p.ws + WS_Y);
    const int t0 = tile * 128;
    const size_t rowbase = (size_t)b * SEQ + t0;
    LAS float* PL = (LAS float*)lds;
    LAS bf16_t* PA = (LAS bf16_t*)(lds + 73728);
    LAS bf16_t* PWL = (LAS bf16_t*)(lds + 108544);
    {
#pragma unroll
        for (int i = 0; i < 5; ++i) {
            const int idx = tid + i * 512;
            if (idx < 144 * 16) {
                const int rr = idx >> 4, c8 = (idx & 15) * 8; const u32x4 vv = pre.pl[i];
                *(LAS f32x4*)(PL + rr * 128 + c8) = (f32x4){bf_lo(vv[0]), bf_hi(vv[0]), bf_lo(vv[1]), bf_hi(vv[1])};
                *(LAS f32x4*)(PL + rr * 128 + c8 + 4) = (f32x4){bf_lo(vv[2]), bf_hi(vv[2]), bf_lo(vv[3]), bf_hi(vv[3])};
            }
        }
#pragma unroll
        for (int i = 0; i < 4; ++i) { const int idx = tid + i * 512; *(LAS u32x4*)(PWL + (idx >> 4) * 136 + (idx & 15) * 8) = pre.wt[i]; }
    }
    __syncthreads();
    {
        const int tg = tid >> 4, c8 = (tid & 15) * 8; const int win = 2 << gi;
        const int tf = tg * 4;
        f32x4 s0 = (f32x4){0.f, 0.f, 0.f, 0.f}, s1 = (f32x4){0.f, 0.f, 0.f, 0.f};
        for (int k = 0; k < win; ++k) { const LAS float* rp = PL + (tf + 16 - k) * 128 + c8; s0 += *(const LAS f32x4*)rp; s1 += *(const LAS f32x4*)(rp + 4); }
#pragma unroll
        for (int i = 0; i < 4; ++i) {
            const int t = tf + i;
            const LAS float* cp = PL + (t + 16) * 128 + c8;
            const f32x4 c0 = *(const LAS f32x4*)cp, c1 = *(const LAS f32x4*)(cp + 4);
            if (i > 0) { const LAS float* op = PL + (t + 16 - win) * 128 + c8; s0 += c0 - *(const LAS f32x4*)op; s1 += c1 - *(const LAS f32x4*)(op + 4); }
            const int tabs = t0 + t; const int cnt = (tabs + 1 < win) ? tabs + 1 : win;
            const float inv = rcp_((float)cnt);
            const f32x4 a = s0 * inv - c0, bq = s1 * inv - c1;
            u32x4 o; o.x = cvt_pk_bf16(a[0], a[1]); o.y = cvt_pk_bf16(a[2], a[3]); o.z = cvt_pk_bf16(bq[0], bq[1]); o.w = cvt_pk_bf16(bq[2], bq[3]);
            *(LAS u32x4*)(PA + t * 136 + c8) = o;
        }
    }
    __syncthreads();
    {
        f32x4 acc[8];
#pragma unroll
        for (int q = 0; q < 8; ++q) acc[q] = (f32x4){0.f, 0.f, 0.f, 0.f};
#pragma unroll
        for (int kk = 0; kk < 4; ++kk) {
            const bf16x8 pf = *(const LAS bf16x8*)(PA + (w * 16 + fr) * 136 + kk * 32 + fq * 8);
#pragma unroll
            for (int q = 0; q < 8; ++q) { const bf16x8 wf = *(const LAS bf16x8*)(PWL + (q * 16 + fr) * 136 + kk * 32 + fq * 8); acc[q] = __builtin_amdgcn_mfma_f32_16x16x32_bf16(wf, pf, acc[q], 0, 0, 0); }
        }
        const int t = w * 16 + fr;
        bf16_t* yp = Y + tiled(rowbase + t, 512 + gi * 128 + fq * 4, 1024);
#pragma unroll
        for (int q = 0; q < 8; ++q) { u32x2 o; o.x = cvt_pk_bf16(acc[q][0], acc[q][1]); o.y = cvt_pk_bf16(acc[q][2], acc[q][3]); *(u32x2*)(yp + (q >> 2) * 16384 + (q & 3) * 16) = o; }
    }
    __syncthreads();
}

__device__ __forceinline__ void zero_y(const Params& p) {
    int tid = threadIdx.x; asm volatile("" : "+v"(tid));
    u32x4* yz = (u32x4*)(p.ws + WS_Y);
    for (size_t i = (size_t)blockIdx.x * NTHR + tid; i < (size_t)MTOK * 128; i += (size_t)gridDim.x * NTHR) yz[i] = (u32x4){0u, 0u, 0u, 0u};
}
__device__ __forceinline__ void final_norm(const Params& p) {
    int tid = threadIdx.x; asm volatile("" : "+v"(tid));
    const int lane = tid & 63, wave = tid >> 6;
    const int gw = blockIdx.x * 8 + wave, NGW = gridDim.x * 8;
    const float* rowss = (const float*)(p.ws + WS_ROWSS); const float* gain = p.in[22];
    f32x4 gv[4];
#pragma unroll
    for (int q = 0; q < 4; ++q) gv[q] = *((const f32x4*)gain + lane + 64 * q);
    for (int row = gw; row < MTOK; row += 2 * NGW) {
        const int row2 = row + NGW;
        f32x4* hr = (f32x4*)(p.out + (size_t)row * DM) + lane; f32x4* hr2 = (f32x4*)(p.out + (size_t)row2 * DM) + lane;
        f32x4 v[4], v2[4];
#pragma unroll
        for (int q = 0; q < 4; ++q) { v[q] = hr[64 * q]; v2[q] = hr2[64 * q]; }
        const f32x4* sp = (const f32x4*)(rowss + (size_t)row * 16); const f32x4* sp2 = (const f32x4*)(rowss + (size_t)row2 * 16);
        const f32x4 st = (sp[0] + sp[1]) + (sp[2] + sp[3]), st2 = (sp2[0] + sp2[1]) + (sp2[2] + sp2[3]);
        const float rstd = rsqrtf(((st[0] + st[1]) + (st[2] + st[3])) * (1.0f / 1024.0f) + EPS);
        const float rstd2 = rsqrtf(((st2[0] + st2[1]) + (st2[2] + st2[3])) * (1.0f / 1024.0f) + EPS);
#pragma unroll
        for (int q = 0; q < 4; ++q) { hr[64 * q] = v[q] * rstd * gv[q]; hr2[64 * q] = v2[q] * rstd2 * gv[q]; }
    }
}

#define XB_TMO      128
#define XB_XCNT(j)  (256  + 64 * (j))
#define XB_XSUB(j)  (1280 + 64 * (j))
#define XB_XGEN(j)  (2304 + 64 * (j))
#define XB_TOP      3328
#define XB_TOPGEN   3392
#define XCD_BAR_WORDS 3456
#define XB_SPIN_CAP (1u << 18)
__device__ __forceinline__ unsigned xb_ld(unsigned* p)              { return __hip_atomic_load(p, __ATOMIC_RELAXED, __HIP_MEMORY_SCOPE_AGENT); }
__device__ __forceinline__ unsigned xb_add(unsigned* p, unsigned v) { return __hip_atomic_fetch_add(p, v, __ATOMIC_RELAXED, __HIP_MEMORY_SCOPE_AGENT); }
__device__ __forceinline__ unsigned xb_xcc_id() { return (unsigned)__builtin_amdgcn_s_getreg((3 << 11) | 20) & 0xFu; }
#define XB_SPIN(cond, bar) do { unsigned _sp = 0; while (cond) { __builtin_amdgcn_s_sleep(1); \
    if ((++_sp & 255u) == 0u) { if (xb_ld(&(bar)[XB_TMO])) break; if (_sp > XB_SPIN_CAP) { atomicAdd(&(bar)[XB_TMO], 1u); break; } } } } while (0)
struct XcdBarrier { unsigned* bar; unsigned x; volatile LAS unsigned* st; };
__device__ __forceinline__ XcdBarrier xcd_barrier_post(unsigned* bar, volatile LAS unsigned* st) {
    XcdBarrier b; b.bar = bar; b.x = xb_xcc_id(); b.st = st;
    if (threadIdx.x == 0) (void)xb_add(&bar[XB_XCNT(b.x)], 1u);
    return b;
}
__device__ __forceinline__ void xcd_barrier_complete(unsigned* bar, unsigned x, unsigned& nloc, unsigned& nx) {
    const unsigned G = gridDim.x * gridDim.y * gridDim.z;
    unsigned sum, cnt, mine, sp = 0u;
    for (;;) {
        sum = 0u; cnt = 0u; mine = 0u;
#pragma unroll
        for (unsigned j = 0; j < 16; ++j) { const unsigned c = xb_ld(&bar[XB_XCNT(j)]); sum += c; cnt += (c > 0u) ? 1u : 0u; mine = (j == x) ? c : mine; }
        if (sum == G) break;
        __builtin_amdgcn_s_sleep(1);
        if ((++sp & 255u) == 0u) { if (xb_ld(&bar[XB_TMO])) break; if (sp > XB_SPIN_CAP) { atomicAdd(&bar[XB_TMO], 1u); break; } }
    }
    nloc = mine > 0u ? mine : 1u; nx = cnt > 0u ? cnt : 1u;
}
__device__ __forceinline__ void xcd_barrier(const XcdBarrier& b) {
    asm volatile("s_waitcnt vmcnt(0)" ::: "memory");
    __syncthreads();
    if (threadIdx.x == 0) {
        unsigned* bar = b.bar;
        __builtin_amdgcn_s_waitcnt(0);
        unsigned nloc = b.st[0], nx = b.st[1];
        if (nloc == 0u) { xcd_barrier_complete(bar, b.x, nloc, nx); b.st[0] = nloc; b.st[1] = nx; }
        const unsigned old = xb_add(&bar[XB_XSUB(b.x)], 1u);
        const unsigned gen = old / nloc;
        if (old + 1u == (gen + 1u) * nloc) {
            __builtin_amdgcn_fence(__ATOMIC_RELEASE, "agent");
            asm volatile("s_waitcnt vmcnt(0)" ::: "memory");
            const unsigned og = xb_add(&bar[XB_TOP], 1u);
            const unsigned tg = og / nx;
            if (og + 1u == (tg + 1u) * nx) xb_add(&bar[XB_TOPGEN], 1u);
            else XB_SPIN(xb_ld(&bar[XB_TOPGEN]) == tg, bar);
            __builtin_amdgcn_fence(__ATOMIC_ACQUIRE, "agent");
            xb_add(&bar[XB_XGEN(b.x)], 1u);
            asm volatile("s_waitcnt vmcnt(0)" ::: "memory");
        } else {
            XB_SPIN(xb_ld(&bar[XB_XGEN(b.x)]) == gen, bar);
            __builtin_amdgcn_fence(__ATOMIC_ACQUIRE, "agent");
            asm volatile("s_waitcnt vmcnt(0)" ::: "memory");
        }
    }
    __syncthreads();
}

__device__ __forceinline__ void xcd_local_barrier(const XcdBarrier& b) {
    asm volatile("s_waitcnt vmcnt(0)" ::: "memory");
    __syncthreads();
    if (threadIdx.x == 0) {
        unsigned* bar = b.bar;
        __builtin_amdgcn_s_waitcnt(0);
        const unsigned nloc = b.st[0];
        const unsigned old = xb_add(&bar[XB_XSUB(b.x)], 1u);
        const unsigned gen = old / nloc;
        if (old + 1u == (gen + 1u) * nloc) xb_add(&bar[XB_XGEN(b.x)], 1u);
        else XB_SPIN(xb_ld(&bar[XB_XGEN(b.x)]) == gen, bar);
        __builtin_amdgcn_fence(__ATOMIC_ACQUIRE, "agent");
        asm volatile("s_waitcnt vmcnt(0)" ::: "memory");
    }
    __syncthreads();
}

__global__ void __launch_bounds__(NTHR, 2) fwd_megakernel(Params p) {
    extern __shared__ __attribute__((aligned(16))) unsigned char lds_raw[];
    LAS unsigned char* lds = (LAS unsigned char*)lds_raw;
    const int G = gridDim.x, bid = blockIdx.x;
    bf16_t* WTb = (bf16_t*)(p.ws + WS_WT);
    bf16_t* HB = (bf16_t*)(p.ws + WS_HB); bf16_t* Y = (bf16_t*)(p.ws + WS_Y); bf16_t* BIG = (bf16_t*)(p.ws + WS_BIG);
    float* rowss = (float*)(p.ws + WS_ROWSS);

    volatile LAS unsigned* xst = (volatile LAS unsigned*)(lds + LDS_BYTES - 64);
    if (threadIdx.x < 8) xst[threadIdx.x] = 0u;
    __syncthreads();
    XcdBarrier xbar; xbar.bar = (unsigned*)(p.ws + WS_BAR); xbar.st = xst; xbar.x = xb_xcc_id();
    if (threadIdx.x == 0) xst[2] = xb_add(&xbar.bar[XB_XCNT(xbar.x)], 1u);
    for (int rep = 0; rep < DBG_REP_P0; ++rep) phase0(lds, p);
    cg::this_grid().sync();
    if (threadIdx.x == 0) {
        bool okc = (G % 8) == 0;
        for (unsigned jx = 0; jx < 16; ++jx) { const unsigned cx = xb_ld(&xbar.bar[XB_XCNT(jx)]); okc = okc && (cx == (jx < 8 ? (unsigned)G / 8u : 0u)); }
        xst[4] = okc ? (xst[2] * 8u + xbar.x) : (unsigned)bid; xst[5] = okc ? 1u : 0u;
    }
    __syncthreads();
    const int vid = __builtin_amdgcn_readfirstlane((int)xst[4]);
    const bool xlocal = USE_LOCAL_BAR && (__builtin_amdgcn_readfirstlane((int)xst[5]) != 0);
    const int NX = ((G & 7) == 0) ? 8 : 1, xv = vid % NX, rk = vid / NX, RK = G / NX;
#define SEAM() do { if (xlocal) xcd_local_barrier(xbar); else xcd_barrier(xbar); } while (0)
#define GRID_SYNC() xcd_barrier(xbar)
#pragma unroll 1
    for (int layer = 0; layer < 4; ++layer) {
        const int j = layer >> 1;
        const bool even = (layer & 1) == 0;
        if (even) {
            pg8::Gemm g{HB, WTb + OFF_INE + (size_t)j * 3145728, MTOK, 3072, 1024}; pg8::StaticOrder S; int vq1 = vid, Gq1 = G; asm volatile("" : "+s"(vq1), "+s"(Gq1)); S.init(MTOK, 3072, Gq1, vq1, 0);
            pg8::EpiIn<0> E{BIG, 3072, rowss};
            pg8::gemm_phase(lds, g, S, E);
        } else {
            pg8::Gemm g{HB, WTb + OFF_INO + (size_t)j * 1572864, MTOK, 1536, 1024}; pg8::StaticOrder S; int vq2 = vid, Gq2 = G; asm volatile("" : "+s"(vq2), "+s"(Gq2)); S.init(MTOK, 1536, Gq2, vq2, 0);
            pg8::EpiIn<1> E{BIG, 1536, rowss};
            pg8::gemm_phase(lds, g, S, E);
        }
        if (layer == 0) GRID_SYNC(); else SEAM();
        if (even) {
            for (int i = rk; i < 256 / NX; i += RK) lru_pass<1>(lds, p, j, xv * (256 / NX) + i);
            hgrn2_run<1>(lds, p, j, xv * (512 / NX) + rk, RK, (512 / NX - rk + RK - 1) / RK);
            SEAM();
            for (int i = rk; i < 256 / NX; i += RK) lru_pass<2>(lds, p, j, xv * (256 / NX) + i);
            hgrn2_run<2>(lds, p, j, xv * (512 / NX) + rk, RK, (512 / NX - rk + RK - 1) / RK);
        } else {
            if (rk < 2048 / NX) {
                const int sbase = xv * (2048 / NX);
                if ((RK & 3) == 0) sgu_weights(lds, p, j, (sbase + rk) & 3);
                SguPre snx; sgu_load(p, sbase + rk, snx);
                for (int i = rk; i < 2048 / NX; i += RK) {
                    const SguPre scur = snx;
                    if ((RK & 3) != 0) { __syncthreads(); sgu_weights(lds, p, j, (sbase + i) & 3); }
                    if (i + RK < 2048 / NX) sgu_load(p, sbase + i + RK, snx);
                    sgu_item(lds, p, j, sbase + i, scur);
                }
            }
            if (rk < 2048 / NX) {
                const int pbase = xv * (2048 / NX);
                PoolPre pnx; pool_load(p, j, pbase + (rk & ~3) + (rk & 3), pnx);
                for (int i = rk, k = 0; i < 2048 / NX; i += RK, ++k) {
                    const PoolPre pcur = pnx;
                    const int i2 = i + RK;
                    if (i2 < 2048 / NX) pool_load(p, j, pbase + (i2 & ~3) + ((i2 + k + 1) & 3), pnx);
                    pool_item(lds, p, j, pbase + (i & ~3) + ((i + k) & 3), pcur);
                }
            }
        }
        SEAM();
        {
            const bf16_t* Wt = even ? WTb + OFF_OUTE + (size_t)j * 1048576 : WTb + OFF_OUTO + (size_t)j * 1048576;
            pg8::Gemm g{Y, Wt, MTOK, 1024, 1024}; pg8::StaticOrder S; int vq3 = vid, Gq3 = G; asm volatile("" : "+s"(vq3), "+s"(Gq3)); S.init(MTOK, 1024, Gq3, vq3, 1);
            pg8::EpiRes E{layer == 0 ? p.in[0] : (const float*)p.out, p.out, HB, rowss};
            pg8::gemm_phase(lds, g, S, E);
        }
        SEAM();
        {
            pg8::Gemm g{HB, WTb + OFF_FIN + (size_t)layer * 4194304, MTOK, 4096, 1024}; pg8::StaticOrder S; int vq4 = vid, Gq4 = G; asm volatile("" : "+s"(vq4), "+s"(Gq4)); S.init(MTOK, 4096, Gq4, vq4, 0);
            pg8::EpiIn<2> E{BIG, 4096, rowss};
            pg8::gemm_phase(lds, g, S, E);
        }
        SEAM();
        {
            pg8::Gemm g{BIG, WTb + OFF_FOUT + (size_t)layer * 4194304, MTOK, 1024, 4096}; pg8::StaticOrder S; int vq5 = vid, Gq5 = G; asm volatile("" : "+s"(vq5), "+s"(Gq5)); S.init(MTOK, 1024, Gq5, vq5, 1);
            pg8::EpiRes E{(const float*)p.out, p.out, HB, rowss};
            pg8::gemm_phase(lds, g, S, E);
        }
        if (layer == 3) GRID_SYNC(); else SEAM();
    }
    for (int rep = 0; rep < DBG_EXTRA_SYNCS; ++rep) GRID_SYNC();
    final_norm(p);
}

extern "C" void kernel_launch(void* const* d_in, const int* in_sizes, int n_in, void* d_out, int out_size, void* d_ws, size_t ws_size, hipStream_t stream) {
    static int grid_blocks = 0;
    if (!grid_blocks) {
        int dev = 0, cus = 0, per_cu = 0;
        (void)hipGetDevice(&dev);
        (void)hipDeviceGetAttribute(&cus, hipDeviceAttributeMultiprocessorCount, dev);
        (void)hipFuncSetAttribute((const void*)fwd_megakernel, hipFuncAttributeMaxDynamicSharedMemorySize, LDS_BYTES);
        (void)hipOccupancyMaxActiveBlocksPerMultiprocessor(&per_cu, (const void*)fwd_megakernel, NTHR, LDS_BYTES);
        (void)hipGetLastError();
        grid_blocks = cus > 0 ? cus : 256;
        if (n_in != 23 || out_size != MTOK * DM || ws_size < (size_t)868 * MiB) fprintf(stderr, "kernel_launch: unexpected shapes n_in %d out %d ws %zu\n", n_in, out_size, ws_size);
    }
    Params p{};
    for (int i = 0; i < 23; ++i) p.in[i] = (const float*)d_in[i];
    p.out = (float*)d_out; p.ws = (unsigned char*)d_ws;
    (void)hipMemsetAsync((unsigned char*)d_ws + WS_BAR, 0, 16384, stream);
    void* args[] = {&p};
    hipError_t e = hipLaunchCooperativeKernel((void*)fwd_megakernel, dim3(grid_blocks), dim3(NTHR), args, LDS_BYTES, stream);
    if (e != hipSuccess) fprintf(stderr, "cooperative launch failed: %s (grid %d)\n", hipGetErrorString(e), grid_blocks);
}
```

```cpp
#include <hip/hip_runtime.h>
#include <hip/hip_cooperative_groups.h>
#include <cstdio>
namespace cg = cooperative_groups;

#define LAS __attribute__((address_space(3)))
typedef unsigned short bf16_t;
typedef short bf16x8 __attribute__((ext_vector_type(8)));
typedef float f32x4 __attribute__((ext_vector_type(4)));
typedef unsigned u32x4 __attribute__((ext_vector_type(4)));
typedef unsigned u32x2 __attribute__((ext_vector_type(2)));

constexpr int MTOK = 65536, DM = 1024, SEQ = 4096;
constexpr float EPS = 1e-6f;
constexpr int LDS_BYTES = 155648;
#define DBG_REP_EVEN 1
#define DBG_REP_ODD 1
#define DBG_REP_FFNIN 1
#define DBG_REP_P0 1
#define DBG_EPI2 0
#define DBG_EXTRA_SYNCS 0
#define USE_LOCAL_BAR 1
#define DBG_SKIP_EVEN 0
#define DBG_SKIP_LRU 0
#define DBG_SKIP_HGRN 0
#define DBG_SKIP_ODD 0
constexpr int NTHR = 512;

constexpr size_t MiB = 1u << 20;
constexpr size_t WS_WT = 0;
constexpr size_t WS_SMALL = 90 * MiB;
constexpr size_t WS_BAR = 91 * MiB;
constexpr size_t WS_ROWSS = 92 * MiB;
constexpr size_t WS_LRUC = 96 * MiB;
constexpr size_t WS_HGG = 98 * MiB;
constexpr size_t WS_HB = 100 * MiB;
constexpr size_t WS_Y = 228 * MiB;
constexpr size_t WS_BIG = 356 * MiB;
constexpr size_t WS_ST = 868 * MiB;
constexpr size_t OFF_INE = 0, OFF_OUTE = 6291456, OFF_INO = 8388608, OFF_OUTO = 11534336, OFF_FIN = 13631488, OFF_FOUT = 30408704;
constexpr size_t SM_WAT = 0, SM_WXT = 256 * 1024, SM_SGUW = 512 * 1024, SM_PWT = 768 * 1024;

struct Params { const float* in[23]; float* out; unsigned char* ws; };

typedef float f32x2_ __attribute__((ext_vector_type(2)));
typedef __bf16 bf16x2_ __attribute__((ext_vector_type(2)));
__device__ __forceinline__ unsigned cvt_pk_bf16(float lo, float hi) { f32x2_ v = {lo, hi}; bf16x2_ r = __builtin_convertvector(v, bf16x2_); return __builtin_bit_cast(unsigned, r); }
__device__ __forceinline__ float bf_lo(unsigned w) { return __uint_as_float(w << 16); }
__device__ __forceinline__ float bf_hi(unsigned w) { return __uint_as_float(w & 0xffff0000u); }
__device__ __forceinline__ float bf2f(bf16_t b) { return __uint_as_float(((unsigned)b) << 16); }
__device__ __forceinline__ bf16_t f2bf(float f) { return (bf16_t)(cvt_pk_bf16(f, 0.f) & 0xffffu); }
__device__ __forceinline__ float rcp_(float x) { return __builtin_amdgcn_rcpf(x); }
__device__ __forceinline__ float sigmoid_(float x) { return rcp_(1.0f + __expf(-x)); }
__device__ __forceinline__ float gelu_tanh(float x) { const float u = 0.7978845608f * (x + 0.044715f * x * x * x); return x * rcp_(1.0f + __expf(-2.0f * u)); }
__device__ __forceinline__ float silu_(float x) { return x * rcp_(1.0f + __expf(-x)); }
__device__ __forceinline__ size_t tiled(size_t row, int col, int K) { return ((row >> 8) * (size_t)K + (size_t)(col >> 6) * 64) * 256 + ((row & 255) << 6) + (size_t)(col & 63); }
__device__ __forceinline__ size_t proj_off(size_t row, int ldc) { return (row >> 13) * (size_t)33554432 + (row & 8191) * (size_t)ldc; }
#define LDS_WAIT() asm volatile("s_waitcnt lgkmcnt(0)" ::: "memory")

namespace pg8 {
constexpr int BM = 256, BK = 64, HALF = 128, HTB = HALF * BK * 2, STAGE_BYTES = 8 * HTB, NXCD = 8, WGM = 4;
__host__ __device__ __forceinline__ int lds_byte(int r, int c) { const int st = (r >> 4) * 2 + (c >> 5), rr = r & 15, cc = c & 31, ob = rr * 64 + cc * 2; return st * 1024 + (ob ^ (((ob >> 9) & 1) << 5)); }
__host__ __device__ __forceinline__ void stage_rc(int b, int& R, int& C) { const int st = b / 1024, sb = b % 1024, swz = sb ^ (((sb >> 9) & 1) << 5); R = (st >> 1) * 16 + swz / 64; C = (st & 1) * 32 + (swz % 64) / 2; }
__host__ __device__ __forceinline__ int perm32(int rho) { const int n = rho >> 4, i = rho & 15; return 8 * (i >> 2) + 4 * n + (i & 3); }
struct Unit { int pm, pn; };
struct Gemm { const bf16_t* A; const bf16_t* Bt; int M, N, K; };
struct StaticOrder {
    int nM, nN, nwg, G, c, rev;
    __device__ void init(int M, int N, int G_, int c_, int rev_ = 0) { nM = M / BM; nN = N / BM; nwg = nM * nN; G = G_; c = c_; rev = rev_; }
    __device__ bool next(int i, Unit& u) const {
        const int nround = (nwg + G - 1) / G; if (i >= nround) return false;
        const long L = (long)(rev ? (nround - 1 - i) : i) * G + c; if (L >= nwg) return false;
        int wgid = (int)L; { const int q = nwg / NXCD, r = nwg % NXCD, xcd = wgid % NXCD, off = wgid / NXCD; wgid = (xcd < r ? xcd * (q + 1) : r * (q + 1) + (xcd - r) * q) + off; }
        const int nig = WGM * nN, gid = wgid / nig, fm = gid * WGM, gsz = (nM - fm) < WGM ? (nM - fm) : WGM;
        u.pm = fm + ((wgid % nig) % gsz); u.pn = (wgid % nig) / gsz; return true;
    }
};

template <int ACT> struct EpiIn {
    static constexpr bool PERM = true, PRE = true;
    bf16_t* O; int ldc; const float* rowss;
    __device__ __forceinline__ void operator()(const f32x4 (&acc)[2][2][4][2], const Unit& u, int wr, int wc, int fr, int fq, const LAS float* RS) const {
        const int row0 = u.pm * BM + wr * 64 + fr, col0 = u.pn * BM + wc * 32 + 8 * fq;
        const bool do_gelu = (ACT == 1) && (u.pn < 4);
        float rs[8];
#pragma unroll
        for (int i = 0; i < 8; ++i) rs[i] = RS[(i >> 2) * HALF + wr * 64 + (i & 3) * 16 + fr];
#pragma unroll
        for (int ai = 0; ai < 2; ++ai)
#pragma unroll
            for (int m = 0; m < 4; ++m) {
                const int row = row0 + ai * HALF + m * 16;
                const float rstd = rs[ai * 4 + m];
                bf16_t* rowp = (ACT == 2) ? O + tiled((size_t)row, col0, ldc) : O + proj_off((size_t)row, ldc) + col0;
#pragma unroll
                for (int bj = 0; bj < 2; ++bj) {
                    f32x4 v0 = acc[ai][bj][m][0] * rstd, v1 = acc[ai][bj][m][1] * rstd;
                    if (ACT == 1) { if (do_gelu) {
#pragma unroll
                        for (int q = 0; q < 4; ++q) { v0[q] = gelu_tanh(v0[q]); v1[q] = gelu_tanh(v1[q]); } } }
                    if (ACT == 2) {
#pragma unroll
                        for (int q = 0; q < 4; ++q) { const float a = fmaxf(v0[q], 0.f), b = fmaxf(v1[q], 0.f); v0[q] = a * a; v1[q] = b * b; } }
                    u32x4 w; w.x = cvt_pk_bf16(v0[0], v0[1]); w.y = cvt_pk_bf16(v0[2], v0[3]); w.z = cvt_pk_bf16(v1[0], v1[1]); w.w = cvt_pk_bf16(v1[2], v1[3]);
                    *(u32x4*)(rowp + bj * ((ACT == 2) ? HALF * 256 : HALF)) = w;
                }
            }
    }
};
struct EpiRes {
    static constexpr bool PERM = true, PRE = false;
    const float* res; float* H; bf16_t* HB; float* rowss;
    __device__ __forceinline__ void operator()(const f32x4 (&acc)[2][2][4][2], const Unit& u, int wr, int wc, int fr, int fq, const LAS float*) const {
        const int row0 = u.pm * BM + wr * 64 + fr, col0 = u.pn * BM + wc * 32 + 8 * fq;
#pragma unroll
        for (int ai = 0; ai < 2; ++ai) {
            f32x4 r[4][4];
#pragma unroll
            for (int m = 0; m < 4; ++m) {
                const size_t off = (size_t)(row0 + ai * HALF + m * 16) * DM + col0;
#pragma unroll
                for (int q = 0; q < 4; ++q) r[m][q] = *(const f32x4*)(res + off + (q >> 1) * HALF + (q & 1) * 4);
            }
#pragma unroll
            for (int m = 0; m < 4; ++m) {
                const int row = row0 + ai * HALF + m * 16;
                const size_t off = (size_t)row * DM + col0;
                float ss = 0.f;
#pragma unroll
                for (int bj = 0; bj < 2; ++bj) {
                    const f32x4 v0 = r[m][bj * 2] + acc[ai][bj][m][0], v1 = r[m][bj * 2 + 1] + acc[ai][bj][m][1];
                    *(f32x4*)(H + off + bj * HALF) = v0; *(f32x4*)(H + off + bj * HALF + 4) = v1;
                    ss += ((v0[0] * v0[0] + v0[1] * v0[1]) + (v0[2] * v0[2] + v0[3] * v0[3])) + ((v1[0] * v1[0] + v1[1] * v1[1]) + (v1[2] * v1[2] + v1[3] * v1[3]));
                    u32x4 w; w.x = cvt_pk_bf16(v0[0], v0[1]); w.y = cvt_pk_bf16(v0[2], v0[3]); w.z = cvt_pk_bf16(v1[0], v1[1]); w.w = cvt_pk_bf16(v1[2], v1[3]);
                    *(u32x4*)(HB + tiled((size_t)row, col0 + bj * HALF, DM)) = w;
                }
                ss += __shfl_xor(ss, 16); ss += __shfl_xor(ss, 32);
                if (fq == 0) rowss[(size_t)row * 16 + u.pn * 4 + wc] = ss;
            }
        }
    }
};

template <class Epi, class Sched>
__device__ __forceinline__ void gemm_phase(LAS unsigned char* lds, const Gemm g, const Sched& S, const Epi& E) {
    int tid = threadIdx.x; asm volatile("" : "+v"(tid));
    const int wid = __builtin_amdgcn_readfirstlane(tid >> 6), lane = tid & 63, wr = wid >> 2, wc = wid & 3, fr = lane & 15, fq = lane >> 4;
    const int K = g.K, nt = K / BK;
    unsigned voffA[2], voffB[2];
#pragma unroll
    for (int i = 0; i < 2; ++i) { int R, C; stage_rc(tid * 16 + i * 8192, R, C); const int Rb = Epi::PERM ? ((R & ~31) + perm32(R & 31)) : R;
        voffA[i] = (unsigned)(R * BK + C) * 2u; voffB[i] = (unsigned)(Rb * K + C) * 2u; }
    const size_t kstep = (size_t)(BK * 2);
    const size_t hstep = (size_t)HALF * K * 2;
    const size_t tstep = 2 * hstep;
    const size_t kstepA = (size_t)BM * BK * 2, hstepA = (size_t)HALF * BK * 2;
    const unsigned ldsw = (unsigned)wid * 1024u;
    const int aoff = lds_byte(wr * 64 + fr, fq * 8), boff = lds_byte(wc * 32 + fr, fq * 8);
    LAS float* RS = (LAS float*)(lds + STAGE_BYTES);
#define PG8_SA(b, h) (((b) * 2 + (h)) * HTB)
#define PG8_SB(b, h) ((4 + (b) * 2 + (h)) * HTB)
#define PG8_STAGE(bufoff, gbase, voff) do { _Pragma("unroll") for (int _i = 0; _i < 2; ++_i) \
        __builtin_amdgcn_global_load_lds((const unsigned*)((const char*)(gbase) + (voff)[_i]), (LAS unsigned*)(lds + (bufoff) + ldsw + _i * 8192), 16, 0, 0); } while (0)
#define PG8_LDA(dst, b, h) do { _Pragma("unroll") for (int m = 0; m < 4; ++m) _Pragma("unroll") for (int k = 0; k < 2; ++k) dst[m][k] = *(const LAS bf16x8*)(lds + PG8_SA(b, h) + aoff + m * 2048 + k * 1024); } while (0)
#define PG8_LDB(dst, b, h) do { _Pragma("unroll") for (int n = 0; n < 2; ++n) _Pragma("unroll") for (int k = 0; k < 2; ++k) dst[n][k] = *(const LAS bf16x8*)(lds + PG8_SB(b, h) + boff + n * 2048 + k * 1024); } while (0)
#define PG8_MMA(ai, bj, At, Bt) do { __builtin_amdgcn_s_setprio(1); _Pragma("unroll") for (int m = 0; m < 4; ++m) _Pragma("unroll") for (int n = 0; n < 2; ++n) _Pragma("unroll") for (int k = 0; k < 2; ++k) \
        acc[ai][bj][m][n] = __builtin_amdgcn_mfma_f32_16x16x32_bf16(Bt[n][k], At[m][k], acc[ai][bj][m][n], 0, 0, 0); __builtin_amdgcn_s_setprio(0); } while (0)
#define PG8_WAIT_V(n) asm volatile("s_waitcnt vmcnt(" #n ")" ::: "memory")
#define PG8_WAIT_L(n) asm volatile("s_waitcnt lgkmcnt(" #n ")" ::: "memory")
#define PG8_BAR __builtin_amdgcn_s_barrier()
#define PG8_SCHED __builtin_amdgcn_sched_barrier(0)
    Unit cur, nxt; int ui = 0;
    if (!S.next(0, cur)) return;
    f32x4 acc[2][2][4][2];
#pragma unroll
    for (int a = 0; a < 2; ++a)
#pragma unroll
        for (int b = 0; b < 2; ++b)
#pragma unroll
            for (int m = 0; m < 4; ++m)
#pragma unroll
                for (int n = 0; n < 2; ++n) acc[a][b][m][n] = (f32x4){0.f, 0.f, 0.f, 0.f};
    bf16x8 At[4][2], B0[2][2], B1[2][2];
    const char* cA = (const char*)g.A + (size_t)cur.pm * tstep; const char* cB = (const char*)g.Bt + (size_t)cur.pn * tstep;
    PG8_STAGE(PG8_SB(0, 0), cB, voffB); PG8_STAGE(PG8_SA(0, 0), cA, voffA); PG8_STAGE(PG8_SB(0, 1), cB + hstep, voffB); PG8_STAGE(PG8_SA(0, 1), cA + hstepA, voffA);
    if (wr == 1) PG8_BAR;
    PG8_WAIT_V(4); PG8_BAR;
    PG8_STAGE(PG8_SB(1, 0), cB + kstep, voffB); PG8_STAGE(PG8_SA(1, 0), cA + kstepA, voffA); PG8_STAGE(PG8_SB(1, 1), cB + hstep + kstep, voffB);
    PG8_WAIT_V(6); PG8_BAR;
    for (;;) {
        const bool has_next = S.next(ui + 1, nxt);
        const char* nA = has_next ? (const char*)g.A + (size_t)nxt.pm * tstep : cA; const char* nB = has_next ? (const char*)g.Bt + (size_t)nxt.pn * tstep : cB;
        for (int t = 0; t < nt; t += 2) {
            const bool last = (t == nt - 2);
            const char* a1 = cA + (size_t)(t + 1) * kstepA;
            const char* a2 = last ? nA : cA + (size_t)(t + 2) * kstepA; const char* b2 = last ? nB : cB + (size_t)(t + 2) * kstep;
            const char* a3 = a2 + kstepA; const char* b3 = b2 + kstep;
            f32x4 rsA;
            if constexpr (Epi::PRE) { if (t <= 2) { const float* rp = E.rowss + (size_t)(cur.pm * BM + (t >> 1) * HALF + (tid >> 2)) * 16 + (tid & 3) * 4;
                asm volatile("global_load_dwordx4 %0, %1, off" : "=&v"(rsA) : "v"(rp) : "memory"); } }
            PG8_LDB(B0, 0, 0); PG8_SCHED; PG8_LDA(At, 0, 0); PG8_STAGE(PG8_SA(1, 1), a1 + hstepA, voffA);
            PG8_WAIT_L(8); PG8_BAR; PG8_WAIT_L(0); PG8_MMA(0, 0, At, B0); PG8_BAR; PG8_SCHED;
            PG8_LDB(B1, 0, 1); PG8_STAGE(PG8_SB(0, 0), b2, voffB);
            PG8_BAR; PG8_WAIT_L(0); PG8_MMA(0, 1, At, B1); PG8_BAR;
            PG8_LDA(At, 0, 1); PG8_STAGE(PG8_SA(0, 0), a2, voffA);
            PG8_BAR; PG8_WAIT_L(0); PG8_MMA(1, 0, At, B0); PG8_BAR; PG8_SCHED;
            PG8_STAGE(PG8_SB(0, 1), b2 + hstep, voffB);
            PG8_WAIT_V(6); PG8_BAR; PG8_MMA(1, 1, At, B1); PG8_BAR;
            if constexpr (Epi::PRE) { if (t <= 2) { asm volatile("s_waitcnt vmcnt(8)" : "+v"(rsA) :: "memory"); float sq = (rsA[0] + rsA[1]) + (rsA[2] + rsA[3]); sq += __shfl_xor(sq, 1); sq += __shfl_xor(sq, 2);
                if (!(tid & 3)) RS[(t >> 1) * HALF + (tid >> 2)] = rsqrtf(sq * (1.0f / 1024.0f) + EPS); } }
            PG8_LDB(B0, 1, 0); PG8_SCHED; PG8_LDA(At, 1, 0); PG8_STAGE(PG8_SA(0, 1), a2 + hstepA, voffA);
            PG8_WAIT_L(8); PG8_BAR; PG8_WAIT_L(0); PG8_MMA(0, 0, At, B0); PG8_BAR; PG8_SCHED;
            PG8_LDB(B1, 1, 1); PG8_STAGE(PG8_SB(1, 0), b3, voffB);
            PG8_BAR; PG8_WAIT_L(0); PG8_MMA(0, 1, At, B1); PG8_BAR;
            PG8_LDA(At, 1, 1); PG8_STAGE(PG8_SA(1, 0), a3, voffA);
            PG8_BAR; PG8_WAIT_L(0); PG8_MMA(1, 0, At, B0); PG8_BAR; PG8_SCHED;
            PG8_STAGE(PG8_SB(1, 1), b3 + hstep, voffB);
            PG8_WAIT_V(6); PG8_BAR; PG8_MMA(1, 1, At, B1); PG8_BAR;
        }
        E(acc, cur, wr, wc, fr, fq, RS);
        if (!has_next) break;
#pragma unroll
        for (int a = 0; a < 2; ++a)
#pragma unroll
            for (int b = 0; b < 2; ++b)
#pragma unroll
                for (int m = 0; m < 4; ++m)
#pragma unroll
                    for (int n = 0; n < 2; ++n) acc[a][b][m][n] = (f32x4){0.f, 0.f, 0.f, 0.f};
        cur = nxt; cA = nA; cB = nB; ++ui;
    }
    PG8_WAIT_V(0);
    if (wr == 0) PG8_BAR;
    PG8_BAR;
#undef PG8_SA
#undef PG8_SB
#undef PG8_STAGE
#undef PG8_LDA
#undef PG8_LDB
#undef PG8_MMA
#undef PG8_WAIT_V
#undef PG8_WAIT_L
#undef PG8_BAR
#undef PG8_SCHED
}
}

__device__ __forceinline__ void transpose_item(const float* W, int K, int N, bf16_t* WT, const float* kscale, LAS float* scr, int item, int lane) {
    const int nblk = N / 32, kb = item / nblk, nb = item % nblk, k0 = 64 * kb, n0 = 32 * nb;
    float wv[32];
#pragma unroll
    for (int i = 0; i < 32; ++i) wv[i] = W[(size_t)(k0 + 2 * i + (lane >> 5)) * N + n0 + (lane & 31)];
#pragma unroll
    for (int i = 0; i < 32; ++i) { const int kk = 2 * i + (lane >> 5); const float s = kscale ? kscale[k0 + kk] : 1.0f; scr[kk * 33 + (lane & 31)] = wv[i] * s; }
    LDS_WAIT();
    const int c = lane & 7;
#pragma unroll
    for (int j = 0; j < 4; ++j) { const int n = (lane >> 3) + 8 * j; const LAS float* s = scr + (8 * c) * 33 + n;
        u32x4 o; o.x = cvt_pk_bf16(s[0 * 33], s[1 * 33]); o.y = cvt_pk_bf16(s[2 * 33], s[3 * 33]); o.z = cvt_pk_bf16(s[4 * 33], s[5 * 33]); o.w = cvt_pk_bf16(s[6 * 33], s[7 * 33]);
        *(u32x4*)(WT + (size_t)(n0 + n) * K + k0 + 8 * c) = o; }
    LDS_WAIT();
}

__device__ __forceinline__ void phase0(LAS unsigned char* lds, const Params& p) {
    int tid = threadIdx.x; asm volatile("" : "+v"(tid));
    const int lane = tid & 63, wave = tid >> 6;
    const int gw = blockIdx.x * 8 + wave, NGW = gridDim.x * 8;
    LAS float* scr = (LAS float*)(lds + wave * 8704);
    bf16_t* WTb = (bf16_t*)(p.ws + WS_WT);
#pragma unroll 1
    for (int mat = 0; mat < 16; ++mat) {
        const float* W; int K, N; bf16_t* WT; const float* ks = nullptr;
        if (mat < 2)       { W = p.in[3] + (size_t)mat * 1024 * 3072; K = 1024; N = 3072; WT = WTb + OFF_INE + (size_t)mat * 3145728; ks = p.in[1] + (2 * mat) * 1024; }
        else if (mat < 4)  { const int j = mat - 2; W = p.in[13] + (size_t)j * 1048576; K = 1024; N = 1024; WT = WTb + OFF_OUTE + (size_t)j * 1048576; }
        else if (mat < 6)  { const int j = mat - 4; W = p.in[14] + (size_t)j * 1024 * 1536; K = 1024; N = 1536; WT = WTb + OFF_INO + (size_t)j * 1572864; ks = p.in[1] + (2 * j + 1) * 1024; }
        else if (mat < 8)  { const int j = mat - 6; W = p.in[19] + (size_t)j * 1048576; K = 1024; N = 1024; WT = WTb + OFF_OUTO + (size_t)j * 1048576; }
        else if (mat < 12) { const int l = mat - 8; W = p.in[20] + (size_t)l * 4194304; K = 1024; N = 4096; WT = WTb + OFF_FIN + (size_t)l * 4194304; ks = p.in[2] + l * 1024; }
        else               { const int l = mat - 12; W = p.in[21] + (size_t)l * 4194304; K = 4096; N = 1024; WT = WTb + OFF_FOUT + (size_t)l * 4194304; }
        const int nitems = (K / 64) * (N / 32);
        for (int it = gw; it < nitems; it += NGW) transpose_item(W, K, N, WT, ks, scr, it, lane);
    }
    {
        const size_t gtid = (size_t)blockIdx.x * NTHR + tid, gsz = (size_t)gridDim.x * NTHR;
        bf16_t* WaT = (bf16_t*)(p.ws + WS_SMALL + SM_WAT); bf16_t* WxT = (bf16_t*)(p.ws + WS_SMALL + SM_WXT);
        bf16_t* SW = (bf16_t*)(p.ws + WS_SMALL + SM_SGUW); bf16_t* PWT = (bf16_t*)(p.ws + WS_SMALL + SM_PWT);
        for (size_t i = gtid; i < 131072; i += gsz) {
            const int ii = i & 63, jo = (i >> 6) & 63; const size_t lh = i >> 12;
            if (i < 65536) { WaT[i] = f2bf(p.in[6][lh * 4096 + ii * 64 + jo]);
            WxT[i] = f2bf(p.in[8][lh * 4096 + ii * 64 + jo]); }
            const int s = i & 127, t = (i >> 7) & 127;
            SW[i] = f2bf(s <= t ? p.in[15][i] : 0.f);
            const int c = i & 127, d = (i >> 7) & 127; const size_t lg = i >> 14; const size_t l = lg >> 2, gi = lg & 3;
            PWT[i] = f2bf(p.in[17][lg * 16384 + c * 128 + d] * p.in[18][l * 512 + gi * 128 + d]);
        }
    }
    {
        const float* x = p.in[0]; bf16_t* HB = (bf16_t*)(p.ws + WS_HB); float* rowss = (float*)(p.ws + WS_ROWSS);
        for (int row = gw; row < MTOK; row += 2 * NGW) {
            const int row2 = row + NGW;
            const f32x4* xr = (const f32x4*)(x + (size_t)row * DM) + lane;
            const f32x4* xr2 = (const f32x4*)(x + (size_t)row2 * DM) + lane;
            f32x4 v[4], v2[4]; float s = 0.f, s2 = 0.f;
#pragma unroll
            for (int j = 0; j < 4; ++j) { v[j] = xr[64 * j]; v2[j] = xr2[64 * j]; }
#pragma unroll
            for (int j = 0; j < 4; ++j) { s += (v[j][0] * v[j][0] + v[j][1] * v[j][1]) + (v[j][2] * v[j][2] + v[j][3] * v[j][3]); s2 += (v2[j][0] * v2[j][0] + v2[j][1] * v2[j][1]) + (v2[j][2] * v2[j][2] + v2[j][3] * v2[j][3]); }
#pragma unroll
            for (int o = 1; o < 64; o <<= 1) { s += __shfl_xor(s, o); s2 += __shfl_xor(s2, o); }
            u32x2* o8 = (u32x2*)(HB + tiled((size_t)row, 4 * lane, DM)); u32x2* o82 = (u32x2*)(HB + tiled((size_t)row2, 4 * lane, DM));
#pragma unroll
            for (int j = 0; j < 4; ++j) { u32x2 w; w.x = cvt_pk_bf16(v[j][0], v[j][1]); w.y = cvt_pk_bf16(v[j][2], v[j][3]); o8[16384 * j] = w;
                u32x2 w2; w2.x = cvt_pk_bf16(v2[j][0], v2[j][1]); w2.y = cvt_pk_bf16(v2[j][2], v2[j][3]); o82[16384 * j] = w2; }
            if (lane < 16) { rowss[(size_t)row * 16 + lane] = (lane == 0) ? s : 0.f; rowss[(size_t)row2 * 16 + lane] = (lane == 0) ? s2 : 0.f; }
        }
    }
}

template <int PASS>
__device__ __forceinline__ void lru_pass(LAS unsigned char* lds, const Params& p, int j, int item) {
    int tid = threadIdx.x; asm volatile("" : "+v"(tid));
    const int lane = tid & 63, w = __builtin_amdgcn_readfirstlane(tid >> 6), fr = lane & 15, fq = lane >> 4;
    const int b = item >> 4, seg = item & 15;
    const bf16_t* PROJ = (const bf16_t*)(p.ws + WS_BIG);
    bf16_t* Y = (bf16_t*)(p.ws + WS_Y);
    float* Pbuf = (float*)(p.ws + WS_LRUC); float* Hbuf = Pbuf + 256 * 512;
    LAS bf16_t* U = (LAS bf16_t*)lds;
    LAS bf16_t* HS = (LAS bf16_t*)(lds + 66560);
    const bf16_t* WaT = (const bf16_t*)(p.ws + WS_SMALL + SM_WAT) + (size_t)(j * 8 + w) * 4096;
    const bf16_t* WxT = (const bf16_t*)(p.ws + WS_SMALL + SM_WXT) + (size_t)(j * 8 + w) * 4096;
    bf16x8 Ba[4][2], Bx[4][2];
#pragma unroll
    for (int n = 0; n < 4; ++n)
#pragma unroll
        for (int kk = 0; kk < 2; ++kk) { Ba[n][kk] = *(const bf16x8*)(WaT + (n * 16 + fr) * 64 + kk * 32 + fq * 8); Bx[n][kk] = *(const bf16x8*)(WxT + (n * 16 + fr) * 64 + kk * 32 + fq * 8); }
    float ba[4], bx[4], sp[4], h[4], P[4];
#pragma unroll
    for (int n = 0; n < 4; ++n) {
        const int c = w * 64 + n * 16 + fr;
        ba[n] = p.in[7][j * 512 + c]; bx[n] = p.in[9][j * 512 + c];
        const float lam = p.in[10][j * 512 + c];
        sp[n] = 8.0f * 1.44269504f * log1pf(__expf(-lam));
        float hh = 0.f;
        if (PASS == 2) {
            float pq[15], hq[15];
#pragma unroll
            for (int s = 0; s < 15; ++s) { pq[s] = Pbuf[(size_t)(b * 16 + s) * 512 + c]; hq[s] = Hbuf[(size_t)(b * 16 + s) * 512 + c]; }
#pragma unroll
            for (int s = 0; s < 15; ++s) hh = (s < seg) ? pq[s] * hh + hq[s] : hh;
        }
        h[n] = hh; P[n] = 1.0f;
    }
    const int c8 = (tid & 63) * 8, tg = tid >> 6;
    LAS float* CW = (LAS float*)(lds + 133120);
    {
        const float* src = (tid < 128 * 4) ? p.in[4] + (size_t)j * 2048 : p.in[4];
        *(LAS f32x4*)(CW + tid * 4) = *(const f32x4*)(src + tid * 4);
        if (tid < 128) *(LAS f32x4*)(CW + 2048 + tid * 4) = *(const f32x4*)(p.in[5] + j * 512 + tid * 4);
    }
    __syncthreads();
#pragma unroll 1
    for (int sub = 0; sub < 4; ++sub) {
        const int t0 = seg * 256 + sub * 64;
        const size_t rowbase = (size_t)b * SEQ + t0;

        {
            float cw[4][8], cb[8];
#pragma unroll
            for (int k = 0; k < 4; ++k) { const f32x4 a = *(const LAS f32x4*)(CW + k * 512 + c8), bq = *(const LAS f32x4*)(CW + k * 512 + c8 + 4);
#pragma unroll
                for (int q = 0; q < 4; ++q) { cw[k][q] = a[q]; cw[k][4 + q] = bq[q]; } }
            { const f32x4 a = *(const LAS f32x4*)(CW + 2048 + c8), bq = *(const LAS f32x4*)(CW + 2048 + c8 + 4);
#pragma unroll
                for (int q = 0; q < 4; ++q) { cb[q] = a[q]; cb[4 + q] = bq[q]; } }
            u32x4 xw[4];
#pragma unroll
            for (int k = 0; k < 3; ++k) { const int tl = tg * 8 - 3 + k; xw[k] = (t0 + tl >= 0) ? *(const u32x4*)(PROJ + proj_off(rowbase + tl, 3072) + c8) : (u32x4){0u, 0u, 0u, 0u}; }
#pragma unroll
            for (int i = 0; i < 8; ++i) {
                const int tl = tg * 8 + i;
                xw[3] = *(const u32x4*)(PROJ + proj_off(rowbase + tl, 3072) + c8);
                float uo[8];
#pragma unroll
                for (int q = 0; q < 4; ++q) {
                    float lo = cb[2 * q], hi = cb[2 * q + 1];
#pragma unroll
                    for (int k = 0; k < 4; ++k) { lo += cw[k][2 * q] * bf_lo(xw[k][q]); hi += cw[k][2 * q + 1] * bf_hi(xw[k][q]); }
                    uo[2 * q] = lo; uo[2 * q + 1] = hi;
                }
                u32x4 o; o.x = cvt_pk_bf16(uo[0], uo[1]); o.y = cvt_pk_bf16(uo[2], uo[3]); o.z = cvt_pk_bf16(uo[4], uo[5]); o.w = cvt_pk_bf16(uo[6], uo[7]);
                *(LAS u32x4*)(U + tl * 520 + c8) = o;
                xw[0] = xw[1]; xw[1] = xw[2]; xw[2] = xw[3];
            }
        }
        __syncthreads();
#pragma unroll 1
        for (int tt = 0; tt < 4; ++tt) {
            bf16x8 a0 = *(const LAS bf16x8*)(U + (tt * 16 + fr) * 520 + w * 64 + fq * 8);
            bf16x8 a1 = *(const LAS bf16x8*)(U + (tt * 16 + fr) * 520 + w * 64 + 32 + fq * 8);
#pragma unroll
            for (int n = 0; n < 4; ++n) {
                f32x4 ar = (f32x4){ba[n], ba[n], ba[n], ba[n]}, ai = (f32x4){bx[n], bx[n], bx[n], bx[n]};
                ar = __builtin_amdgcn_mfma_f32_16x16x32_bf16(a0, Ba[n][0], ar, 0, 0, 0); ar = __builtin_amdgcn_mfma_f32_16x16x32_bf16(a1, Ba[n][1], ar, 0, 0, 0);
                ai = __builtin_amdgcn_mfma_f32_16x16x32_bf16(a0, Bx[n][0], ai, 0, 0, 0); ai = __builtin_amdgcn_mfma_f32_16x16x32_bf16(a1, Bx[n][1], ai, 0, 0, 0);
                const int c = w * 64 + n * 16 + fr;
                float av[4], bv[4];
#pragma unroll
                for (int jj = 0; jj < 4; ++jj) {
                    const int t = tt * 16 + fq * 4 + jj;
                    const float u = bf2f(U[t * 520 + c]);
                    const float r = sigmoid_(ar[jj]), ig = sigmoid_(ai[jj]);
                    const float a = __builtin_amdgcn_exp2f(-r * sp[n]);
                    const float beta = __builtin_amdgcn_sqrtf(fmaxf(1.0f - a * a, 0.f));
                    av[jj] = a; bv[jj] = beta * ig * u;
                }
                const float A4 = (av[0] * av[1]) * (av[2] * av[3]);
                const float B4 = ((bv[0] * av[1] + bv[1]) * av[2] + bv[2]) * av[3] + bv[3];
                float hs = h[n];
#pragma unroll
                for (int g = 0; g < 4; ++g) {
                    const float he = A4 * hs + B4;
                    const float nx = __shfl(he, fr + 16 * g);
                    if (fq > g) hs = nx;
                    if (g == 3) h[n] = nx;
                }
                if (PASS == 1) { float pp = A4; pp *= __shfl_xor(pp, 16); pp *= __shfl_xor(pp, 32); P[n] *= pp; }
                if (PASS == 2) {
                    float xh = hs;
#pragma unroll
                    for (int jj = 0; jj < 4; ++jj) { xh = av[jj] * xh + bv[jj]; HS[(tt * 16 + fq * 4 + jj) * 520 + c] = f2bf(xh); }
                }
            }
        }
        if (PASS == 2) {
            __syncthreads();
            u32x4 gpre[8];
#pragma unroll
            for (int i = 0; i < 8; ++i) gpre[i] = *(const u32x4*)(PROJ + proj_off(rowbase + tg * 8 + i, 3072) + 512 + c8);
#pragma unroll
            for (int i = 0; i < 8; ++i) {
                const int tl = tg * 8 + i;
                const u32x4 hv = *(const LAS u32x4*)(HS + tl * 520 + c8);
                const u32x4 gv = gpre[i];
                u32x4 o;
#pragma unroll
                for (int q = 0; q < 4; ++q) o[q] = cvt_pk_bf16(bf_lo(hv[q]) * gelu_tanh(bf_lo(gv[q])), bf_hi(hv[q]) * gelu_tanh(bf_hi(gv[q])));
                *(u32x4*)(Y + tiled(rowbase + tl, c8, 1024)) = o;
            }
        }
        __syncthreads();
    }
    if (PASS == 1) {
        if (fq == 0) {
#pragma unroll
            for (int n = 0; n < 4; ++n) { const int c = w * 64 + n * 16 + fr; Pbuf[(size_t)item * 512 + c] = P[n]; Hbuf[(size_t)item * 512 + c] = h[n]; }
        }
    }
}


__device__ __forceinline__ void hgrn_bcum2(LAS float* BC, LAS float* PT, const u32x4 (&zv)[2], const float (&lb)[8], int tid, float (&kout)[2][8]) {
    {
        const int d8 = (tid & 15) * 8, t = tid >> 4;
#pragma unroll
        for (int rr = 0; rr < 2; ++rr) {
            const int tr = t + rr * 32;
            float lf[8];
#pragma unroll
            for (int q = 0; q < 4; ++q) {
                const float z0 = bf_lo(zv[rr][q]), z1 = bf_hi(zv[rr][q]);
                const float k0 = (1.0f - lb[2 * q]) * sigmoid_(-z0), k1 = (1.0f - lb[2 * q + 1]) * sigmoid_(-z1);
                kout[rr][2 * q] = k0; kout[rr][2 * q + 1] = k1;
                lf[2 * q] = __logf(fmaxf(1.0f - k0, 1e-20f));
                lf[2 * q + 1] = __logf(fmaxf(1.0f - k1, 1e-20f));
            }
            *(LAS f32x4*)(BC + tr * 128 + d8) = (f32x4){lf[0], lf[1], lf[2], lf[3]};
            *(LAS f32x4*)(BC + tr * 128 + d8 + 4) = (f32x4){lf[4], lf[5], lf[6], lf[7]};
        }
    }
    __syncthreads();
    const int d = tid & 127, part = tid >> 7;
    {
        float a = 0.f;
#pragma unroll
        for (int i = 0; i < 16; ++i) { const int t = part * 16 + i; a += BC[t * 128 + d]; BC[t * 128 + d] = a; }
        PT[part * 128 + d] = a;
    }
    __syncthreads();
}
struct HcPre { u32x4 zv[2], vv[2], qv[2], gp[2]; };
template <int PASS>
__device__ __forceinline__ void hgrn2_load(const Params& p, int item, int c, HcPre& r) {
    int tid = threadIdx.x; asm volatile("" : "+v"(tid));
    const int bh = item >> 3, sup = item & 7, b = bh >> 2, h = bh & 3;
    const bf16_t* PROJ = (const bf16_t*)(p.ws + WS_BIG);
    const size_t rowbase = (size_t)b * SEQ + (size_t)(sup * 8 + c) * 64;
    const int d8 = (tid & 15) * 8, t = tid >> 4;
#pragma unroll
    for (int rr = 0; rr < 2; ++rr) {
        r.zv[rr] = *(const u32x4*)(PROJ + proj_off(rowbase + t + rr * 32, 3072) + 1536 + h * 128 + d8);
        r.vv[rr] = *(const u32x4*)(PROJ + proj_off(rowbase + t + rr * 32, 3072) + 2048 + h * 128 + d8);
        if (PASS == 2) r.qv[rr] = *(const u32x4*)(PROJ + proj_off(rowbase + t + rr * 32, 3072) + 1024 + h * 128 + d8);
    }
    if (PASS == 2) {
        const bf16_t* gp = PROJ + proj_off(rowbase + (tid >> 3), 3072) + 2560 + h * 128 + (tid & 7) * 16;
        r.gp[0] = *(const u32x4*)gp; r.gp[1] = *(const u32x4*)(gp + 8);
    }
}
template <int PASS>
__device__ __forceinline__ void hgrn2_init(const Params& p, int item, f32x4 (&S)[8], float (&Gt)[4]) {
    int tid = threadIdx.x; asm volatile("" : "+v"(tid));
    const int lane = tid & 63, w = __builtin_amdgcn_readfirstlane(tid >> 6), fq = lane >> 4;
#pragma unroll
    for (int n = 0; n < 8; ++n) S[n] = (f32x4){0.f, 0.f, 0.f, 0.f};
#pragma unroll
    for (int jj = 0; jj < 4; ++jj) Gt[jj] = 1.0f;
    if (PASS == 2) {
        const int bh = item >> 3, sup = item & 7;
        const float* SUMb = (const float*)(p.ws + WS_ST); const float* GTb = (const float*)(p.ws + WS_HGG);
        for (int s2 = 0; s2 < sup; ++s2) {
            const size_t it2 = (size_t)bh * 8 + s2;
            const f32x4 g4 = *(const f32x4*)(GTb + it2 * 128 + w * 16 + fq * 4);
#pragma unroll
            for (int n = 0; n < 8; ++n) { const f32x4 T = *(const f32x4*)(SUMb + it2 * 16384 + (size_t)((n * 8 + w) * 64 + lane) * 4); S[n] = g4 * S[n] + T; }
        }
    }
}
__device__ __forceinline__ void hgrn2_finish(const Params& p, int item, const f32x4 (&S)[8], const float (&Gt)[4]) {
    int tid = threadIdx.x; asm volatile("" : "+v"(tid));
    const int lane = tid & 63, w = __builtin_amdgcn_readfirstlane(tid >> 6), fr = lane & 15, fq = lane >> 4;
    float* SUMb = (float*)(p.ws + WS_ST); float* GTb = (float*)(p.ws + WS_HGG);
#pragma unroll
    for (int n = 0; n < 8; ++n) *(f32x4*)(SUMb + (size_t)item * 16384 + (size_t)((n * 8 + w) * 64 + lane) * 4) = S[n];
    if (fr == 0) *(f32x4*)(GTb + (size_t)item * 128 + w * 16 + fq * 4) = (f32x4){Gt[0], Gt[1], Gt[2], Gt[3]};
}
template <int PASS>
__device__ __forceinline__ void hgrn2_chunk(LAS unsigned char* lds, const Params& p, int j, int item, int c, const HcPre& pre, f32x4 (&S)[8], float (&Gt)[4], const float (&lb)[8]) {
    int tid = threadIdx.x; asm volatile("" : "+v"(tid));
    const int lane = tid & 63, w = __builtin_amdgcn_readfirstlane(tid >> 6), fr = lane & 15, fq = lane >> 4;
    const int bh = item >> 3, sup = item & 7, b = bh >> 2, h = bh & 3;
    bf16_t* Y = (bf16_t*)(p.ws + WS_Y);
    const size_t rowbase = (size_t)b * SEQ + (size_t)(sup * 8 + c) * 64;
    LAS float* BC = (LAS float*)lds;
    LAS bf16_t* QA = (LAS bf16_t*)(lds + 32768);
    LAS bf16_t* KA = (LAS bf16_t*)(lds + 50176);
    LAS bf16_t* VT = (LAS bf16_t*)(lds + 67584);
    LAS bf16_t* SS = (LAS bf16_t*)(lds + 86016);
    LAS bf16_t* AT = (LAS bf16_t*)(lds + 120832);
    LAS float* PT = (LAS float*)(lds + 130048);
    LAS bf16_t* VN = SS;
    const float* lbl = p.in[11];
    const int d8 = (tid & 15) * 8, t = tid >> 4;
    u32x4 zv[2], vv[2], qv[2], gpre[2];
#pragma unroll
    for (int rr = 0; rr < 2; ++rr) { zv[rr] = pre.zv[rr]; vv[rr] = pre.vv[rr]; if (PASS == 2) { qv[rr] = pre.qv[rr]; gpre[rr] = pre.gp[rr]; } }
    f32x4 gnv[4];
    if (PASS == 2) {
        const float* gn0 = p.in[12] + j * 512 + h * 128 + (tid & 7) * 16;
#pragma unroll
        for (int q = 0; q < 4; ++q) gnv[q] = *(const f32x4*)(gn0 + q * 4);
    }
#pragma unroll
    for (int rr = 0; rr < 2; ++rr) *(LAS u32x4*)(VN + (t + rr * 32) * 136 + d8) = vv[rr];
    float kq[2][8];
    hgrn_bcum2(BC, PT, zv, lb, tid, kq);
    {
        float bref[8], c1[8], c2[8], c3[8];
        {
            const f32x4 pa0 = *(const LAS f32x4*)(PT + d8), pa1 = *(const LAS f32x4*)(PT + d8 + 4);
            const f32x4 pb0 = *(const LAS f32x4*)(PT + 128 + d8), pb1 = *(const LAS f32x4*)(PT + 128 + d8 + 4);
            const f32x4 pc0 = *(const LAS f32x4*)(PT + 256 + d8), pc1 = *(const LAS f32x4*)(PT + 256 + d8 + 4);
#pragma unroll
            for (int q = 0; q < 4; ++q) { c1[q] = pa0[q]; c1[4 + q] = pa1[q]; c2[q] = pa0[q] + pb0[q]; c2[4 + q] = pa1[q] + pb1[q]; c3[q] = c2[q] + pc0[q]; c3[4 + q] = c2[4 + q] + pc1[q]; }
        }
        const bool hi16 = (t >> 4) != 0;
#pragma unroll
        for (int q = 0; q < 8; ++q) bref[q] = BC[31 * 128 + d8 + q] + c1[q];
#pragma unroll
        for (int rr = 0; rr < 2; ++rr) {
            const int tr = t + rr * 32;
            float qa[8], ka[8];
#pragma unroll
            for (int q = 0; q < 8; ++q) {
                const float bc = BC[tr * 128 + d8 + q] + (rr == 0 ? (hi16 ? c1[q] : 0.f) : (hi16 ? c3[q] : c2[q]));
                const float dq = fminf(fmaxf(bc - bref[q], -80.f), 80.f);
                const float e1 = __expf(dq);
                if (PASS == 2) { const float qq = silu_((q & 1) ? bf_hi(qv[rr][q >> 1]) : bf_lo(qv[rr][q >> 1])); qa[q] = qq * e1; }
                ka[q] = kq[rr][q] * rcp_(e1);
            }
            u32x4 o;
            if (PASS == 2) {
#pragma unroll
                for (int q = 0; q < 4; ++q) o[q] = cvt_pk_bf16(qa[2 * q], qa[2 * q + 1]);
                *(LAS u32x4*)(QA + tr * 136 + d8) = o;
            }
#pragma unroll
            for (int q = 0; q < 4; ++q) o[q] = cvt_pk_bf16(ka[2 * q], ka[2 * q + 1]);
            *(LAS u32x4*)(KA + tr * 136 + d8) = o;
        }
        {
            const int e = tid & 127, tq = tid >> 7;
            bf16_t vq[16];
#pragma unroll
            for (int i = 0; i < 16; ++i) vq[i] = VN[(tq * 16 + i) * 136 + e];
            u32x4 p0, p1;
#pragma unroll
            for (int q = 0; q < 4; ++q) { p0[q] = (unsigned)vq[2 * q] | ((unsigned)vq[2 * q + 1] << 16); p1[q] = (unsigned)vq[8 + 2 * q] | ((unsigned)vq[8 + 2 * q + 1] << 16); }
            *(LAS u32x4*)(VT + e * 72 + tq * 16) = p0; *(LAS u32x4*)(VT + e * 72 + tq * 16 + 8) = p1;
        }
    }
    float gsc[4], sc[4], eb[4];
#pragma unroll
    for (int jj = 0; jj < 4; ++jj) { const int dd = w * 16 + fq * 4 + jj; const float p0 = PT[dd], br = BC[31 * 128 + dd] + p0, bl = BC[63 * 128 + dd] + ((p0 + PT[128 + dd]) + PT[256 + dd]); gsc[jj] = __expf(bl); sc[jj] = __expf(bl - br); eb[jj] = __expf(br); }
    __syncthreads();
    if (PASS == 2) {
#pragma unroll
        for (int n = 0; n < 8; ++n) { u32x2 o; o.x = cvt_pk_bf16(S[n][0] * eb[0], S[n][1] * eb[1]); o.y = cvt_pk_bf16(S[n][2] * eb[2], S[n][3] * eb[3]);
            *(LAS u32x2*)(SS + (n * 16 + fr) * 136 + w * 16 + fq * 4) = o; }
        {
            const int tt = w >> 1;
#pragma unroll
            for (int si = 0; si < 2; ++si) {
                const int ss = (w & 1) * 2 + si;
                f32x4 acc = (f32x4){0.f, 0.f, 0.f, 0.f};
                if (ss <= tt) {
#pragma unroll
                    for (int kk = 0; kk < 4; ++kk) {
                        const bf16x8 a = *(const LAS bf16x8*)(QA + (tt * 16 + fr) * 136 + kk * 32 + fq * 8);
                        const bf16x8 bb = *(const LAS bf16x8*)(KA + (ss * 16 + fr) * 136 + kk * 32 + fq * 8);
                        acc = __builtin_amdgcn_mfma_f32_16x16x32_bf16(a, bb, acc, 0, 0, 0);
                    }
                }
#pragma unroll
                for (int jj = 0; jj < 4; ++jj) {
                    const int tq2 = tt * 16 + fq * 4 + jj, sq2 = ss * 16 + fr;
                    const float v = (sq2 <= tq2) ? acc[jj] : 0.f;
                    AT[tq2 * 72 + sq2] = f2bf(v);
                }
            }
        }
        __syncthreads();
        {
            const int tt = w >> 1, n0 = (w & 1) * 4;
            f32x4 acc[4];
#pragma unroll
            for (int n = 0; n < 4; ++n) acc[n] = (f32x4){0.f, 0.f, 0.f, 0.f};
#pragma unroll
            for (int kk = 0; kk < 4; ++kk) {
                const bf16x8 a = *(const LAS bf16x8*)(QA + (tt * 16 + fr) * 136 + kk * 32 + fq * 8);
#pragma unroll
                for (int n = 0; n < 4; ++n) { const bf16x8 bb = *(const LAS bf16x8*)(SS + ((n0 + n) * 16 + fr) * 136 + kk * 32 + fq * 8); acc[n] = __builtin_amdgcn_mfma_f32_16x16x32_bf16(a, bb, acc[n], 0, 0, 0); }
            }
#pragma unroll
            for (int kk = 0; kk < 2; ++kk) {
                if (kk * 32 <= tt * 16 + 15) {
                    const bf16x8 a = *(const LAS bf16x8*)(AT + (tt * 16 + fr) * 72 + kk * 32 + fq * 8);
#pragma unroll
                    for (int n = 0; n < 4; ++n) { const bf16x8 bb = *(const LAS bf16x8*)(VT + ((n0 + n) * 16 + fr) * 72 + kk * 32 + fq * 8); acc[n] = __builtin_amdgcn_mfma_f32_16x16x32_bf16(a, bb, acc[n], 0, 0, 0); }
                }
            }
            LAS float* OS = BC;
#pragma unroll
            for (int n = 0; n < 4; ++n)
#pragma unroll
                for (int jj = 0; jj < 4; ++jj) OS[(tt * 16 + fq * 4 + jj) * 128 + (n0 + n) * 16 + fr] = acc[n][jj];
        }
    }
    {
        bf16x8 af[2];
#pragma unroll
        for (int kk = 0; kk < 2; ++kk)
#pragma unroll
            for (int i = 0; i < 8; ++i) af[kk][i] = (short)KA[(kk * 32 + fq * 8 + i) * 136 + w * 16 + fr];
#pragma unroll
        for (int n = 0; n < 8; ++n) {
            f32x4 acc = (f32x4){0.f, 0.f, 0.f, 0.f};
#pragma unroll
            for (int kk = 0; kk < 2; ++kk) { const bf16x8 bb = *(const LAS bf16x8*)(VT + (n * 16 + fr) * 72 + kk * 32 + fq * 8); acc = __builtin_amdgcn_mfma_f32_16x16x32_bf16(af[kk], bb, acc, 0, 0, 0); }
#pragma unroll
            for (int jj = 0; jj < 4; ++jj) S[n][jj] = gsc[jj] * S[n][jj] + sc[jj] * acc[jj];
        }
        if (PASS == 1) {
#pragma unroll
            for (int jj = 0; jj < 4; ++jj) Gt[jj] *= gsc[jj];
        }
    }
    if (PASS == 2) {
        __syncthreads();
        LAS float* OS = BC;
        const int t2 = tid >> 3, e16 = (tid & 7) * 16;
        f32x4 ov[4]; float ss = 0.f;
#pragma unroll
        for (int q = 0; q < 4; ++q) { ov[q] = *(const LAS f32x4*)(OS + t2 * 128 + e16 + q * 4); ss += (ov[q][0] * ov[q][0] + ov[q][1] * ov[q][1]) + (ov[q][2] * ov[q][2] + ov[q][3] * ov[q][3]); }
        ss += __shfl_xor(ss, 1); ss += __shfl_xor(ss, 2); ss += __shfl_xor(ss, 4);
        const float rstd = rsqrtf(ss * (1.0f / 128.0f) + EPS);
        bf16_t* yp = Y + tiled(rowbase + t2, 512 + h * 128 + e16, 1024);
#pragma unroll
        for (int hlf = 0; hlf < 2; ++hlf) {
            const u32x4 gv = gpre[hlf];
            const f32x4 n0v = gnv[hlf * 2], n1v = gnv[hlf * 2 + 1];
            u32x4 o;
#pragma unroll
            for (int q = 0; q < 4; ++q) {
                const float o0 = ov[hlf * 2 + (q >> 1)][(q & 1) * 2], o1 = ov[hlf * 2 + (q >> 1)][(q & 1) * 2 + 1];
                const float g0 = (q < 2) ? n0v[2 * q] : n1v[2 * q - 4], g1 = (q < 2) ? n0v[2 * q + 1] : n1v[2 * q - 3];
                o[q] = cvt_pk_bf16(o0 * rstd * g0 * silu_(bf_lo(gv[q])), o1 * rstd * g1 * silu_(bf_hi(gv[q])));
            }
            *(u32x4*)(yp + hlf * 8) = o;
        }
        __syncthreads();
    }
}
template <int PASS>
__device__ __forceinline__ void hgrn2_run(LAS unsigned char* lds, const Params& p, int j, int bid, int G, int nitems) {
    f32x4 S[8]; float Gt[4]; float lbv[8]; HcPre nxt;
    const int nsteps = nitems * 8;
    if (nsteps <= 0) return;
    hgrn2_load<PASS>(p, bid, 0, nxt);
#pragma unroll 1
    for (int step = 0; step < nsteps; ++step) {
        const bool mir = (G == 32) && (nitems == 2);
        const int k0 = step >> 3, k1 = (step + 1) >> 3;
        const int item = (mir && k0 == 1) ? ((bid & ~31) + 32 + ((bid & 31) ^ 7)) : bid + k0 * G, c = step & 7;
        const HcPre cur = nxt;
        if (step + 1 < nsteps) hgrn2_load<PASS>(p, (mir && k1 == 1) ? ((bid & ~31) + 32 + ((bid & 31) ^ 7)) : bid + k1 * G, (step + 1) & 7, nxt);
        if (c == 0) {
            hgrn2_init<PASS>(p, item, S, Gt);
            int tl = threadIdx.x; asm volatile("" : "+v"(tl));
            const int hh = (item >> 3) & 3, d8l = (tl & 15) * 8; const float* lbl = p.in[11];
#pragma unroll
            for (int q = 0; q < 8; ++q) { const int ch = hh * 128 + d8l + q; lbv[q] = (j == 0) ? 0.f : sigmoid_(lbl[512 + ch] - lbl[ch]); }
        }
        hgrn2_chunk<PASS>(lds, p, j, item, c, cur, S, Gt, lbv);
        if (PASS == 1 && c == 7) hgrn2_finish(p, item, S, Gt);
    }
    __syncthreads();
}

struct SguPre { u32x4 vv[4]; u32x2 uv[8]; };
__device__ __forceinline__ void sgu_load(const Params& p, int item, SguPre& r) {
    int tid = threadIdx.x; asm volatile("" : "+v"(tid));
    const int lane = tid & 63, w = __builtin_amdgcn_readfirstlane(tid >> 6), fr = lane & 15, fq = lane >> 4;
    const int g = item & 3, n = (item >> 2) & 31, b = item >> 7;
    const bf16_t* PROJ = (const bf16_t*)(p.ws + WS_BIG);
    const size_t rowbase = (size_t)b * SEQ + n * 128;
    const bf16_t* vp = PROJ + proj_off(rowbase + (tid >> 2), 1536) + 512 + g * 128 + (tid & 3) * 32;
#pragma unroll
    for (int i = 0; i < 4; ++i) r.vv[i] = *(const u32x4*)(vp + i * 8);
    const bf16_t* up = PROJ + proj_off(rowbase + w * 16 + fr, 1536) + g * 128 + fq * 4;
#pragma unroll
    for (int q = 0; q < 8; ++q) r.uv[q] = *(const u32x2*)(up + q * 16);
}
__device__ __forceinline__ void sgu_weights(LAS unsigned char* lds, const Params& p, int j, int g) {
    int tid = threadIdx.x; asm volatile("" : "+v"(tid));
    LAS bf16_t* WL = (LAS bf16_t*)(lds + 69632);
    const bf16_t* Wm = (const bf16_t*)(p.ws + WS_SMALL + SM_SGUW) + (size_t)(j * 4 + g) * 16384;
#pragma unroll
    for (int i = 0; i < 4; ++i) { const int idx = tid + i * 512; *(LAS u32x4*)(WL + (idx >> 4) * 136 + (idx & 15) * 8) = *(const u32x4*)(Wm + (idx >> 4) * 128 + (idx & 15) * 8); }
}
__device__ __forceinline__ void sgu_item(LAS unsigned char* lds, const Params& p, int j, int item, const SguPre& pre) {
    int tid = threadIdx.x; asm volatile("" : "+v"(tid));
    const int lane = tid & 63, w = __builtin_amdgcn_readfirstlane(tid >> 6), fr = lane & 15, fq = lane >> 4;
    const int g = item & 3, n = (item >> 2) & 31, b = item >> 7;
    bf16_t* Y = (bf16_t*)(p.ws + WS_Y);
    const size_t rowbase = (size_t)b * SEQ + n * 128;
    LAS bf16_t* VT = (LAS bf16_t*)lds;
    LAS bf16_t* WL = (LAS bf16_t*)(lds + 69632);
    const int tC = w * 16 + fr;
    u32x2 uv[8];
#pragma unroll
    for (int q = 0; q < 8; ++q) uv[q] = pre.uv[q];
    {
        const int s = tid >> 2, qtr = tid & 3;
        float v[32]; float sum = 0.f;
#pragma unroll
        for (int i = 0; i < 4; ++i) { const u32x4 vv = pre.vv[i];
#pragma unroll
            for (int q = 0; q < 4; ++q) { v[i * 8 + 2 * q] = bf_lo(vv[q]); v[i * 8 + 2 * q + 1] = bf_hi(vv[q]); sum += v[i * 8 + 2 * q] + v[i * 8 + 2 * q + 1]; } }
        sum += __shfl_xor(sum, 1); sum += __shfl_xor(sum, 2);
        const float mu = sum * (1.0f / 128.0f); float var = 0.f;
#pragma unroll
        for (int i = 0; i < 32; ++i) { v[i] -= mu; var += v[i] * v[i]; }
        var += __shfl_xor(var, 1); var += __shfl_xor(var, 2);
        const float rstd = rsqrtf(var * (1.0f / 128.0f) + EPS);
        LAS bf16_t* VN = (LAS bf16_t*)(lds + 34816);
#pragma unroll
        for (int i = 0; i < 4; ++i) { u32x4 o;
#pragma unroll
            for (int q = 0; q < 4; ++q) o[q] = cvt_pk_bf16(v[i * 8 + 2 * q] * rstd, v[i * 8 + 2 * q + 1] * rstd);
            *(LAS u32x4*)(VN + s * 136 + qtr * 32 + i * 8) = o; }
    }
    __syncthreads();
    {
        LAS const bf16_t* VN = (LAS const bf16_t*)(lds + 34816);
        const int c = tid & 127, sq = tid >> 7;
        bf16_t vq[32];
#pragma unroll
        for (int i = 0; i < 32; ++i) vq[i] = VN[(sq * 32 + i) * 136 + c];
#pragma unroll
        for (int i = 0; i < 4; ++i) { u32x4 o;
#pragma unroll
            for (int q = 0; q < 4; ++q) o[q] = (unsigned)vq[i * 8 + 2 * q] | ((unsigned)vq[i * 8 + 2 * q + 1] << 16);
            *(LAS u32x4*)(VT + c * 136 + sq * 32 + i * 8) = o; }
    }
    __syncthreads();
    {
        f32x4 acc[8];
#pragma unroll
        for (int q = 0; q < 8; ++q) acc[q] = (f32x4){0.f, 0.f, 0.f, 0.f};
        const int kmax = w >> 1;
#pragma unroll
        for (int kk = 0; kk < 4; ++kk) {
            if (kk <= kmax) {
                const bf16x8 wf = *(const LAS bf16x8*)(WL + (w * 16 + fr) * 136 + kk * 32 + fq * 8);
#pragma unroll
                for (int q = 0; q < 8; ++q) { const bf16x8 vf = *(const LAS bf16x8*)(VT + (q * 16 + fr) * 136 + kk * 32 + fq * 8); acc[q] = __builtin_amdgcn_mfma_f32_16x16x32_bf16(vf, wf, acc[q], 0, 0, 0); }
            }
        }
        const float bias = p.in[16][(size_t)(j * 4 + g) * 128 + tC];
        bf16_t* yp = Y + tiled(rowbase + tC, g * 128 + fq * 4, 1024);
#pragma unroll
        for (int q = 0; q < 8; ++q) {
            u32x2 o; o.x = cvt_pk_bf16(bf_lo(uv[q].x) * (acc[q][0] + bias), bf_hi(uv[q].x) * (acc[q][1] + bias)); o.y = cvt_pk_bf16(bf_lo(uv[q].y) * (acc[q][2] + bias), bf_hi(uv[q].y) * (acc[q][3] + bias));
            *(u32x2*)(yp + (q >> 2) * 16384 + (q & 3) * 16) = o;
        }
    }
    __syncthreads();
}

struct PoolPre { u32x4 pl[5]; u32x4 wt[4]; };
__device__ __forceinline__ void pool_load(const Params& p, int j, int item, PoolPre& r) {
    int tid = threadIdx.x; asm volatile("" : "+v"(tid));
    const int gi = item & 3, tile = (item >> 2) & 31, b = item >> 7;
    const bf16_t* PROJ = (const bf16_t*)(p.ws + WS_BIG);
    const int t0 = tile * 128;
    const bf16_t* PWT = (const bf16_t*)(p.ws + WS_SMALL + SM_PWT) + (size_t)(j * 4 + gi) * 16384;
#pragma unroll
    for (int i = 0; i < 4; ++i) { const int idx = tid + i * 512; r.wt[i] = *(const u32x4*)(PWT + (idx >> 4) * 128 + (idx & 15) * 8); }
#pragma unroll
    for (int i = 0; i < 5; ++i) {
        const int idx = tid + i * 512; const int rr = idx >> 4, c8 = (idx & 15) * 8; const int ts = t0 - 16 + rr;
        u32x4 vv = (u32x4){0u, 0u, 0u, 0u};
        if (idx < 144 * 16 && ts >= 0) vv = *(const u32x4*)(PROJ + proj_off((size_t)b * SEQ + ts, 1536) + 1024 + gi * 128 + c8);
        r.pl[i] = vv;
    }
}
__device__ __forceinline__ void pool_item(LAS unsigned char* lds, const Params& p, int j, int item, const PoolPre& pre) {
    int tid = threadIdx.x; asm volatile("" : "+v"(tid));
    const int lane = tid & 63, w = __builtin_amdgcn_readfirstlane(tid >> 6), fr = lane & 15, fq = lane >> 4;
    const int gi = item & 3, tile = (item >> 2) & 31, b = item >> 7;
    bf16_t* Y = (bf16_t*)(p.ws + WS_Y);
    const int t0 = tile * 128;
    const size_t rowbase = (size_t)b * SEQ + t0;
    LAS float* PL = (LAS float*)lds;
    LAS bf16_t* PA = (LAS bf16_t*)(lds + 73728);
    LAS bf16_t* PWL = (LAS bf16_t*)(lds + 108544);
    {
#pragma unroll
        for (int i = 0; i < 5; ++i) {
            const int idx = tid + i * 512;
            if (idx < 144 * 16) {
                const int rr = idx >> 4, c8 = (idx & 15) * 8; const u32x4 vv = pre.pl[i];
                *(LAS f32x4*)(PL + rr * 128 + c8) = (f32x4){bf_lo(vv[0]), bf_hi(vv[0]), bf_lo(vv[1]), bf_hi(vv[1])};
                *(LAS f32x4*)(PL + rr * 128 + c8 + 4) = (f32x4){bf_lo(vv[2]), bf_hi(vv[2]), bf_lo(vv[3]), bf_hi(vv[3])};
            }
        }
#pragma unroll
        for (int i = 0; i < 4; ++i) { const int idx = tid + i * 512; *(LAS u32x4*)(PWL + (idx >> 4) * 136 + (idx & 15) * 8) = pre.wt[i]; }
    }
    __syncthreads();
    {
        const int tg = tid >> 4, c8 = (tid & 15) * 8; const int win = 2 << gi;
        const int tf = tg * 4;
        f32x4 s0 = (f32x4){0.f, 0.f, 0.f, 0.f}, s1 = (f32x4){0.f, 0.f, 0.f, 0.f};
        for (int k = 0; k < win; ++k) { const LAS float* rp = PL + (tf + 16 - k) * 128 + c8; s0 += *(const LAS f32x4*)rp; s1 += *(const LAS f32x4*)(rp + 4); }
#pragma unroll
        for (int i = 0; i < 4; ++i) {
            const int t = tf + i;
            const LAS float* cp = PL + (t + 16) * 128 + c8;
            const f32x4 c0 = *(const LAS f32x4*)cp, c1 = *(const LAS f32x4*)(cp + 4);
            if (i > 0) { const LAS float* op = PL + (t + 16 - win) * 128 + c8; s0 += c0 - *(const LAS f32x4*)op; s1 += c1 - *(const LAS f32x4*)(op + 4); }
            const int tabs = t0 + t; const int cnt = (tabs + 1 < win) ? tabs + 1 : win;
            const float inv = rcp_((float)cnt);
            const f32x4 a = s0 * inv - c0, bq = s1 * inv - c1;
            u32x4 o; o.x = cvt_pk_bf16(a[0], a[1]); o.y = cvt_pk_bf16(a[2], a[3]); o.z = cvt_pk_bf16(bq[0], bq[1]); o.w = cvt_pk_bf16(bq[2], bq[3]);
            *(LAS u32x4*)(PA + t * 136 + c8) = o;
        }
    }
    __syncthreads();
    {
        f32x4 acc[8];
#pragma unroll
        for (int q = 0; q < 8; ++q) acc[q] = (f32x4){0.f, 0.f, 0.f, 0.f};
#pragma unroll
        for (int kk = 0; kk < 4; ++kk) {
            const bf16x8 pf = *(const LAS bf16x8*)(PA + (w * 16 + fr) * 136 + kk * 32 + fq * 8);
#pragma unroll
            for (int q = 0; q < 8; ++q) { const bf16x8 wf = *(const LAS bf16x8*)(PWL + (q * 16 + fr) * 136 + kk * 32 + fq * 8); acc[q] = __builtin_amdgcn_mfma_f32_16x16x32_bf16(wf, pf, acc[q], 0, 0, 0); }
        }
        const int t = w * 16 + fr;
        bf16_t* yp = Y + tiled(rowbase + t, 512 + gi * 128 + fq * 4, 1024);
#pragma unroll
        for (int q = 0; q < 8; ++q) { u32x2 o; o.x = cvt_pk_bf16(acc[q][0], acc[q][1]); o.y = cvt_pk_bf16(acc[q][2], acc[q][3]); *(u32x2*)(yp + (q >> 2) * 16384 + (q & 3) * 16) = o; }
    }
    __syncthreads();
}

__device__ __forceinline__ void zero_y(const Params& p) {
    int tid = threadIdx.x; asm volatile("" : "+v"(tid));
    u32x4* yz = (u32x4*)(p.ws + WS_Y);
    for (size_t i = (size_t)blockIdx.x * NTHR + tid; i < (size_t)MTOK * 128; i += (size_t)gridDim.x * NTHR) yz[i] = (u32x4){0u, 0u, 0u, 0u};
}
__device__ __forceinline__ void final_norm(const Params& p) {
    int tid = threadIdx.x; asm volatile("" : "+v"(tid));
    const int lane = tid & 63, wave = tid >> 6;
    const int gw = blockIdx.x * 8 + wave, NGW = gridDim.x * 8;
    const float* rowss = (const float*)(p.ws + WS_ROWSS); const float* gain = p.in[22];
    f32x4 gv[4];
#pragma unroll
    for (int q = 0; q < 4; ++q) gv[q] = *((const f32x4*)gain + lane + 64 * q);
    for (int row = gw; row < MTOK; row += 2 * NGW) {
        const int row2 = row + NGW;
        f32x4* hr = (f32x4*)(p.out + (size_t)row * DM) + lane; f32x4* hr2 = (f32x4*)(p.out + (size_t)row2 * DM) + lane;
        f32x4 v[4], v2[4];
#pragma unroll
        for (int q = 0; q < 4; ++q) { v[q] = hr[64 * q]; v2[q] = hr2[64 * q]; }
        const f32x4* sp = (const f32x4*)(rowss + (size_t)row * 16); const f32x4* sp2 = (const f32x4*)(rowss + (size_t)row2 * 16);
        const f32x4 st = (sp[0] + sp[1]) + (sp[2] + sp[3]), st2 = (sp2[0] + sp2[1]) + (sp2[2] + sp2[3]);
        const float rstd = rsqrtf(((st[0] + st[1]) + (st[2] + st[3])) * (1.0f / 1024.0f) + EPS);
        const float rstd2 = rsqrtf(((st2[0] + st2[1]) + (st2[2] + st2[3])) * (1.0f / 1024.0f) + EPS);
#pragma unroll
        for (int q = 0; q < 4; ++q) { hr[64 * q] = v[q] * rstd * gv[q]; hr2[64 * q] = v2[q] * rstd2 * gv[q]; }
    }
}

#define XB_TMO      128
#define XB_XCNT(j)  (256  + 64 * (j))
#define XB_XSUB(j)  (1280 + 64 * (j))
#define XB_XGEN(j)  (2304 + 64 * (j))
#define XB_TOP      3328
#define XB_TOPGEN   3392
#define XCD_BAR_WORDS 3456
#define XB_SPIN_CAP (1u << 18)
__device__ __forceinline__ unsigned xb_ld(unsigned* p)              { return __hip_atomic_load(p, __ATOMIC_RELAXED, __HIP_MEMORY_SCOPE_AGENT); }
__device__ __forceinline__ unsigned xb_add(unsigned* p, unsigned v) { return __hip_atomic_fetch_add(p, v, __ATOMIC_RELAXED, __HIP_MEMORY_SCOPE_AGENT); }
__device__ __forceinline__ unsigned xb_xcc_id() { return (unsigned)__builtin_amdgcn_s_getreg((3 << 11) | 20) & 0xFu; }
#define XB_SPIN(cond, bar) do { unsigned _sp = 0; while (cond) { __builtin_amdgcn_s_sleep(1); \
    if ((++_sp & 255u) == 0u) { if (xb_ld(&(bar)[XB_TMO])) break; if (_sp > XB_SPIN_CAP) { atomicAdd(&(bar)[XB_TMO], 1u); break; } } } } while (0)
struct XcdBarrier { unsigned* bar; unsigned x; volatile LAS unsigned* st; };
__device__ __forceinline__ XcdBarrier xcd_barrier_post(unsigned* bar, volatile LAS unsigned* st) {
    XcdBarrier b; b.bar = bar; b.x = xb_xcc_id(); b.st = st;
    if (threadIdx.x == 0) (void)xb_add(&bar[XB_XCNT(b.x)], 1u);
    return b;
}
__device__ __forceinline__ void xcd_barrier_complete(unsigned* bar, unsigned x, unsigned& nloc, unsigned& nx) {
    const unsigned G = gridDim.x * gridDim.y * gridDim.z;
    unsigned sum, cnt, mine, sp = 0u;
    for (;;) {
        sum = 0u; cnt = 0u; mine = 0u;
#pragma unroll
        for (unsigned j = 0; j < 16; ++j) { const unsigned c = xb_ld(&bar[XB_XCNT(j)]); sum += c; cnt += (c > 0u) ? 1u : 0u; mine = (j == x) ? c : mine; }
        if (sum == G) break;
        __builtin_amdgcn_s_sleep(1);
        if ((++sp & 255u) == 0u) { if (xb_ld(&bar[XB_TMO])) break; if (sp > XB_SPIN_CAP) { atomicAdd(&bar[XB_TMO], 1u); break; } }
    }
    nloc = mine > 0u ? mine : 1u; nx = cnt > 0u ? cnt : 1u;
}
__device__ __forceinline__ void xcd_barrier(const XcdBarrier& b) {
    asm volatile("s_waitcnt vmcnt(0)" ::: "memory");
    __syncthreads();
    if (threadIdx.x == 0) {
        unsigned* bar = b.bar;
        __builtin_amdgcn_s_waitcnt(0);
        unsigned nloc = b.st[0], nx = b.st[1];
        if (nloc == 0u) { xcd_barrier_complete(bar, b.x, nloc, nx); b.st[0] = nloc; b.st[1] = nx; }
        const unsigned old = xb_add(&bar[XB_XSUB(b.x)], 1u);
        const unsigned gen = old / nloc;
        if (old + 1u == (gen + 1u) * nloc) {
            __builtin_amdgcn_fence(__ATOMIC_RELEASE, "agent");
            asm volatile("s_waitcnt vmcnt(0)" ::: "memory");
            const unsigned og = xb_add(&bar[XB_TOP], 1u);
            const unsigned tg = og / nx;
            if (og + 1u == (tg + 1u) * nx) xb_add(&bar[XB_TOPGEN], 1u);
            else XB_SPIN(xb_ld(&bar[XB_TOPGEN]) == tg, bar);
            __builtin_amdgcn_fence(__ATOMIC_ACQUIRE, "agent");
            xb_add(&bar[XB_XGEN(b.x)], 1u);
            asm volatile("s_waitcnt vmcnt(0)" ::: "memory");
        } else {
            XB_SPIN(xb_ld(&bar[XB_XGEN(b.x)]) == gen, bar);
            __builtin_amdgcn_fence(__ATOMIC_ACQUIRE, "agent");
            asm volatile("s_waitcnt vmcnt(0)" ::: "memory");
        }
    }
    __syncthreads();
}

__device__ __forceinline__ void xcd_local_barrier(const XcdBarrier& b) {
    asm volatile("s_waitcnt vmcnt(0)" ::: "memory");
    __syncthreads();
    if (threadIdx.x == 0) {
        unsigned* bar = b.bar;
        __builtin_amdgcn_s_waitcnt(0);
        const unsigned nloc = b.st[0];
        const unsigned old = xb_add(&bar[XB_XSUB(b.x)], 1u);
        const unsigned gen = old / nloc;
        if (old + 1u == (gen + 1u) * nloc) xb_add(&bar[XB_XGEN(b.x)], 1u);
        else XB_SPIN(xb_ld(&bar[XB_XGEN(b.x)]) == gen, bar);
        __builtin_amdgcn_fence(__ATOMIC_ACQUIRE, "agent");
        asm volatile("s_waitcnt vmcnt(0)" ::: "memory");
    }
    __syncthreads();
}

__global__ void __launch_bounds__(NTHR, 2) fwd_megakernel(Params p) {
    extern __shared__ __attribute__((aligned(16))) unsigned char lds_raw[];
    LAS unsigned char* lds = (LAS unsigned char*)lds_raw;
    const int G = gridDim.x, bid = blockIdx.x;
    bf16_t* WTb = (bf16_t*)(p.ws + WS_WT);
    bf16_t* HB = (bf16_t*)(p.ws + WS_HB); bf16_t* Y = (bf16_t*)(p.ws + WS_Y); bf16_t* BIG = (bf16_t*)(p.ws + WS_BIG);
    float* rowss = (float*)(p.ws + WS_ROWSS);

    volatile LAS unsigned* xst = (volatile LAS unsigned*)(lds + LDS_BYTES - 64);
    if (threadIdx.x < 8) xst[threadIdx.x] = 0u;
    __syncthreads();
    XcdBarrier xbar; xbar.bar = (unsigned*)(p.ws + WS_BAR); xbar.st = xst; xbar.x = xb_xcc_id();
    if (threadIdx.x == 0) xst[2] = xb_add(&xbar.bar[XB_XCNT(xbar.x)], 1u);
    for (int rep = 0; rep < DBG_REP_P0; ++rep) phase0(lds, p);
    cg::this_grid().sync();
    if (threadIdx.x == 0) {
        bool okc = (G % 8) == 0;
        for (unsigned jx = 0; jx < 16; ++jx) { const unsigned cx = xb_ld(&xbar.bar[XB_XCNT(jx)]); okc = okc && (cx == (jx < 8 ? (unsigned)G / 8u : 0u)); }
        xst[4] = okc ? (xst[2] * 8u + xbar.x) : (unsigned)bid; xst[5] = okc ? 1u : 0u;
    }
    __syncthreads();
    const int vid = __builtin_amdgcn_readfirstlane((int)xst[4]);
    const bool xlocal = USE_LOCAL_BAR && (__builtin_amdgcn_readfirstlane((int)xst[5]) != 0);
    const int NX = ((G & 7) == 0) ? 8 : 1, xv = vid % NX, rk = vid / NX, RK = G / NX;
#define SEAM() do { if (xlocal) xcd_local_barrier(xbar); else xcd_barrier(xbar); } while (0)
#define GRID_SYNC() xcd_barrier(xbar)
#pragma unroll 1
    for (int layer = 0; layer < 4; ++layer) {
        const int j = layer >> 1;
        const bool even = (layer & 1) == 0;
        if (even) {
            pg8::Gemm g{HB, WTb + OFF_INE + (size_t)j * 3145728, MTOK, 3072, 1024}; pg8::StaticOrder S; int vq1 = vid, Gq1 = G; asm volatile("" : "+s"(vq1), "+s"(Gq1)); S.init(MTOK, 3072, Gq1, vq1, 0);
            pg8::EpiIn<0> E{BIG, 3072, rowss};
            pg8::gemm_phase(lds, g, S, E);
        } else {
            pg8::Gemm g{HB, WTb + OFF_INO + (size_t)j * 1572864, MTOK, 1536, 1024}; pg8::StaticOrder S; int vq2 = vid, Gq2 = G; asm volatile("" : "+s"(vq2), "+s"(Gq2)); S.init(MTOK, 1536, Gq2, vq2, 0);
            pg8::EpiIn<1> E{BIG, 1536, rowss};
            pg8::gemm_phase(lds, g, S, E);
        }
        if (layer == 0) GRID_SYNC(); else SEAM();
        if (even) {
            for (int i = rk; i < 256 / NX; i += RK) lru_pass<1>(lds, p, j, xv * (256 / NX) + i);
            hgrn2_run<1>(lds, p, j, xv * (512 / NX) + rk, RK, (512 / NX - rk + RK - 1) / RK);
            SEAM();
            for (int i = rk; i < 256 / NX; i += RK) lru_pass<2>(lds, p, j, xv * (256 / NX) + i);
            hgrn2_run<2>(lds, p, j, xv * (512 / NX) + rk, RK, (512 / NX - rk + RK - 1) / RK);
        } else {
            if (rk < 2048 / NX) {
                const int sbase = xv * (2048 / NX);
                if ((RK & 3) == 0) sgu_weights(lds, p, j, (sbase + rk) & 3);
                SguPre snx; sgu_load(p, sbase + rk, snx);
                for (int i = rk; i < 2048 / NX; i += RK) {
                    const SguPre scur = snx;
                    if ((RK & 3) != 0) { __syncthreads(); sgu_weights(lds, p, j, (sbase + i) & 3); }
                    if (i + RK < 2048 / NX) sgu_load(p, sbase + i + RK, snx);
                    sgu_item(lds, p, j, sbase + i, scur);
                }
            }
            if (rk < 2048 / NX) {
                const int pbase = xv * (2048 / NX);
                PoolPre pnx; pool_load(p, j, pbase + (rk & ~3) + (rk & 3), pnx);
                for (int i = rk, k = 0; i < 2048 / NX; i += RK, ++k) {
                    const PoolPre pcur = pnx;
                    const int i2 = i + RK;
                    if (i2 < 2048 / NX) pool_load(p, j, pbase + (i2 & ~3) + ((i2 + k + 1) & 3), pnx);
                    pool_item(lds, p, j, pbase + (i & ~3) + ((i + k) & 3), pcur);
                }
            }
        }
        SEAM();
        {
            const bf16_t* Wt = even ? WTb + OFF_OUTE + (size_t)j * 1048576 : WTb + OFF_OUTO + (size_t)j * 1048576;
            pg8::Gemm g{Y, Wt, MTOK, 1024, 1024}; pg8::StaticOrder S; int vq3 = vid, Gq3 = G; asm volatile("" : "+s"(vq3), "+s"(Gq3)); S.init(MTOK, 1024, Gq3, vq3, 1);
            pg8::EpiRes E{layer == 0 ? p.in[0] : (const float*)p.out, p.out, HB, rowss};
            pg8::gemm_phase(lds, g, S, E);
        }
        SEAM();
        {
            pg8::Gemm g{HB, WTb + OFF_FIN + (size_t)layer * 4194304, MTOK, 4096, 1024}; pg8::StaticOrder S; int vq4 = vid, Gq4 = G; asm volatile("" : "+s"(vq4), "+s"(Gq4)); S.init(MTOK, 4096, Gq4, vq4, 0);
            pg8::EpiIn<2> E{BIG, 4096, rowss};
            pg8::gemm_phase(lds, g, S, E);
        }
        SEAM();
        {
            pg8::Gemm g{BIG, WTb + OFF_FOUT + (size_t)layer * 4194304, MTOK, 1024, 4096}; pg8::StaticOrder S; int vq5 = vid, Gq5 = G; asm volatile("" : "+s"(vq5), "+s"(Gq5)); S.init(MTOK, 1024, Gq5, vq5, 1);
            pg8::EpiRes E{(const float*)p.out, p.out, HB, rowss};
            pg8::gemm_phase(lds, g, S, E);
        }
        if (layer == 3) GRID_SYNC(); else SEAM();
    }
    for (int rep = 0; rep < DBG_EXTRA_SYNCS; ++rep) GRID_SYNC();
    final_norm(p);
}

extern "C" void kernel_launch(void* const* d_in, const int* in_sizes, int n_in, void* d_out, int out_size, void* d_ws, size_t ws_size, hipStream_t stream) {
    static int grid_blocks = 0;
    if (!grid_blocks) {
        int dev = 0, cus = 0, per_cu = 0;
        (void)hipGetDevice(&dev);
        (void)hipDeviceGetAttribute(&cus, hipDeviceAttributeMultiprocessorCount, dev);
        (void)hipFuncSetAttribute((const void*)fwd_megakernel, hipFuncAttributeMaxDynamicSharedMemorySize, LDS_BYTES);
        (void)hipOccupancyMaxActiveBlocksPerMultiprocessor(&per_cu, (const void*)fwd_megakernel, NTHR, LDS_BYTES);
        (void)hipGetLastError();
        grid_blocks = cus > 0 ? cus : 256;
        if (n_in != 23 || out_size != MTOK * DM || ws_size < (size_t)868 * MiB) fprintf(stderr, "kernel_launch: unexpected shapes n_in %d out %d ws %zu\n", n_in, out_size, ws_size);
    }
    Params p{};
    for (int i = 0; i < 23; ++i) p.in[i] = (const float*)d_in[i];
    p.out = (float*)d_out; p.ws = (unsigned char*)d_ws;
    (void)hipMemsetAsync((unsigned char*)d_ws + WS_BAR, 0, 16384, stream);
    void* args[] = {&p};
    hipError_t e = hipLaunchCooperativeKernel((void*)fwd_megakernel, dim3(grid_blocks), dim3(NTHR), args, LDS_BYTES, stream);
    if (e != hipSuccess) fprintf(stderr, "cooperative launch failed: %s (grid %d)\n", hipGetErrorString(e), grid_blocks);
}
```

```cpp
#include <hip/hip_runtime.h>
#include <hip/hip_cooperative_groups.h>
#include <cstdio>
namespace cg = cooperative_groups;

#define LAS __attribute__((address_space(3)))
typedef unsigned short bf16_t;
typedef short bf16x8 __attribute__((ext_vector_type(8)));
typedef float f32x4 __attribute__((ext_vector_type(4)));
typedef unsigned u32x4 __attribute__((ext_vector_type(4)));
typedef unsigned u32x2 __attribute__((ext_vector_type(2)));

constexpr int MTOK = 65536, DM = 1024, SEQ = 4096;
constexpr float EPS = 1e-6f;
constexpr int LDS_BYTES = 155648;
#define DBG_REP_EVEN 1
#define DBG_REP_ODD 1
#define DBG_REP_FFNIN 1
#define DBG_REP_P0 1
#define DBG_EPI2 0
#define DBG_EXTRA_SYNCS 0
#define USE_LOCAL_BAR 1
#define DBG_SKIP_EVEN 0
#define DBG_SKIP_LRU 0
#define DBG_SKIP_HGRN 0
#define DBG_SKIP_ODD 0
constexpr int NTHR = 512;

constexpr size_t MiB = 1u << 20;
constexpr size_t WS_WT = 0;
constexpr size_t WS_SMALL = 90 * MiB;
constexpr size_t WS_BAR = 91 * MiB;
constexpr size_t WS_ROWSS = 92 * MiB;
constexpr size_t WS_LRUC = 96 * MiB;
constexpr size_t WS_HGG = 98 * MiB;
constexpr size_t WS_HB = 100 * MiB;
constexpr size_t WS_Y = 228 * MiB;
constexpr size_t WS_BIG = 356 * MiB;
constexpr size_t WS_ST = 868 * MiB;
constexpr size_t OFF_INE = 0, OFF_OUTE = 6291456, OFF_INO = 8388608, OFF_OUTO = 11534336, OFF_FIN = 13631488, OFF_FOUT = 30408704;
constexpr size_t SM_WAT = 0, SM_WXT = 256 * 1024, SM_SGUW = 512 * 1024, SM_PWT = 768 * 1024;

struct Params { const float* in[23]; float* out; unsigned char* ws; };

typedef float f32x2_ __attribute__((ext_vector_type(2)));
typedef __bf16 bf16x2_ __attribute__((ext_vector_type(2)));
__device__ __forceinline__ unsigned cvt_pk_bf16(float lo, float hi) { f32x2_ v = {lo, hi}; bf16x2_ r = __builtin_convertvector(v, bf16x2_); return __builtin_bit_cast(unsigned, r); }
__device__ __forceinline__ float bf_lo(unsigned w) { return __uint_as_float(w << 16); }
__device__ __forceinline__ float bf_hi(unsigned w) { return __uint_as_float(w & 0xffff0000u); }
__device__ __forceinline__ float bf2f(bf16_t b) { return __uint_as_float(((unsigned)b) << 16); }
__device__ __forceinline__ bf16_t f2bf(float f) { return (bf16_t)(cvt_pk_bf16(f, 0.f) & 0xffffu); }
__device__ __forceinline__ float rcp_(float x) { return __builtin_amdgcn_rcpf(x); }
__device__ __forceinline__ float sigmoid_(float x) { return rcp_(1.0f + __expf(-x)); }
__device__ __forceinline__ float gelu_tanh(float x) { const float u = 0.7978845608f * (x + 0.044715f * x * x * x); return x * rcp_(1.0f + __expf(-2.0f * u)); }
__device__ __forceinline__ float silu_(float x) { return x * rcp_(1.0f + __expf(-x)); }
__device__ __forceinline__ size_t tiled(size_t row, int col, int K) { return ((row >> 8) * (size_t)K + (size_t)(col >> 6) * 64) * 256 + ((row & 255) << 6) + (size_t)(col & 63); }
__device__ __forceinline__ size_t proj_off(size_t row, int ldc) { return (row >> 13) * (size_t)33554432 + (row & 8191) * (size_t)ldc; }
#define LDS_WAIT() asm volatile("s_waitcnt lgkmcnt(0)" ::: "memory")

namespace pg8 {
constexpr int BM = 256, BK = 64, HALF = 128, HTB = HALF * BK * 2, STAGE_BYTES = 8 * HTB, NXCD = 8, WGM = 4;
__host__ __device__ __forceinline__ int lds_byte(int r, int c) { const int st = (r >> 4) * 2 + (c >> 5), rr = r & 15, cc = c & 31, ob = rr * 64 + cc * 2; return st * 1024 + (ob ^ (((ob >> 9) & 1) << 5)); }
__host__ __device__ __forceinline__ void stage_rc(int b, int& R, int& C) { const int st = b / 1024, sb = b % 1024, swz = sb ^ (((sb >> 9) & 1) << 5); R = (st >> 1) * 16 + swz / 64; C = (st & 1) * 32 + (swz % 64) / 2; }
__host__ __device__ __forceinline__ int perm32(int rho) { const int n = rho >> 4, i = rho & 15; return 8 * (i >> 2) + 4 * n + (i & 3); }
struct Unit { int pm, pn; };
struct Gemm { const bf16_t* A; const bf16_t* Bt; int M, N, K; };
struct StaticOrder {
    int nM, nN, nwg, G, c, rev;
    __device__ void init(int M, int N, int G_, int c_, int rev_ = 0) { nM = M / BM; nN = N / BM; nwg = nM * nN; G = G_; c = c_; rev = rev_; }
    __device__ bool next(int i, Unit& u) const {
        const int nround = (nwg + G - 1) / G; if (i >= nround) return false;
        const long L = (long)(rev ? (nround - 1 - i) : i) * G + c; if (L >= nwg) return false;
        int wgid = (int)L; { const int q = nwg / NXCD, r = nwg % NXCD, xcd = wgid % NXCD, off = wgid / NXCD; wgid = (xcd < r ? xcd * (q + 1) : r * (q + 1) + (xcd - r) * q) + off; }
        const int nig = WGM * nN, gid = wgid / nig, fm = gid * WGM, gsz = (nM - fm) < WGM ? (nM - fm) : WGM;
        u.pm = fm + ((wgid % nig) % gsz); u.pn = (wgid % nig) / gsz; return true;
    }
};

template <int ACT> struct EpiIn {
    static constexpr bool PERM = true, PRE = true;
    bf16_t* O; int ldc; const float* rowss;
    __device__ __forceinline__ void operator()(const f32x4 (&acc)[2][2][4][2], const Unit& u, int wr, int wc, int fr, int fq, const LAS float* RS) const {
        const int row0 = u.pm * BM + wr * 64 + fr, col0 = u.pn * BM + wc * 32 + 8 * fq;
        const bool do_gelu = (ACT == 1) && (u.pn < 4);
        float rs[8];
#pragma unroll
        for (int i = 0; i < 8; ++i) rs[i] = RS[(i >> 2) * HALF + wr * 64 + (i & 3) * 16 + fr];
#pragma unroll
        for (int ai = 0; ai < 2; ++ai)
#pragma unroll
            for (int m = 0; m < 4; ++m) {
                const int row = row0 + ai * HALF + m * 16;
                const float rstd = rs[ai * 4 + m];
                bf16_t* rowp = (ACT == 2) ? O + tiled((size_t)row, col0, ldc) : O + proj_off((size_t)row, ldc) + col0;
#pragma unroll
                for (int bj = 0; bj < 2; ++bj) {
                    f32x4 v0 = acc[ai][bj][m][0] * rstd, v1 = acc[ai][bj][m][1] * rstd;
                    if (ACT == 1) { if (do_gelu) {
#pragma unroll
                        for (int q = 0; q < 4; ++q) { v0[q] = gelu_tanh(v0[q]); v1[q] = gelu_tanh(v1[q]); } } }
                    if (ACT == 2) {
#pragma unroll
                        for (int q = 0; q < 4; ++q) { const float a = fmaxf(v0[q], 0.f), b = fmaxf(v1[q], 0.f); v0[q] = a * a; v1[q] = b * b; } }
                    u32x4 w; w.x = cvt_pk_bf16(v0[0], v0[1]); w.y = cvt_pk_bf16(v0[2], v0[3]); w.z = cvt_pk_bf16(v1[0], v1[1]); w.w = cvt_pk_bf16(v1[2], v1[3]);
                    *(u32x4*)(rowp + bj * ((ACT == 2) ? HALF * 256 : HALF)) = w;
                }
            }
    }
};
struct EpiRes {
    static constexpr bool PERM = true, PRE = false;
    const float* res; float* H; bf16_t* HB; float* rowss;
    __device__ __forceinline__ void operator()(const f32x4 (&acc)[2][2][4][2], const Unit& u, int wr, int wc, int fr, int fq, const LAS float*) const {
        const int row0 = u.pm * BM + wr * 64 + fr, col0 = u.pn * BM + wc * 32 + 8 * fq;
#pragma unroll
        for (int ai = 0; ai < 2; ++ai) {
            f32x4 r[4][4];
#pragma unroll
            for (int m = 0; m < 4; ++m) {
                const size_t off = (size_t)(row0 + ai * HALF + m * 16) * DM + col0;
#pragma unroll
                for (int q = 0; q < 4; ++q) r[m][q] = *(const f32x4*)(res + off + (q >> 1) * HALF + (q & 1) * 4);
            }
#pragma unroll
            for (int m = 0; m < 4; ++m) {
                const int row = row0 + ai * HALF + m * 16;
                const size_t off = (size_t)row * DM + col0;
                float ss = 0.f;
#pragma unroll
                for (int bj = 0; bj < 2; ++bj) {
                    const f32x4 v0 = r[m][bj * 2] + acc[ai][bj][m][0], v1 = r[m][bj * 2 + 1] + acc[ai][bj][m][1];
                    *(f32x4*)(H + off + bj * HALF) = v0; *(f32x4*)(H + off + bj * HALF + 4) = v1;
                    ss += ((v0[0] * v0[0] + v0[1] * v0[1]) + (v0[2] * v0[2] + v0[3] * v0[3])) + ((v1[0] * v1[0] + v1[1] * v1[1]) + (v1[2] * v1[2] + v1[3] * v1[3]));
                    u32x4 w; w.x = cvt_pk_bf16(v0[0], v0[1]); w.y = cvt_pk_bf16(v0[2], v0[3]); w.z = cvt_pk_bf16(v1[0], v1[1]); w.w = cvt_pk_bf16(v1[2], v1[3]);
                    *(u32x4*)(HB + tiled((size_t)row, col0 + bj * HALF, DM)) = w;
                }
                ss += __shfl_xor(ss, 16); ss += __shfl_xor(ss, 32);
                if (fq == 0) rowss[(size_t)row * 16 + u.pn * 4 + wc] = ss;
            }
        }
    }
};

template <class Epi, class Sched>
__device__ __forceinline__ void gemm_phase(LAS unsigned char* lds, const Gemm g, const Sched& S, const Epi& E) {
    int tid = threadIdx.x; asm volatile("" : "+v"(tid));
    const int wid = __builtin_amdgcn_readfirstlane(tid >> 6), lane = tid & 63, wr = wid >> 2, wc = wid & 3, fr = lane & 15, fq = lane >> 4;
    const int K = g.K, nt = K / BK;
    unsigned voffA[2], voffB[2];
#pragma unroll
    for (int i = 0; i < 2; ++i) { int R, C; stage_rc(tid * 16 + i * 8192, R, C); const int Rb = Epi::PERM ? ((R & ~31) + perm32(R & 31)) : R;
        voffA[i] = (unsigned)(R * BK + C) * 2u; voffB[i] = (unsigned)(Rb * K + C) * 2u; }
    const size_t kstep = (size_t)(BK * 2);
    const size_t hstep = (size_t)HALF * K * 2;
    const size_t tstep = 2 * hstep;
    const size_t kstepA = (size_t)BM * BK * 2, hstepA = (size_t)HALF * BK * 2;
    const unsigned ldsw = (unsigned)wid * 1024u;
    const int aoff = lds_byte(wr * 64 + fr, fq * 8), boff = lds_byte(wc * 32 + fr, fq * 8);
    LAS float* RS = (LAS float*)(lds + STAGE_BYTES);
#define PG8_SA(b, h) (((b) * 2 + (h)) * HTB)
#define PG8_SB(b, h) ((4 + (b) * 2 + (h)) * HTB)
#define PG8_STAGE(bufoff, gbase, voff) do { _Pragma("unroll") for (int _i = 0; _i < 2; ++_i) \
        __builtin_amdgcn_global_load_lds((const unsigned*)((const char*)(gbase) + (voff)[_i]), (LAS unsigned*)(lds + (bufoff) + ldsw + _i * 8192), 16, 0, 0); } while (0)
#define PG8_LDA(dst, b, h) do { _Pragma("unroll") for (int m = 0; m < 4; ++m) _Pragma("unroll") for (int k = 0; k < 2; ++k) dst[m][k] = *(const LAS bf16x8*)(lds + PG8_SA(b, h) + aoff + m * 2048 + k * 1024); } while (0)
#define PG8_LDB(dst, b, h) do { _Pragma("unroll") for (int n = 0; n < 2; ++n) _Pragma("unroll") for (int k = 0; k < 2; ++k) dst[n][k] = *(const LAS bf16x8*)(lds + PG8_SB(b, h) + boff + n * 2048 + k * 1024); } while (0)
#define PG8_MMA(ai, bj, At, Bt) do { __builtin_amdgcn_s_setprio(1); _Pragma("unroll") for (int m = 0; m < 4; ++m) _Pragma("unroll") for (int n = 0; n < 2; ++n) _Pragma("unroll") for (int k = 0; k < 2; ++k) \
        acc[ai][bj][m][n] = __builtin_amdgcn_mfma_f32_16x16x32_bf16(Bt[n][k], At[m][k], acc[ai][bj][m][n], 0, 0, 0); __builtin_amdgcn_s_setprio(0); } while (0)
#define PG8_WAIT_V(n) asm volatile("s_waitcnt vmcnt(" #n ")" ::: "memory")
#define PG8_WAIT_L(n) asm volatile("s_waitcnt lgkmcnt(" #n ")" ::: "memory")
#define PG8_BAR __builtin_amdgcn_s_barrier()
#define PG8_SCHED __builtin_amdgcn_sched_barrier(0)
    Unit cur, nxt; int ui = 0;
    if (!S.next(0, cur)) return;
    f32x4 acc[2][2][4][2];
#pragma unroll
    for (int a = 0; a < 2; ++a)
#pragma unroll
        for (int b = 0; b < 2; ++b)
#pragma unroll
            for (int m = 0; m < 4; ++m)
#pragma unroll
                for (int n = 0; n < 2; ++n) acc[a][b][m][n] = (f32x4){0.f, 0.f, 0.f, 0.f};
    bf16x8 At[4][2], B0[2][2], B1[2][2];
    const char* cA = (const char*)g.A + (size_t)cur.pm * tstep; const char* cB = (const char*)g.Bt + (size_t)cur.pn * tstep;
    PG8_STAGE(PG8_SB(0, 0), cB, voffB); PG8_STAGE(PG8_SA(0, 0), cA, voffA); PG8_STAGE(PG8_SB(0, 1), cB + hstep, voffB); PG8_STAGE(PG8_SA(0, 1), cA + hstepA, voffA);
    if (wr == 1) PG8_BAR;
    PG8_WAIT_V(4); PG8_BAR;
    PG8_STAGE(PG8_SB(1, 0), cB + kstep, voffB); PG8_STAGE(PG8_SA(1, 0), cA + kstepA, voffA); PG8_STAGE(PG8_SB(1, 1), cB + hstep + kstep, voffB);
    PG8_WAIT_V(6); PG8_BAR;
    for (;;) {
        const bool has_next = S.next(ui + 1, nxt);
        const char* nA = has_next ? (const char*)g.A + (size_t)nxt.pm * tstep : cA; const char* nB = has_next ? (const char*)g.Bt + (size_t)nxt.pn * tstep : cB;
        for (int t = 0; t < nt; t += 2) {
            const bool last = (t == nt - 2);
            const char* a1 = cA + (size_t)(t + 1) * kstepA;
            const char* a2 = last ? nA : cA + (size_t)(t + 2) * kstepA; const char* b2 = last ? nB : cB + (size_t)(t + 2) * kstep;
            const char* a3 = a2 + kstepA; const char* b3 = b2 + kstep;
            f32x4 rsA;
            if constexpr (Epi::PRE) { if (t <= 2) { const float* rp = E.rowss + (size_t)(cur.pm * BM + (t >> 1) * HALF + (tid >> 2)) * 16 + (tid & 3) * 4;
                asm volatile("global_load_dwordx4 %0, %1, off" : "=&v"(rsA) : "v"(rp) : "memory"); } }
            PG8_LDB(B0, 0, 0); PG8_SCHED; PG8_LDA(At, 0, 0); PG8_STAGE(PG8_SA(1, 1), a1 + hstepA, voffA);
            PG8_WAIT_L(8); PG8_BAR; PG8_WAIT_L(0); PG8_MMA(0, 0, At, B0); PG8_BAR; PG8_SCHED;
            PG8_LDB(B1, 0, 1); PG8_STAGE(PG8_SB(0, 0), b2, voffB);
            PG8_BAR; PG8_WAIT_L(0); PG8_MMA(0, 1, At, B1); PG8_BAR;
            PG8_LDA(At, 0, 1); PG8_STAGE(PG8_SA(0, 0), a2, voffA);
            PG8_BAR; PG8_WAIT_L(0); PG8_MMA(1, 0, At, B0); PG8_BAR; PG8_SCHED;
            PG8_STAGE(PG8_SB(0, 1), b2 + hstep, voffB);
            PG8_WAIT_V(6); PG8_BAR; PG8_MMA(1, 1, At, B1); PG8_BAR;
            if constexpr (Epi::PRE) { if (t <= 2) { asm volatile("s_waitcnt vmcnt(8)" : "+v"(rsA) :: "memory"); float sq = (rsA[0] + rsA[1]) + (rsA[2] + rsA[3]); sq += __shfl_xor(sq, 1); sq += __shfl_xor(sq, 2);
                if (!(tid & 3)) RS[(t >> 1) * HALF + (tid >> 2)] = rsqrtf(sq * (1.0f / 1024.0f) + EPS); } }
            PG8_LDB(B0, 1, 0); PG8_SCHED; PG8_LDA(At, 1, 0); PG8_STAGE(PG8_SA(0, 1), a2 + hstepA, voffA);
            PG8_WAIT_L(8); PG8_BAR; PG8_WAIT_L(0); PG8_MMA(0, 0, At, B0); PG8_BAR; PG8_SCHED;
            PG8_LDB(B1, 1, 1); PG8_STAGE(PG8_SB(1, 0), b3, voffB);
            PG8_BAR; PG8_WAIT_L(0); PG8_MMA(0, 1, At, B1); PG8_BAR;
            PG8_LDA(At, 1, 1); PG8_STAGE(PG8_SA(1, 0), a3, voffA);
            PG8_BAR; PG8_WAIT_L(0); PG8_MMA(1, 0, At, B0); PG8_BAR; PG8_SCHED;
            PG8_STAGE(PG8_SB(1, 1), b3 + hstep, voffB);
            PG8_WAIT_V(6); PG8_BAR; PG8_MMA(1, 1, At, B1); PG8_BAR;
        }
        E(acc, cur, wr, wc, fr, fq, RS);
        if (!has_next) break;
#pragma unroll
        for (int a = 0; a < 2; ++a)
#pragma unroll
            for (int b = 0; b < 2; ++b)
#pragma unroll
                for (int m = 0; m < 4; ++m)
#pragma unroll
                    for (int n = 0; n < 2; ++n) acc[a][b][m][n] = (f32x4){0.f, 0.f, 0.f, 0.f};
        cur = nxt; cA = nA; cB = nB; ++ui;
    }
    PG8_WAIT_V(0);
    if (wr == 0) PG8_BAR;
    PG8_BAR;
#undef PG8_SA
#undef PG8_SB
#undef PG8_STAGE
#undef PG8_LDA
#undef PG8_LDB
#undef PG8_MMA
#undef PG8_WAIT_V
#undef PG8_WAIT_L
#undef PG8_BAR
#undef PG8_SCHED
}
}

__device__ __forceinline__ void transpose_item(const float* W, int K, int N, bf16_t* WT, const float* kscale, LAS float* scr, int item, int lane) {
    const int nblk = N / 32, kb = item / nblk, nb = item % nblk, k0 = 64 * kb, n0 = 32 * nb;
    float wv[32];
#pragma unroll
    for (int i = 0; i < 32; ++i) wv[i] = W[(size_t)(k0 + 2 * i + (lane >> 5)) * N + n0 + (lane & 31)];
#pragma unroll
    for (int i = 0; i < 32; ++i) { const int kk = 2 * i + (lane >> 5); const float s = kscale ? kscale[k0 + kk] : 1.0f; scr[kk * 33 + (lane & 31)] = wv[i] * s; }
    LDS_WAIT();
    const int c = lane & 7;
#pragma unroll
    for (int j = 0; j < 4; ++j) { const int n = (lane >> 3) + 8 * j; const LAS float* s = scr + (8 * c) * 33 + n;
        u32x4 o; o.x = cvt_pk_bf16(s[0 * 33], s[1 * 33]); o.y = cvt_pk_bf16(s[2 * 33], s[3 * 33]); o.z = cvt_pk_bf16(s[4 * 33], s[5 * 33]); o.w = cvt_pk_bf16(s[6 * 33], s[7 * 33]);
        *(u32x4*)(WT + (size_t)(n0 + n) * K + k0 + 8 * c) = o; }
    LDS_WAIT();
}

__device__ __forceinline__ void phase0(LAS unsigned char* lds, const Params& p) {
    int tid = threadIdx.x; asm volatile("" : "+v"(tid));
    const int lane = tid & 63, wave = tid >> 6;
    const int gw = blockIdx.x * 8 + wave, NGW = gridDim.x * 8;
    LAS float* scr = (LAS float*)(lds + wave * 8704);
    bf16_t* WTb = (bf16_t*)(p.ws + WS_WT);
#pragma unroll 1
    for (int mat = 0; mat < 16; ++mat) {
        const float* W; int K, N; bf16_t* WT; const float* ks = nullptr;
        if (mat < 2)       { W = p.in[3] + (size_t)mat * 1024 * 3072; K = 1024; N = 3072; WT = WTb + OFF_INE + (size_t)mat * 3145728; ks = p.in[1] + (2 * mat) * 1024; }
        else if (mat < 4)  { const int j = mat - 2; W = p.in[13] + (size_t)j * 1048576; K = 1024; N = 1024; WT = WTb + OFF_OUTE + (size_t)j * 1048576; }
        else if (mat < 6)  { const int j = mat - 4; W = p.in[14] + (size_t)j * 1024 * 1536; K = 1024; N = 1536; WT = WTb + OFF_INO + (size_t)j * 1572864; ks = p.in[1] + (2 * j + 1) * 1024; }
        else if (mat < 8)  { const int j = mat - 6; W = p.in[19] + (size_t)j * 1048576; K = 1024; N = 1024; WT = WTb + OFF_OUTO + (size_t)j * 1048576; }
        else if (mat < 12) { const int l = mat - 8; W = p.in[20] + (size_t)l * 4194304; K = 1024; N = 4096; WT = WTb + OFF_FIN + (size_t)l * 4194304; ks = p.in[2] + l * 1024; }
        else               { const int l = mat - 12; W = p.in[21] + (size_t)l * 4194304; K = 4096; N = 1024; WT = WTb + OFF_FOUT + (size_t)l * 4194304; }
        const int nitems = (K / 64) * (N / 32);
        for (int it = gw; it < nitems; it += NGW) transpose_item(W, K, N, WT, ks, scr, it, lane);
    }
    {
        const size_t gtid = (size_t)blockIdx.x * NTHR + tid, gsz = (size_t)gridDim.x * NTHR;
        bf16_t* WaT = (bf16_t*)(p.ws + WS_SMALL + SM_WAT); bf16_t* WxT = (bf16_t*)(p.ws + WS_SMALL + SM_WXT);
        bf16_t* SW = (bf16_t*)(p.ws + WS_SMALL + SM_SGUW); bf16_t* PWT = (bf16_t*)(p.ws + WS_SMALL + SM_PWT);
        for (size_t i = gtid; i < 131072; i += gsz) {
            const int ii = i & 63, jo = (i >> 6) & 63; const size_t lh = i >> 12;
            if (i < 65536) { WaT[i] = f2bf(p.in[6][lh * 4096 + ii * 64 + jo]);
            WxT[i] = f2bf(p.in[8][lh * 4096 + ii * 64 + jo]); }
            const int s = i & 127, t = (i >> 7) & 127;
            SW[i] = f2bf(s <= t ? p.in[15][i] : 0.f);
            const int c = i & 127, d = (i >> 7) & 127; const size_t lg = i >> 14; const size_t l = lg >> 2, gi = lg & 3;
            PWT[i] = f2bf(p.in[17][lg * 16384 + c * 128 + d] * p.in[18][l * 512 + gi * 128 + d]);
        }
    }
    {
        const float* x = p.in[0]; bf16_t* HB = (bf16_t*)(p.ws + WS_HB); float* rowss = (float*)(p.ws + WS_ROWSS);
        for (int row = gw; row < MTOK; row += 2 * NGW) {
            const int row2 = row + NGW;
            const f32x4* xr = (const f32x4*)(x + (size_t)row * DM) + lane;
            const f32x4* xr2 = (const f32x4*)(x + (size_t)row2 * DM) + lane;
            f32x4 v[4], v2[4]; float s = 0.f, s2 = 0.f;
#pragma unroll
            for (int j = 0; j < 4; ++j) { v[j] = xr[64 * j]; v2[j] = xr2[64 * j]; }
#pragma unroll
            for (int j = 0; j < 4; ++j) { s += (v[j][0] * v[j][0] + v[j][1] * v[j][1]) + (v[j][2] * v[j][2] + v[j][3] * v[j][3]); s2 += (v2[j][0] * v2[j][0] + v2[j][1] * v2[j][1]) + (v2[j][2] * v2[j][2] + v2[j][3] * v2[j][3]); }
#pragma unroll
            for (int o = 1; o < 64; o <<= 1) { s += __shfl_xor(s, o); s2 += __shfl_xor(s2, o); }
            u32x2* o8 = (u32x2*)(HB + tiled((size_t)row, 4 * lane, DM)); u32x2* o82 = (u32x2*)(HB + tiled((size_t)row2, 4 * lane, DM));
#pragma unroll
            for (int j = 0; j < 4; ++j) { u32x2 w; w.x = cvt_pk_bf16(v[j][0], v[j][1]); w.y = cvt_pk_bf16(v[j][2], v[j][3]); o8[16384 * j] = w;
                u32x2 w2; w2.x = cvt_pk_bf16(v2[j][0], v2[j][1]); w2.y = cvt_pk_bf16(v2[j][2], v2[j][3]); o82[16384 * j] = w2; }
            if (lane < 16) { rowss[(size_t)row * 16 + lane] = (lane == 0) ? s : 0.f; rowss[(size_t)row2 * 16 + lane] = (lane == 0) ? s2 : 0.f; }
        }
    }
}

template <int PASS>
__device__ __forceinline__ void lru_pass(LAS unsigned char* lds, const Params& p, int j, int item) {
    int tid = threadIdx.x; asm volatile("" : "+v"(tid));
    const int lane = tid & 63, w = __builtin_amdgcn_readfirstlane(tid >> 6), fr = lane & 15, fq = lane >> 4;
    const int b = item >> 4, seg = item & 15;
    const bf16_t* PROJ = (const bf16_t*)(p.ws + WS_BIG);
    bf16_t* Y = (bf16_t*)(p.ws + WS_Y);
    float* Pbuf = (float*)(p.ws + WS_LRUC); float* Hbuf = Pbuf + 256 * 512;
    LAS bf16_t* U = (LAS bf16_t*)lds;
    LAS bf16_t* HS = (LAS bf16_t*)(lds + 66560);
    const bf16_t* WaT = (const bf16_t*)(p.ws + WS_SMALL + SM_WAT) + (size_t)(j * 8 + w) * 4096;
    const bf16_t* WxT = (const bf16_t*)(p.ws + WS_SMALL + SM_WXT) + (size_t)(j * 8 + w) * 4096;
    bf16x8 Ba[4][2], Bx[4][2];
#pragma unroll
    for (int n = 0; n < 4; ++n)
#pragma unroll
        for (int kk = 0; kk < 2; ++kk) { Ba[n][kk] = *(const bf16x8*)(WaT + (n * 16 + fr) * 64 + kk * 32 + fq * 8); Bx[n][kk] = *(const bf16x8*)(WxT + (n * 16 + fr) * 64 + kk * 32 + fq * 8); }
    float ba[4], bx[4], sp[4], h[4], P[4];
#pragma unroll
    for (int n = 0; n < 4; ++n) {
        const int c = w * 64 + n * 16 + fr;
        ba[n] = p.in[7][j * 512 + c]; bx[n] = p.in[9][j * 512 + c];
        const float lam = p.in[10][j * 512 + c];
        sp[n] = 8.0f * 1.44269504f * log1pf(__expf(-lam));
        float hh = 0.f;
        if (PASS == 2) {
            float pq[15], hq[15];
#pragma unroll
            for (int s = 0; s < 15; ++s) { pq[s] = Pbuf[(size_t)(b * 16 + s) * 512 + c]; hq[s] = Hbuf[(size_t)(b * 16 + s) * 512 + c]; }
#pragma unroll
            for (int s = 0; s < 15; ++s) hh = (s < seg) ? pq[s] * hh + hq[s] : hh;
        }
        h[n] = hh; P[n] = 1.0f;
    }
    const int c8 = (tid & 63) * 8, tg = tid >> 6;
    LAS float* CW = (LAS float*)(lds + 133120);
    {
        const float* src = (tid < 128 * 4) ? p.in[4] + (size_t)j * 2048 : p.in[4];
        *(LAS f32x4*)(CW + tid * 4) = *(const f32x4*)(src + tid * 4);
        if (tid < 128) *(LAS f32x4*)(CW + 2048 + tid * 4) = *(const f32x4*)(p.in[5] + j * 512 + tid * 4);
    }
    __syncthreads();
#pragma unroll 1
    for (int sub = 0; sub < 4; ++sub) {
        const int t0 = seg * 256 + sub * 64;
        const size_t rowbase = (size_t)b * SEQ + t0;

        {
            float cw[4][8], cb[8];
#pragma unroll
            for (int k = 0; k < 4; ++k) { const f32x4 a = *(const LAS f32x4*)(CW + k * 512 + c8), bq = *(const LAS f32x4*)(CW + k * 512 + c8 + 4);
#pragma unroll
                for (int q = 0; q < 4; ++q) { cw[k][q] = a[q]; cw[k][4 + q] = bq[q]; } }
            { const f32x4 a = *(const LAS f32x4*)(CW + 2048 + c8), bq = *(const LAS f32x4*)(CW + 2048 + c8 + 4);
#pragma unroll
                for (int q = 0; q < 4; ++q) { cb[q] = a[q]; cb[4 + q] = bq[q]; } }
            u32x4 xw[4];
#pragma unroll
            for (int k = 0; k < 3; ++k) { const int tl = tg * 8 - 3 + k; xw[k] = (t0 + tl >= 0) ? *(const u32x4*)(PROJ + proj_off(rowbase + tl, 3072) + c8) : (u32x4){0u, 0u, 0u, 0u}; }
#pragma unroll
            for (int i = 0; i < 8; ++i) {
                const int tl = tg * 8 + i;
                xw[3] = *(const u32x4*)(PROJ + proj_off(rowbase + tl, 3072) + c8);
                float uo[8];
#pragma unroll
                for (int q = 0; q < 4; ++q) {
                    float lo = cb[2 * q], hi = cb[2 * q + 1];
#pragma unroll
                    for (int k = 0; k < 4; ++k) { lo += cw[k][2 * q] * bf_lo(xw[k][q]); hi += cw[k][2 * q + 1] * bf_hi(xw[k][q]); }
                    uo[2 * q] = lo; uo[2 * q + 1] = hi;
                }
                u32x4 o; o.x = cvt_pk_bf16(uo[0], uo[1]); o.y = cvt_pk_bf16(uo[2], uo[3]); o.z = cvt_pk_bf16(uo[4], uo[5]); o.w = cvt_pk_bf16(uo[6], uo[7]);
                *(LAS u32x4*)(U + tl * 520 + c8) = o;
                xw[0] = xw[1]; xw[1] = xw[2]; xw[2] = xw[3];
            }
        }
        __syncthreads();
#pragma unroll 1
        for (int tt = 0; tt < 4; ++tt) {
            bf16x8 a0 = *(const LAS bf16x8*)(U + (tt * 16 + fr) * 520 + w * 64 + fq * 8);
            bf16x8 a1 = *(const LAS bf16x8*)(U + (tt * 16 + fr) * 520 + w * 64 + 32 + fq * 8);
#pragma unroll
            for (int n = 0; n < 4; ++n) {
                f32x4 ar = (f32x4){ba[n], ba[n], ba[n], ba[n]}, ai = (f32x4){bx[n], bx[n], bx[n], bx[n]};
                ar = __builtin_amdgcn_mfma_f32_16x16x32_bf16(a0, Ba[n][0], ar, 0, 0, 0); ar = __builtin_amdgcn_mfma_f32_16x16x32_bf16(a1, Ba[n][1], ar, 0, 0, 0);
                ai = __builtin_amdgcn_mfma_f32_16x16x32_bf16(a0, Bx[n][0], ai, 0, 0, 0); ai = __builtin_amdgcn_mfma_f32_16x16x32_bf16(a1, Bx[n][1], ai, 0, 0, 0);
                const int c = w * 64 + n * 16 + fr;
                float av[4], bv[4];
#pragma unroll
                for (int jj = 0; jj < 4; ++jj) {
                    const int t = tt * 16 + fq * 4 + jj;
                    const float u = bf2f(U[t * 520 + c]);
                    const float r = sigmoid_(ar[jj]), ig = sigmoid_(ai[jj]);
                    const float a = __builtin_amdgcn_exp2f(-r * sp[n]);
                    const float beta = __builtin_amdgcn_sqrtf(fmaxf(1.0f - a * a, 0.f));
                    av[jj] = a; bv[jj] = beta * ig * u;
                }
                const float A4 = (av[0] * av[1]) * (av[2] * av[3]);
                const float B4 = ((bv[0] * av[1] + bv[1]) * av[2] + bv[2]) * av[3] + bv[3];
                float hs = h[n];
#pragma unroll
                for (int g = 0; g < 4; ++g) {
                    const float he = A4 * hs + B4;
                    const float nx = __shfl(he, fr + 16 * g);
                    if (fq > g) hs = nx;
                    if (g == 3) h[n] = nx;
                }
                if (PASS == 1) { float pp = A4; pp *= __shfl_xor(pp, 16); pp *= __shfl_xor(pp, 32); P[n] *= pp; }
                if (PASS == 2) {
                    float xh = hs;
#pragma unroll
                    for (int jj = 0; jj < 4; ++jj) { xh = av[jj] * xh + bv[jj]; HS[(tt * 16 + fq * 4 + jj) * 520 + c] = f2bf(xh); }
                }
            }
        }
        if (PASS == 2) {
            __syncthreads();
            u32x4 gpre[8];
#pragma unroll
            for (int i = 0; i < 8; ++i) gpre[i] = *(const u32x4*)(PROJ + proj_off(rowbase + tg * 8 + i, 3072) + 512 + c8);
#pragma unroll
            for (int i = 0; i < 8; ++i) {
                const int tl = tg * 8 + i;
                const u32x4 hv = *(const LAS u32x4*)(HS + tl * 520 + c8);
                const u32x4 gv = gpre[i];
                u32x4 o;
#pragma unroll
                for (int q = 0; q < 4; ++q) o[q] = cvt_pk_bf16(bf_lo(hv[q]) * gelu_tanh(bf_lo(gv[q])), bf_hi(hv[q]) * gelu_tanh(bf_hi(gv[q])));
                *(u32x4*)(Y + tiled(rowbase + tl, c8, 1024)) = o;
            }
        }
        __syncthreads();
    }
    if (PASS == 1) {
        if (fq == 0) {
#pragma unroll
            for (int n = 0; n < 4; ++n) { const int c = w * 64 + n * 16 + fr; Pbuf[(size_t)item * 512 + c] = P[n]; Hbuf[(size_t)item * 512 + c] = h[n]; }
        }
    }
}


__device__ __forceinline__ void hgrn_bcum2(LAS float* BC, LAS float* PT, const u32x4 (&zv)[2], const float (&lb)[8], int tid, float (&kout)[2][8]) {
    {
        const int d8 = (tid & 15) * 8, t = tid >> 4;
#pragma unroll
        for (int rr = 0; rr < 2; ++rr) {
            const int tr = t + rr * 32;
            float lf[8];
#pragma unroll
            for (int q = 0; q < 4; ++q) {
                const float z0 = bf_lo(zv[rr][q]), z1 = bf_hi(zv[rr][q]);
                const float k0 = (1.0f - lb[2 * q]) * sigmoid_(-z0), k1 = (1.0f - lb[2 * q + 1]) * sigmoid_(-z1);
                kout[rr][2 * q] = k0; kout[rr][2 * q + 1] = k1;
                lf[2 * q] = __logf(fmaxf(1.0f - k0, 1e-20f));
                lf[2 * q + 1] = __logf(fmaxf(1.0f - k1, 1e-20f));
            }
            *(LAS f32x4*)(BC + tr * 128 + d8) = (f32x4){lf[0], lf[1], lf[2], lf[3]};
            *(LAS f32x4*)(BC + tr * 128 + d8 + 4) = (f32x4){lf[4], lf[5], lf[6], lf[7]};
        }
    }
    __syncthreads();
    const int d = tid & 127, part = tid >> 7;
    {
        float a = 0.f;
#pragma unroll
        for (int i = 0; i < 16; ++i) { const int t = part * 16 + i; a += BC[t * 128 + d]; BC[t * 128 + d] = a; }
        PT[part * 128 + d] = a;
    }
    __syncthreads();
}
struct HcPre { u32x4 zv[2], vv[2], qv[2], gp[2]; };
template <int PASS>
__device__ __forceinline__ void hgrn2_load(const Params& p, int item, int c, HcPre& r) {
    int tid = threadIdx.x; asm volatile("" : "+v"(tid));
    const int bh = item >> 3, sup = item & 7, b = bh >> 2, h = bh & 3;
    const bf16_t* PROJ = (const bf16_t*)(p.ws + WS_BIG);
    const size_t rowbase = (size_t)b * SEQ + (size_t)(sup * 8 + c) * 64;
    const int d8 = (tid & 15) * 8, t = tid >> 4;
#pragma unroll
    for (int rr = 0; rr < 2; ++rr) {
        r.zv[rr] = *(const u32x4*)(PROJ + proj_off(rowbase + t + rr * 32, 3072) + 1536 + h * 128 + d8);
        r.vv[rr] = *(const u32x4*)(PROJ + proj_off(rowbase + t + rr * 32, 3072) + 2048 + h * 128 + d8);
        if (PASS == 2) r.qv[rr] = *(const u32x4*)(PROJ + proj_off(rowbase + t + rr * 32, 3072) + 1024 + h * 128 + d8);
    }
    if (PASS == 2) {
        const bf16_t* gp = PROJ + proj_off(rowbase + (tid >> 3), 3072) + 2560 + h * 128 + (tid & 7) * 16;
        r.gp[0] = *(const u32x4*)gp; r.gp[1] = *(const u32x4*)(gp + 8);
    }
}
template <int PASS>
__device__ __forceinline__ void hgrn2_init(const Params& p, int item, f32x4 (&S)[8], float (&Gt)[4]) {
    int tid = threadIdx.x; asm volatile("" : "+v"(tid));
    const int lane = tid & 63, w = __builtin_amdgcn_readfirstlane(tid >> 6), fq = lane >> 4;
#pragma unroll
    for (int n = 0; n < 8; ++n) S[n] = (f32x4){0.f, 0.f, 0.f, 0.f};
#pragma unroll
    for (int jj = 0; jj < 4; ++jj) Gt[jj] = 1.0f;
    if (PASS == 2) {
        const int bh = item >> 3, sup = item & 7;
        const float* SUMb = (const float*)(p.ws + WS_ST); const float* GTb = (const float*)(p.ws + WS_HGG);
        for (int s2 = 0; s2 < sup; ++s2) {
            const size_t it2 = (size_t)bh * 8 + s2;
            const f32x4 g4 = *(const f32x4*)(GTb + it2 * 128 + w * 16 + fq * 4);
#pragma unroll
            for (int n = 0; n < 8; ++n) { const f32x4 T = *(const f32x4*)(SUMb + it2 * 16384 + (size_t)((n * 8 + w) * 64 + lane) * 4); S[n] = g4 * S[n] + T; }
        }
    }
}
__device__ __forceinline__ void hgrn2_finish(const Params& p, int item, const f32x4 (&S)[8], const float (&Gt)[4]) {
    int tid = threadIdx.x; asm volatile("" : "+v"(tid));
    const int lane = tid & 63, w = __builtin_amdgcn_readfirstlane(tid >> 6), fr = lane & 15, fq = lane >> 4;
    float* SUMb = (float*)(p.ws + WS_ST); float* GTb = (float*)(p.ws + WS_HGG);
#pragma unroll
    for (int n = 0; n < 8; ++n) *(f32x4*)(SUMb + (size_t)item * 16384 + (size_t)((n * 8 + w) * 64 + lane) * 4) = S[n];
    if (fr == 0) *(f32x4*)(GTb + (size_t)item * 128 + w * 16 + fq * 4) = (f32x4){Gt[0], Gt[1], Gt[2], Gt[3]};
}
template <int PASS>
__device__ __forceinline__ void hgrn2_chunk(LAS unsigned char* lds, const Params& p, int j, int item, int c, const HcPre& pre, f32x4 (&S)[8], float (&Gt)[4], const float (&lb)[8]) {
    int tid = threadIdx.x; asm volatile("" : "+v"(tid));
    const int lane = tid & 63, w = __builtin_amdgcn_readfirstlane(tid >> 6), fr = lane & 15, fq = lane >> 4;
    const int bh = item >> 3, sup = item & 7, b = bh >> 2, h = bh & 3;
    bf16_t* Y = (bf16_t*)(p.ws + WS_Y);
    const size_t rowbase = (size_t)b * SEQ + (size_t)(sup * 8 + c) * 64;
    LAS float* BC = (LAS float*)lds;
    LAS bf16_t* QA = (LAS bf16_t*)(lds + 32768);
    LAS bf16_t* KA = (LAS bf16_t*)(lds + 50176);
    LAS bf16_t* VT = (LAS bf16_t*)(lds + 67584);
    LAS bf16_t* SS = (LAS bf16_t*)(lds + 86016);
    LAS bf16_t* AT = (LAS bf16_t*)(lds + 120832);
    LAS float* PT = (LAS float*)(lds + 130048);
    LAS bf16_t* VN = SS;
    const float* lbl = p.in[11];
    const int d8 = (tid & 15) * 8, t = tid >> 4;
    u32x4 zv[2], vv[2], qv[2], gpre[2];
#pragma unroll
    for (int rr = 0; rr < 2; ++rr) { zv[rr] = pre.zv[rr]; vv[rr] = pre.vv[rr]; if (PASS == 2) { qv[rr] = pre.qv[rr]; gpre[rr] = pre.gp[rr]; } }
    f32x4 gnv[4];
    if (PASS == 2) {
        const float* gn0 = p.in[12] + j * 512 + h * 128 + (tid & 7) * 16;
#pragma unroll
        for (int q = 0; q < 4; ++q) gnv[q] = *(const f32x4*)(gn0 + q * 4);
    }
#pragma unroll
    for (int rr = 0; rr < 2; ++rr) *(LAS u32x4*)(VN + (t + rr * 32) * 136 + d8) = vv[rr];
    float kq[2][8];
    hgrn_bcum2(BC, PT, zv, lb, tid, kq);
    {
        float bref[8], c1[8], c2[8], c3[8];
        {
            const f32x4 pa0 = *(const LAS f32x4*)(PT + d8), pa1 = *(const LAS f32x4*)(PT + d8 + 4);
            const f32x4 pb0 = *(const LAS f32x4*)(PT + 128 + d8), pb1 = *(const LAS f32x4*)(PT + 128 + d8 + 4);
            const f32x4 pc0 = *(const LAS f32x4*)(PT + 256 + d8), pc1 = *(const LAS f32x4*)(PT + 256 + d8 + 4);
#pragma unroll
            for (int q = 0; q < 4; ++q) { c1[q] = pa0[q]; c1[4 + q] = pa1[q]; c2[q] = pa0[q] + pb0[q]; c2[4 + q] = pa1[q] + pb1[q]; c3[q] = c2[q] + pc0[q]; c3[4 + q] = c2[4 + q] + pc1[q]; }
        }
        const bool hi16 = (t >> 4) != 0;
#pragma unroll
        for (int q = 0; q < 8; ++q) bref[q] = BC[31 * 128 + d8 + q] + c1[q];
#pragma unroll
        for (int rr = 0; rr < 2; ++rr) {
            const int tr = t + rr * 32;
            float qa[8], ka[8];
#pragma unroll
            for (int q = 0; q < 8; ++q) {
                const float bc = BC[tr * 128 + d8 + q] + (rr == 0 ? (hi16 ? c1[q] : 0.f) : (hi16 ? c3[q] : c2[q]));
                const float dq = fminf(fmaxf(bc - bref[q], -80.f), 80.f);
                const float e1 = __expf(dq);
                if (PASS == 2) { const float qq = silu_((q & 1) ? bf_hi(qv[rr][q >> 1]) : bf_lo(qv[rr][q >> 1])); qa[q] = qq * e1; }
                ka[q] = kq[rr][q] * rcp_(e1);
            }
            u32x4 o;
            if (PASS == 2) {
#pragma unroll
                for (int q = 0; q < 4; ++q) o[q] = cvt_pk_bf16(qa[2 * q], qa[2 * q + 1]);
                *(LAS u32x4*)(QA + tr * 136 + d8) = o;
            }
#pragma unroll
            for (int q = 0; q < 4; ++q) o[q] = cvt_pk_bf16(ka[2 * q], ka[2 * q + 1]);
            *(LAS u32x4*)(KA + tr * 136 + d8) = o;
        }
        {
            const int e = tid & 127, tq = tid >> 7;
            bf16_t vq[16];
#pragma unroll
            for (int i = 0; i < 16; ++i) vq[i] = VN[(tq * 16 + i) * 136 + e];
            u32x4 p0, p1;
#pragma unroll
            for (int q = 0; q < 4; ++q) { p0[q] = (unsigned)vq[2 * q] | ((unsigned)vq[2 * q + 1] << 16); p1[q] = (unsigned)vq[8 + 2 * q] | ((unsigned)vq[8 + 2 * q + 1] << 16); }
            *(LAS u32x4*)(VT + e * 72 + tq * 16) = p0; *(LAS u32x4*)(VT + e * 72 + tq * 16 + 8) = p1;
        }
    }
    float gsc[4], sc[4], eb[4];
#pragma unroll
    for (int jj = 0; jj < 4; ++jj) { const int dd = w * 16 + fq * 4 + jj; const float p0 = PT[dd], br = BC[31 * 128 + dd] + p0, bl = BC[63 * 128 + dd] + ((p0 + PT[128 + dd]) + PT[256 + dd]); gsc[jj] = __expf(bl); sc[jj] = __expf(bl - br); eb[jj] = __expf(br); }
    __syncthreads();
    if (PASS == 2) {
#pragma unroll
        for (int n = 0; n < 8; ++n) { u32x2 o; o.x = cvt_pk_bf16(S[n][0] * eb[0], S[n][1] * eb[1]); o.y = cvt_pk_bf16(S[n][2] * eb[2], S[n][3] * eb[3]);
            *(LAS u32x2*)(SS + (n * 16 + fr) * 136 + w * 16 + fq * 4) = o; }
        {
            const int tt = w >> 1;
#pragma unroll
            for (int si = 0; si < 2; ++si) {
                const int ss = (w & 1) * 2 + si;
                f32x4 acc = (f32x4){0.f, 0.f, 0.f, 0.f};
                if (ss <= tt) {
#pragma unroll
                    for (int kk = 0; kk < 4; ++kk) {
                        const bf16x8 a = *(const LAS bf16x8*)(QA + (tt * 16 + fr) * 136 + kk * 32 + fq * 8);
                        const bf16x8 bb = *(const LAS bf16x8*)(KA + (ss * 16 + fr) * 136 + kk * 32 + fq * 8);
                        acc = __builtin_amdgcn_mfma_f32_16x16x32_bf16(a, bb, acc, 0, 0, 0);
                    }
                }
#pragma unroll
                for (int jj = 0; jj < 4; ++jj) {
                    const int tq2 = tt * 16 + fq * 4 + jj, sq2 = ss * 16 + fr;
                    const float v = (sq2 <= tq2) ? acc[jj] : 0.f;
                    AT[tq2 * 72 + sq2] = f2bf(v);
                }
            }
        }
        __syncthreads();
        {
            const int tt = w >> 1, n0 = (w & 1) * 4;
            f32x4 acc[4];
#pragma unroll
            for (int n = 0; n < 4; ++n) acc[n] = (f32x4){0.f, 0.f, 0.f, 0.f};
#pragma unroll
            for (int kk = 0; kk < 4; ++kk) {
                const bf16x8 a = *(const LAS bf16x8*)(QA + (tt * 16 + fr) * 136 + kk * 32 + fq * 8);
#pragma unroll
                for (int n = 0; n < 4; ++n) { const bf16x8 bb = *(const LAS bf16x8*)(SS + ((n0 + n) * 16 + fr) * 136 + kk * 32 + fq * 8); acc[n] = __builtin_amdgcn_mfma_f32_16x16x32_bf16(a, bb, acc[n], 0, 0, 0); }
            }
#pragma unroll
            for (int kk = 0; kk < 2; ++kk) {
                if (kk * 32 <= tt * 16 + 15) {
                    const bf16x8 a = *(const LAS bf16x8*)(AT + (tt * 16 + fr) * 72 + kk * 32 + fq * 8);
#pragma unroll
                    for (int n = 0; n < 4; ++n) { const bf16x8 bb = *(const LAS bf16x8*)(VT + ((n0 + n) * 16 + fr) * 72 + kk * 32 + fq * 8); acc[n] = __builtin_amdgcn_mfma_f32_16x16x32_bf16(a, bb, acc[n], 0, 0, 0); }
                }
            }
            LAS float* OS = BC;
#pragma unroll
            for (int n = 0; n < 4; ++n)
#pragma unroll
                for (int jj = 0; jj < 4; ++jj) OS[(tt * 16 + fq * 4 + jj) * 128 + (n0 + n) * 16 + fr] = acc[n][jj];
        }
    }
    {
        bf16x8 af[2];
#pragma unroll
        for (int kk = 0; kk < 2; ++kk)
#pragma unroll
            for (int i = 0; i < 8; ++i) af[kk][i] = (short)KA[(kk * 32 + fq * 8 + i) * 136 + w * 16 + fr];
#pragma unroll
        for (int n = 0; n < 8; ++n) {
            f32x4 acc = (f32x4){0.f, 0.f, 0.f, 0.f};
#pragma unroll
            for (int kk = 0; kk < 2; ++kk) { const bf16x8 bb = *(const LAS bf16x8*)(VT + (n * 16 + fr) * 72 + kk * 32 + fq * 8); acc = __builtin_amdgcn_mfma_f32_16x16x32_bf16(af[kk], bb, acc, 0, 0, 0); }
#pragma unroll
            for (int jj = 0; jj < 4; ++jj) S[n][jj] = gsc[jj] * S[n][jj] + sc[jj] * acc[jj];
        }
        if (PASS == 1) {
#pragma unroll
            for (int jj = 0; jj < 4; ++jj) Gt[jj] *= gsc[jj];
        }
    }
    if (PASS == 2) {
        __syncthreads();
        LAS float* OS = BC;
        const int t2 = tid >> 3, e16 = (tid & 7) * 16;
        f32x4 ov[4]; float ss = 0.f;
#pragma unroll
        for (int q = 0; q < 4; ++q) { ov[q] = *(const LAS f32x4*)(OS + t2 * 128 + e16 + q * 4); ss += (ov[q][0] * ov[q][0] + ov[q][1] * ov[q][1]) + (ov[q][2] * ov[q][2] + ov[q][3] * ov[q][3]); }
        ss += __shfl_xor(ss, 1); ss += __shfl_xor(ss, 2); ss += __shfl_xor(ss, 4);
        const float rstd = rsqrtf(ss * (1.0f / 128.0f) + EPS);
        bf16_t* yp = Y + tiled(rowbase + t2, 512 + h * 128 + e16, 1024);
#pragma unroll
        for (int hlf = 0; hlf < 2; ++hlf) {
            const u32x4 gv = gpre[hlf];
            const f32x4 n0v = gnv[hlf * 2], n1v = gnv[hlf * 2 + 1];
            u32x4 o;
#pragma unroll
            for (int q = 0; q < 4; ++q) {
                const float o0 = ov[hlf * 2 + (q >> 1)][(q & 1) * 2], o1 = ov[hlf * 2 + (q >> 1)][(q & 1) * 2 + 1];
                const float g0 = (q < 2) ? n0v[2 * q] : n1v[2 * q - 4], g1 = (q < 2) ? n0v[2 * q + 1] : n1v[2 * q - 3];
                o[q] = cvt_pk_bf16(o0 * rstd * g0 * silu_(bf_lo(gv[q])), o1 * rstd * g1 * silu_(bf_hi(gv[q])));
            }
            *(u32x4*)(yp + hlf * 8) = o;
        }
        __syncthreads();
    }
}
template <int PASS>
__device__ __forceinline__ void hgrn2_run(LAS unsigned char* lds, const Params& p, int j, int bid, int G, int nitems) {
    f32x4 S[8]; float Gt[4]; float lbv[8]; HcPre nxt;
    const int nsteps = nitems * 8;
    if (nsteps <= 0) return;
    hgrn2_load<PASS>(p, bid, 0, nxt);
#pragma unroll 1
    for (int step = 0; step < nsteps; ++step) {
        const bool mir = (G == 32) && (nitems == 2);
        const int k0 = step >> 3, k1 = (step + 1) >> 3;
        const int item = (mir && k0 == 1) ? ((bid & ~31) + 32 + ((bid & 31) ^ 7)) : bid + k0 * G, c = step & 7;
        const HcPre cur = nxt;
        if (step + 1 < nsteps) hgrn2_load<PASS>(p, (mir && k1 == 1) ? ((bid & ~31) + 32 + ((bid & 31) ^ 7)) : bid + k1 * G, (step + 1) & 7, nxt);
        if (c == 0) {
            hgrn2_init<PASS>(p, item, S, Gt);
            int tl = threadIdx.x; asm volatile("" : "+v"(tl));
            const int hh = (item >> 3) & 3, d8l = (tl & 15) * 8; const float* lbl = p.in[11];
#pragma unroll
            for (int q = 0; q < 8; ++q) { const int ch = hh * 128 + d8l + q; lbv[q] = (j == 0) ? 0.f : sigmoid_(lbl[512 + ch] - lbl[ch]); }
        }
        hgrn2_chunk<PASS>(lds, p, j, item, c, cur, S, Gt, lbv);
        if (PASS == 1 && c == 7) hgrn2_finish(p, item, S, Gt);
    }
    __syncthreads();
}

struct SguPre { u32x4 vv[4]; u32x2 uv[8]; float bias; };
__device__ __forceinline__ void sgu_load(const Params& p, int j, int item, SguPre& r) {
    int tid = threadIdx.x; asm volatile("" : "+v"(tid));
    const int lane = tid & 63, w = __builtin_amdgcn_readfirstlane(tid >> 6), fr = lane & 15, fq = lane >> 4;
    const int g = item & 3, n = (item >> 2) & 31, b = item >> 7;
    const bf16_t* PROJ = (const bf16_t*)(p.ws + WS_BIG);
    const size_t rowbase = (size_t)b * SEQ + n * 128;
    const bf16_t* vp = PROJ + proj_off(rowbase + (tid >> 2), 1536) + 512 + g * 128 + (tid & 3) * 32;
#pragma unroll
    for (int i = 0; i < 4; ++i) r.vv[i] = *(const u32x4*)(vp + i * 8);
    const bf16_t* up = PROJ + proj_off(rowbase + w * 16 + fr, 1536) + g * 128 + fq * 4;
#pragma unroll
    for (int q = 0; q < 8; ++q) r.uv[q] = *(const u32x2*)(up + q * 16);
    r.bias = p.in[16][(size_t)(j * 4 + g) * 128 + w * 16 + fr];
}
__device__ __forceinline__ void sgu_weights(LAS unsigned char* lds, const Params& p, int j, int g) {
    int tid = threadIdx.x; asm volatile("" : "+v"(tid));
    LAS bf16_t* WL = (LAS bf16_t*)(lds + 69632);
    const bf16_t* Wm = (const bf16_t*)(p.ws + WS_SMALL + SM_SGUW) + (size_t)(j * 4 + g) * 16384;
#pragma unroll
    for (int i = 0; i < 4; ++i) { const int idx = tid + i * 512; *(LAS u32x4*)(WL + (idx >> 4) * 136 + (idx & 15) * 8) = *(const u32x4*)(Wm + (idx >> 4) * 128 + (idx & 15) * 8); }
}
__device__ __forceinline__ void sgu_item(LAS unsigned char* lds, const Params& p, int j, int item, const SguPre& pre) {
    int tid = threadIdx.x; asm volatile("" : "+v"(tid));
    const int lane = tid & 63, w = __builtin_amdgcn_readfirstlane(tid >> 6), fr = lane & 15, fq = lane >> 4;
    const int g = item & 3, n = (item >> 2) & 31, b = item >> 7;
    bf16_t* Y = (bf16_t*)(p.ws + WS_Y);
    const size_t rowbase = (size_t)b * SEQ + n * 128;
    LAS bf16_t* VT = (LAS bf16_t*)lds;
    LAS bf16_t* WL = (LAS bf16_t*)(lds + 69632);
    const int tC = w * 16 + fr;
    u32x2 uv[8];
#pragma unroll
    for (int q = 0; q < 8; ++q) uv[q] = pre.uv[q];
    {
        const int s = tid >> 2, qtr = tid & 3;
        float v[32]; float sum = 0.f;
#pragma unroll
        for (int i = 0; i < 4; ++i) { const u32x4 vv = pre.vv[i];
#pragma unroll
            for (int q = 0; q < 4; ++q) { v[i * 8 + 2 * q] = bf_lo(vv[q]); v[i * 8 + 2 * q + 1] = bf_hi(vv[q]); sum += v[i * 8 + 2 * q] + v[i * 8 + 2 * q + 1]; } }
        sum += __shfl_xor(sum, 1); sum += __shfl_xor(sum, 2);
        const float mu = sum * (1.0f / 128.0f); float var = 0.f;
#pragma unroll
        for (int i = 0; i < 32; ++i) { v[i] -= mu; var += v[i] * v[i]; }
        var += __shfl_xor(var, 1); var += __shfl_xor(var, 2);
        const float rstd = rsqrtf(var * (1.0f / 128.0f) + EPS);
        LAS bf16_t* VN = (LAS bf16_t*)(lds + 34816);
#pragma unroll
        for (int i = 0; i < 4; ++i) { u32x4 o;
#pragma unroll
            for (int q = 0; q < 4; ++q) o[q] = cvt_pk_bf16(v[i * 8 + 2 * q] * rstd, v[i * 8 + 2 * q + 1] * rstd);
            *(LAS u32x4*)(VN + s * 136 + qtr * 32 + i * 8) = o; }
    }
    __syncthreads();
    {
        LAS const bf16_t* VN = (LAS const bf16_t*)(lds + 34816);
        const int c = tid & 127, sq = tid >> 7;
        bf16_t vq[32];
#pragma unroll
        for (int i = 0; i < 32; ++i) vq[i] = VN[(sq * 32 + i) * 136 + c];
#pragma unroll
        for (int i = 0; i < 4; ++i) { u32x4 o;
#pragma unroll
            for (int q = 0; q < 4; ++q) o[q] = (unsigned)vq[i * 8 + 2 * q] | ((unsigned)vq[i * 8 + 2 * q + 1] << 16);
            *(LAS u32x4*)(VT + c * 136 + sq * 32 + i * 8) = o; }
    }
    __syncthreads();
    {
        f32x4 acc[8];
#pragma unroll
        for (int q = 0; q < 8; ++q) acc[q] = (f32x4){0.f, 0.f, 0.f, 0.f};
        const int kmax = w >> 1;
#pragma unroll
        for (int kk = 0; kk < 4; ++kk) {
            if (kk <= kmax) {
                const bf16x8 wf = *(const LAS bf16x8*)(WL + (w * 16 + fr) * 136 + kk * 32 + fq * 8);
#pragma unroll
                for (int q = 0; q < 8; ++q) { const bf16x8 vf = *(const LAS bf16x8*)(VT + (q * 16 + fr) * 136 + kk * 32 + fq * 8); acc[q] = __builtin_amdgcn_mfma_f32_16x16x32_bf16(vf, wf, acc[q], 0, 0, 0); }
            }
        }
        const float bias = pre.bias;
        bf16_t* yp = Y + tiled(rowbase + tC, g * 128 + fq * 4, 1024);
#pragma unroll
        for (int q = 0; q < 8; ++q) {
            u32x2 o; o.x = cvt_pk_bf16(bf_lo(uv[q].x) * (acc[q][0] + bias), bf_hi(uv[q].x) * (acc[q][1] + bias)); o.y = cvt_pk_bf16(bf_lo(uv[q].y) * (acc[q][2] + bias), bf_hi(uv[q].y) * (acc[q][3] + bias));
            *(u32x2*)(yp + (q >> 2) * 16384 + (q & 3) * 16) = o;
        }
    }
    __syncthreads();
}

struct PoolPre { u32x4 pl[5]; u32x4 wt[4]; };
__device__ __forceinline__ void pool_load(const Params& p, int j, int item, PoolPre& r) {
    int tid = threadIdx.x; asm volatile("" : "+v"(tid));
    const int gi = item & 3, tile = (item >> 2) & 31, b = item >> 7;
    const bf16_t* PROJ = (const bf16_t*)(p.ws + WS_BIG);
    const int t0 = tile * 128;
    const bf16_t* PWT = (const bf16_t*)(p.ws + WS_SMALL + SM_PWT) + (size_t)(j * 4 + gi) * 16384;
#pragma unroll
    for (int i = 0; i < 4; ++i) { const int idx = tid + i * 512; r.wt[i] = *(const u32x4*)(PWT + (idx >> 4) * 128 + (idx & 15) * 8); }
#pragma unroll
    for (int i = 0; i < 5; ++i) {
        const int idx = tid + i * 512; const int rr = idx >> 4, c8 = (idx & 15) * 8; const int ts = t0 - 16 + rr;
        u32x4 vv = (u32x4){0u, 0u, 0u, 0u};
        if (idx < 144 * 16 && ts >= 0) vv = *(const u32x4*)(PROJ + proj_off((size_t)b * SEQ + ts, 1536) + 1024 + gi * 128 + c8);
        r.pl[i] = vv;
    }
}
__device__ __forceinline__ void pool_item(LAS unsigned char* lds, const Params& p, int j, int item, const PoolPre& pre) {
    int tid = threadIdx.x; asm volatile("" : "+v"(tid));
    const int lane = tid & 63, w = __builtin_amdgcn_readfirstlane(tid >> 6), fr = lane & 15, fq = lane >> 4;
    const int gi = item & 3, tile = (item >> 2) & 31, b = item >> 7;
    bf16_t* Y = (bf16_t*)(p.ws + WS_Y);
    const int t0 = tile * 128;
    const size_t rowbase = (size_t)b * SEQ + t0;
    LAS float* PL = (LAS float*)lds;
    LAS bf16_t* PA = (LAS bf16_t*)(lds + 73728);
    LAS bf16_t* PWL = (LAS bf16_t*)(lds + 108544);
    {
#pragma unroll
        for (int i = 0; i < 5; ++i) {
            const int idx = tid + i * 512;
            if (idx < 144 * 16) {
                const int rr = idx >> 4, c8 = (idx & 15) * 8; const u32x4 vv = pre.pl[i];
                *(LAS f32x4*)(PL + rr * 128 + c8) = (f32x4){bf_lo(vv[0]), bf_hi(vv[0]), bf_lo(vv[1]), bf_hi(vv[1])};
                *(LAS f32x4*)(PL + rr * 128 + c8 + 4) = (f32x4){bf_lo(vv[2]), bf_hi(vv[2]), bf_lo(vv[3]), bf_hi(vv[3])};
            }
        }
#pragma unroll
        for (int i = 0; i < 4; ++i) { const int idx = tid + i * 512; *(LAS u32x4*)(PWL + (idx >> 4) * 136 + (idx & 15) * 8) = pre.wt[i]; }
    }
    __syncthreads();
    {
        const int tg = tid >> 4, c8 = (tid & 15) * 8; const int win = 2 << gi;
        const int tf = tg * 4;
        f32x4 s0 = (f32x4){0.f, 0.f, 0.f, 0.f}, s1 = (f32x4){0.f, 0.f, 0.f, 0.f};
        for (int k = 0; k < win; ++k) { const LAS float* rp = PL + (tf + 16 - k) * 128 + c8; s0 += *(const LAS f32x4*)rp; s1 += *(const LAS f32x4*)(rp + 4); }
#pragma unroll
        for (int i = 0; i < 4; ++i) {
            const int t = tf + i;
            const LAS float* cp = PL + (t + 16) * 128 + c8;
            const f32x4 c0 = *(const LAS f32x4*)cp, c1 = *(const LAS f32x4*)(cp + 4);
            if (i > 0) { const LAS float* op = PL + (t + 16 - win) * 128 + c8; s0 += c0 - *(const LAS f32x4*)op; s1 += c1 - *(const LAS f32x4*)(op + 4); }
            const int tabs = t0 + t; const int cnt = (tabs + 1 < win) ? tabs + 1 : win;
            const float inv = rcp_((float)cnt);
            const f32x4 a = s0 * inv - c0, bq = s1 * inv - c1;
            u32x4 o; o.x = cvt_pk_bf16(a[0], a[1]); o.y = cvt_pk_bf16(a[2], a[3]); o.z = cvt_pk_bf16(bq[0], bq[1]); o.w = cvt_pk_bf16(bq[2], bq[3]);
            *(LAS u32x4*)(PA + t * 136 + c8) = o;
        }
    }
    __syncthreads();
    {
        f32x4 acc[8];
#pragma unroll
        for (int q = 0; q < 8; ++q) acc[q] = (f32x4){0.f, 0.f, 0.f, 0.f};
#pragma unroll
        for (int kk = 0; kk < 4; ++kk) {
            const bf16x8 pf = *(const LAS bf16x8*)(PA + (w * 16 + fr) * 136 + kk * 32 + fq * 8);
#pragma unroll
            for (int q = 0; q < 8; ++q) { const bf16x8 wf = *(const LAS bf16x8*)(PWL + (q * 16 + fr) * 136 + kk * 32 + fq * 8); acc[q] = __builtin_amdgcn_mfma_f32_16x16x32_bf16(wf, pf, acc[q], 0, 0, 0); }
        }
        const int t = w * 16 + fr;
        bf16_t* yp = Y + tiled(rowbase + t, 512 + gi * 128 + fq * 4, 1024);
#pragma unroll
        for (int q = 0; q < 8; ++q) { u32x2 o; o.x = cvt_pk_bf16(acc[q][0], acc[q][1]); o.y = cvt_pk_bf16(acc[q][2], acc[q][3]); *(u32x2*)(yp + (q >> 2) * 16384 + (q & 3) * 16) = o; }
    }
    __syncthreads();
}

__device__ __forceinline__ void zero_y(const Params& p) {
    int tid = threadIdx.x; asm volatile("" : "+v"(tid));
    u32x4* yz = (u32x4*)(p.ws + WS_Y);
    for (size_t i = (size_t)blockIdx.x * NTHR + tid; i < (size_t)MTOK * 128; i += (size_t)gridDim.x * NTHR) yz[i] = (u32x4){0u, 0u, 0u, 0u};
}
__device__ __forceinline__ void final_norm(const Params& p) {
    int tid = threadIdx.x; asm volatile("" : "+v"(tid));
    const int lane = tid & 63, wave = tid >> 6;
    const int gw = blockIdx.x * 8 + wave, NGW = gridDim.x * 8;
    const float* rowss = (const float*)(p.ws + WS_ROWSS); const float* gain = p.in[22];
    f32x4 gv[4];
#pragma unroll
    for (int q = 0; q < 4; ++q) gv[q] = *((const f32x4*)gain + lane + 64 * q);
    for (int row = gw; row < MTOK; row += 2 * NGW) {
        const int row2 = row + NGW;
        f32x4* hr = (f32x4*)(p.out + (size_t)row * DM) + lane; f32x4* hr2 = (f32x4*)(p.out + (size_t)row2 * DM) + lane;
        f32x4 v[4], v2[4];
#pragma unroll
        for (int q = 0; q < 4; ++q) { v[q] = hr[64 * q]; v2[q] = hr2[64 * q]; }
        const f32x4* sp = (const f32x4*)(rowss + (size_t)row * 16); const f32x4* sp2 = (const f32x4*)(rowss + (size_t)row2 * 16);
        const f32x4 st = (sp[0] + sp[1]) + (sp[2] + sp[3]), st2 = (sp2[0] + sp2[1]) + (sp2[2] + sp2[3]);
        const float rstd = rsqrtf(((st[0] + st[1]) + (st[2] + st[3])) * (1.0f / 1024.0f) + EPS);
        const float rstd2 = rsqrtf(((st2[0] + st2[1]) + (st2[2] + st2[3])) * (1.0f / 1024.0f) + EPS);
#pragma unroll
        for (int q = 0; q < 4; ++q) { hr[64 * q] = v[q] * rstd * gv[q]; hr2[64 * q] = v2[q] * rstd2 * gv[q]; }
    }
}

#define XB_TMO      128
#define XB_XCNT(j)  (256  + 64 * (j))
#define XB_XSUB(j)  (1280 + 64 * (j))
#define XB_XGEN(j)  (2304 + 64 * (j))
#define XB_TOP      3328
#define XB_TOPGEN   3392
#define XCD_BAR_WORDS 3456
#define XB_SPIN_CAP (1u << 18)
__device__ __forceinline__ unsigned xb_ld(unsigned* p)              { return __hip_atomic_load(p, __ATOMIC_RELAXED, __HIP_MEMORY_SCOPE_AGENT); }
__device__ __forceinline__ unsigned xb_add(unsigned* p, unsigned v) { return __hip_atomic_fetch_add(p, v, __ATOMIC_RELAXED, __HIP_MEMORY_SCOPE_AGENT); }
__device__ __forceinline__ unsigned xb_xcc_id() { return (unsigned)__builtin_amdgcn_s_getreg((3 << 11) | 20) & 0xFu; }
#define XB_SPIN(cond, bar) do { unsigned _sp = 0; while (cond) { __builtin_amdgcn_s_sleep(1); \
    if ((++_sp & 255u) == 0u) { if (xb_ld(&(bar)[XB_TMO])) break; if (_sp > XB_SPIN_CAP) { atomicAdd(&(bar)[XB_TMO], 1u); break; } } } } while (0)
struct XcdBarrier { unsigned* bar; unsigned x; volatile LAS unsigned* st; };
__device__ __forceinline__ XcdBarrier xcd_barrier_post(unsigned* bar, volatile LAS unsigned* st) {
    XcdBarrier b; b.bar = bar; b.x = xb_xcc_id(); b.st = st;
    if (threadIdx.x == 0) (void)xb_add(&bar[XB_XCNT(b.x)], 1u);
    return b;
}
__device__ __forceinline__ void xcd_barrier_complete(unsigned* bar, unsigned x, unsigned& nloc, unsigned& nx) {
    const unsigned G = gridDim.x * gridDim.y * gridDim.z;
    unsigned sum, cnt, mine, sp = 0u;
    for (;;) {
        sum = 0u; cnt = 0u; mine = 0u;
#pragma unroll
        for (unsigned j = 0; j < 16; ++j) { const unsigned c = xb_ld(&bar[XB_XCNT(j)]); sum += c; cnt += (c > 0u) ? 1u : 0u; mine = (j == x) ? c : mine; }
        if (sum == G) break;
        __builtin_amdgcn_s_sleep(1);
        if ((++sp & 255u) == 0u) { if (xb_ld(&bar[XB_TMO])) break; if (sp > XB_SPIN_CAP) { atomicAdd(&bar[XB_TMO], 1u); break; } }
    }
    nloc = mine > 0u ? mine : 1u; nx = cnt > 0u ? cnt : 1u;
}
__device__ __forceinline__ void xcd_barrier(const XcdBarrier& b) {
    asm volatile("s_waitcnt vmcnt(0)" ::: "memory");
    __syncthreads();
    if (threadIdx.x == 0) {
        unsigned* bar = b.bar;
        __builtin_amdgcn_s_waitcnt(0);
        unsigned nloc = b.st[0], nx = b.st[1];
        if (nloc == 0u) { xcd_barrier_complete(bar, b.x, nloc, nx); b.st[0] = nloc; b.st[1] = nx; }
        const unsigned old = xb_add(&bar[XB_XSUB(b.x)], 1u);
        const unsigned gen = old / nloc;
        if (old + 1u == (gen + 1u) * nloc) {
            __builtin_amdgcn_fence(__ATOMIC_RELEASE, "agent");
            asm volatile("s_waitcnt vmcnt(0)" ::: "memory");
            const unsigned og = xb_add(&bar[XB_TOP], 1u);
            const unsigned tg = og / nx;
            if (og + 1u == (tg + 1u) * nx) xb_add(&bar[XB_TOPGEN], 1u);
            else XB_SPIN(xb_ld(&bar[XB_TOPGEN]) == tg, bar);
            __builtin_amdgcn_fence(__ATOMIC_ACQUIRE, "agent");
            xb_add(&bar[XB_XGEN(b.x)], 1u);
            asm volatile("s_waitcnt vmcnt(0)" ::: "memory");
        } else {
            XB_SPIN(xb_ld(&bar[XB_XGEN(b.x)]) == gen, bar);
            __builtin_amdgcn_fence(__ATOMIC_ACQUIRE, "agent");
            asm volatile("s_waitcnt vmcnt(0)" ::: "memory");
        }
    }
    __syncthreads();
}

__device__ __forceinline__ void xcd_local_barrier(const XcdBarrier& b) {
    asm volatile("s_waitcnt vmcnt(0)" ::: "memory");
    __syncthreads();
    if (threadIdx.x == 0) {
        unsigned* bar = b.bar;
        __builtin_amdgcn_s_waitcnt(0);
        const unsigned nloc = b.st[0];
        const unsigned old = xb_add(&bar[XB_XSUB(b.x)], 1u);
        const unsigned gen = old / nloc;
        if (old + 1u == (gen + 1u) * nloc) xb_add(&bar[XB_XGEN(b.x)], 1u);
        else XB_SPIN(xb_ld(&bar[XB_XGEN(b.x)]) == gen, bar);
        __builtin_amdgcn_fence(__ATOMIC_ACQUIRE, "agent");
        asm volatile("s_waitcnt vmcnt(0)" ::: "memory");
    }
    __syncthreads();
}

__global__ void __launch_bounds__(NTHR, 2) fwd_megakernel(Params p) {
    extern __shared__ __attribute__((aligned(16))) unsigned char lds_raw[];
    LAS unsigned char* lds = (LAS unsigned char*)lds_raw;
    const int G = gridDim.x, bid = blockIdx.x;
    bf16_t* WTb = (bf16_t*)(p.ws + WS_WT);
    bf16_t* HB = (bf16_t*)(p.ws + WS_HB); bf16_t* Y = (bf16_t*)(p.ws + WS_Y); bf16_t* BIG = (bf16_t*)(p.ws + WS_BIG);
    float* rowss = (float*)(p.ws + WS_ROWSS);

    volatile LAS unsigned* xst = (volatile LAS unsigned*)(lds + LDS_BYTES - 64);
    if (threadIdx.x < 8) xst[threadIdx.x] = 0u;
    __syncthreads();
    XcdBarrier xbar; xbar.bar = (unsigned*)(p.ws + WS_BAR); xbar.st = xst; xbar.x = xb_xcc_id();
    if (threadIdx.x == 0) xst[2] = xb_add(&xbar.bar[XB_XCNT(xbar.x)], 1u);
    for (int rep = 0; rep < DBG_REP_P0; ++rep) phase0(lds, p);
    cg::this_grid().sync();
    if (threadIdx.x == 0) {
        bool okc = (G % 8) == 0;
        for (unsigned jx = 0; jx < 16; ++jx) { const unsigned cx = xb_ld(&xbar.bar[XB_XCNT(jx)]); okc = okc && (cx == (jx < 8 ? (unsigned)G / 8u : 0u)); }
        xst[4] = okc ? (xst[2] * 8u + xbar.x) : (unsigned)bid; xst[5] = okc ? 1u : 0u;
    }
    __syncthreads();
    const int vid = __builtin_amdgcn_readfirstlane((int)xst[4]);
    const bool xlocal = USE_LOCAL_BAR && (__builtin_amdgcn_readfirstlane((int)xst[5]) != 0);
    const int NX = ((G & 7) == 0) ? 8 : 1, xv = vid % NX, rk = vid / NX, RK = G / NX;
#define SEAM() do { if (xlocal) xcd_local_barrier(xbar); else xcd_barrier(xbar); } while (0)
#define GRID_SYNC() xcd_barrier(xbar)
#pragma unroll 1
    for (int layer = 0; layer < 4; ++layer) {
        const int j = layer >> 1;
        const bool even = (layer & 1) == 0;
        if (even) {
            pg8::Gemm g{HB, WTb + OFF_INE + (size_t)j * 3145728, MTOK, 3072, 1024}; pg8::StaticOrder S; int vq1 = vid, Gq1 = G; asm volatile("" : "+s"(vq1), "+s"(Gq1)); S.init(MTOK, 3072, Gq1, vq1, 0);
            pg8::EpiIn<0> E{BIG, 3072, rowss};
            pg8::gemm_phase(lds, g, S, E);
        } else {
            pg8::Gemm g{HB, WTb + OFF_INO + (size_t)j * 1572864, MTOK, 1536, 1024}; pg8::StaticOrder S; int vq2 = vid, Gq2 = G; asm volatile("" : "+s"(vq2), "+s"(Gq2)); S.init(MTOK, 1536, Gq2, vq2, 0);
            pg8::EpiIn<1> E{BIG, 1536, rowss};
            pg8::gemm_phase(lds, g, S, E);
        }
        if (layer == 0) GRID_SYNC(); else SEAM();
        if (even) {
            for (int i = rk; i < 256 / NX; i += RK) lru_pass<1>(lds, p, j, xv * (256 / NX) + i);
            hgrn2_run<1>(lds, p, j, xv * (512 / NX) + rk, RK, (512 / NX - rk + RK - 1) / RK);
            SEAM();
            for (int i = rk; i < 256 / NX; i += RK) lru_pass<2>(lds, p, j, xv * (256 / NX) + i);
            hgrn2_run<2>(lds, p, j, xv * (512 / NX) + rk, RK, (512 / NX - rk + RK - 1) / RK);
        } else {
            if (rk < 2048 / NX) {
                const int sbase = xv * (2048 / NX);
                if ((RK & 3) == 0) sgu_weights(lds, p, j, (sbase + rk) & 3);
                SguPre snx; sgu_load(p, j, sbase + rk, snx);
                for (int i = rk; i < 2048 / NX; i += RK) {
                    const SguPre scur = snx;
                    if ((RK & 3) != 0) { __syncthreads(); sgu_weights(lds, p, j, (sbase + i) & 3); }
                    if (i + RK < 2048 / NX) sgu_load(p, j, sbase + i + RK, snx);
                    sgu_item(lds, p, j, sbase + i, scur);
                }
            }
            if (rk < 2048 / NX) {
                const int pbase = xv * (2048 / NX);
                PoolPre pnx; pool_load(p, j, pbase + (rk & ~3) + (rk & 3), pnx);
                for (int i = rk, k = 0; i < 2048 / NX; i += RK, ++k) {
                    const PoolPre pcur = pnx;
                    const int i2 = i + RK;
                    if (i2 < 2048 / NX) pool_load(p, j, pbase + (i2 & ~3) + ((i2 + k + 1) & 3), pnx);
                    pool_item(lds, p, j, pbase + (i & ~3) + ((i + k) & 3), pcur);
                }
            }
        }
        SEAM();
        {
            const bf16_t* Wt = even ? WTb + OFF_OUTE + (size_t)j * 1048576 : WTb + OFF_OUTO + (size_t)j * 1048576;
            pg8::Gemm g{Y, Wt, MTOK, 1024, 1024}; pg8::StaticOrder S; int vq3 = vid, Gq3 = G; asm volatile("" : "+s"(vq3), "+s"(Gq3)); S.init(MTOK, 1024, Gq3, vq3, 1);
            pg8::EpiRes E{layer == 0 ? p.in[0] : (const float*)p.out, p.out, HB, rowss};
            pg8::gemm_phase(lds, g, S, E);
        }
        SEAM();
        {
            pg8::Gemm g{HB, WTb + OFF_FIN + (size_t)layer * 4194304, MTOK, 4096, 1024}; pg8::StaticOrder S; int vq4 = vid, Gq4 = G; asm volatile("" : "+s"(vq4), "+s"(Gq4)); S.init(MTOK, 4096, Gq4, vq4, 0);
            pg8::EpiIn<2> E{BIG, 4096, rowss};
            pg8::gemm_phase(lds, g, S, E);
        }
        SEAM();
        {
            pg8::Gemm g{BIG, WTb + OFF_FOUT + (size_t)layer * 4194304, MTOK, 1024, 4096}; pg8::StaticOrder S; int vq5 = vid, Gq5 = G; asm volatile("" : "+s"(vq5), "+s"(Gq5)); S.init(MTOK, 1024, Gq5, vq5, 1);
            pg8::EpiRes E{(const float*)p.out, p.out, HB, rowss};
            pg8::gemm_phase(lds, g, S, E);
        }
        if (layer == 3) GRID_SYNC(); else SEAM();
    }
    for (int rep = 0; rep < DBG_EXTRA_SYNCS; ++rep) GRID_SYNC();
    final_norm(p);
}

extern "C" void kernel_launch(void* const* d_in, const int* in_sizes, int n_in, void* d_out, int out_size, void* d_ws, size_t ws_size, hipStream_t stream) {
    static int grid_blocks = 0;
    if (!grid_blocks) {
        int dev = 0, cus = 0, per_cu = 0;
        (void)hipGetDevice(&dev);
        (void)hipDeviceGetAttribute(&cus, hipDeviceAttributeMultiprocessorCount, dev);
        (void)hipFuncSetAttribute((const void*)fwd_megakernel, hipFuncAttributeMaxDynamicSharedMemorySize, LDS_BYTES);
        (void)hipOccupancyMaxActiveBlocksPerMultiprocessor(&per_cu, (const void*)fwd_megakernel, NTHR, LDS_BYTES);
        (void)hipGetLastError();
        grid_blocks = cus > 0 ? cus : 256;
        if (n_in != 23 || out_size != MTOK * DM || ws_size < (size_t)868 * MiB) fprintf(stderr, "kernel_launch: unexpected shapes n_in %d out %d ws %zu\n", n_in, out_size, ws_size);
    }
    Params p{};
    for (int i = 0; i < 23; ++i) p.in[i] = (const float*)d_in[i];
    p.out = (float*)d_out; p.ws = (unsigned char*)d_ws;
    (void)hipMemsetAsync((unsigned char*)d_ws + WS_BAR, 0, 16384, stream);
    void* args[] = {&p};
    hipError_t e = hipLaunchCooperativeKernel((void*)fwd_megakernel, dim3(grid_blocks), dim3(NTHR), args, LDS_BYTES, stream);
    if (e != hipSuccess) fprintf(stderr, "cooperative launch failed: %s (grid %d)\n", hipGetErrorString(e), grid_blocks);
}
```

```cpp
#include <hip/hip_runtime.h>
#include <hip/hip_cooperative_groups.h>
#include <cstdio>
namespace cg = cooperative_groups;

#define LAS __attribute__((address_space(3)))
typedef unsigned short bf16_t;
typedef short bf16x8 __attribute__((ext_vector_type(8)));
typedef float f32x4 __attribute__((ext_vector_type(4)));
typedef unsigned u32x4 __attribute__((ext_vector_type(4)));
typedef unsigned u32x2 __attribute__((ext_vector_type(2)));

constexpr int MTOK = 65536, DM = 1024, SEQ = 4096;
constexpr float EPS = 1e-6f;
constexpr int LDS_BYTES = 155648;
#define DBG_REP_EVEN 1
#define DBG_REP_ODD 1
#define DBG_REP_FFNIN 1
#define DBG_REP_P0 1
#define DBG_EPI2 0
#define DBG_EXTRA_SYNCS 0
#define USE_LOCAL_BAR 1
#define DBG_SKIP_EVEN 0
#define DBG_SKIP_LRU 0
#define DBG_SKIP_HGRN 0
#define DBG_SKIP_ODD 0
constexpr int NTHR = 512;

constexpr size_t MiB = 1u << 20;
constexpr size_t WS_WT = 0;
constexpr size_t WS_SMALL = 90 * MiB;
constexpr size_t WS_BAR = 91 * MiB;
constexpr size_t WS_ROWSS = 92 * MiB;
constexpr size_t WS_LRUC = 96 * MiB;
constexpr size_t WS_HGG = 98 * MiB;
constexpr size_t WS_HB = 100 * MiB;
constexpr size_t WS_Y = 228 * MiB;
constexpr size_t WS_BIG = 356 * MiB;
constexpr size_t WS_ST = 868 * MiB;
constexpr size_t OFF_INE = 0, OFF_OUTE = 6291456, OFF_INO = 8388608, OFF_OUTO = 11534336, OFF_FIN = 13631488, OFF_FOUT = 30408704;
constexpr size_t SM_WAT = 0, SM_WXT = 256 * 1024, SM_SGUW = 512 * 1024, SM_PWT = 768 * 1024;

struct Params { const float* in[23]; float* out; unsigned char* ws; };

typedef float f32x2_ __attribute__((ext_vector_type(2)));
typedef __bf16 bf16x2_ __attribute__((ext_vector_type(2)));
__device__ __forceinline__ unsigned cvt_pk_bf16(float lo, float hi) { f32x2_ v = {lo, hi}; bf16x2_ r = __builtin_convertvector(v, bf16x2_); return __builtin_bit_cast(unsigned, r); }
__device__ __forceinline__ float bf_lo(unsigned w) { return __uint_as_float(w << 16); }
__device__ __forceinline__ float bf_hi(unsigned w) { return __uint_as_float(w & 0xffff0000u); }
__device__ __forceinline__ float bf2f(bf16_t b) { return __uint_as_float(((unsigned)b) << 16); }
__device__ __forceinline__ bf16_t f2bf(float f) { return (bf16_t)(cvt_pk_bf16(f, 0.f) & 0xffffu); }
__device__ __forceinline__ float rcp_(float x) { return __builtin_amdgcn_rcpf(x); }
__device__ __forceinline__ float sigmoid_(float x) { return rcp_(1.0f + __expf(-x)); }
__device__ __forceinline__ float gelu_tanh(float x) { const float u = 0.7978845608f * (x + 0.044715f * x * x * x); return x * rcp_(1.0f + __expf(-2.0f * u)); }
__device__ __forceinline__ float silu_(float x) { return x * rcp_(1.0f + __expf(-x)); }
__device__ __forceinline__ size_t tiled(size_t row, int col, int K) { return ((row >> 8) * (size_t)K + (size_t)(col >> 6) * 64) * 256 + ((row & 255) << 6) + (size_t)(col & 63); }
__device__ __forceinline__ size_t proj_off(size_t row, int ldc) { return (row >> 13) * (size_t)33554432 + (row & 8191) * (size_t)ldc; }
#define LDS_WAIT() asm volatile("s_waitcnt lgkmcnt(0)" ::: "memory")

namespace pg8 {
constexpr int BM = 256, BK = 64, HALF = 128, HTB = HALF * BK * 2, STAGE_BYTES = 8 * HTB, NXCD = 8, WGM = 4;
__host__ __device__ __forceinline__ int lds_byte(int r, int c) { const int st = (r >> 4) * 2 + (c >> 5), rr = r & 15, cc = c & 31, ob = rr * 64 + cc * 2; return st * 1024 + (ob ^ (((ob >> 9) & 1) << 5)); }
__host__ __device__ __forceinline__ void stage_rc(int b, int& R, int& C) { const int st = b / 1024, sb = b % 1024, swz = sb ^ (((sb >> 9) & 1) << 5); R = (st >> 1) * 16 + swz / 64; C = (st & 1) * 32 + (swz % 64) / 2; }
__host__ __device__ __forceinline__ int perm32(int rho) { const int n = rho >> 4, i = rho & 15; return 8 * (i >> 2) + 4 * n + (i & 3); }
struct Unit { int pm, pn; };
struct Gemm { const bf16_t* A; const bf16_t* Bt; int M, N, K; };
struct StaticOrder {
    int nM, nN, nwg, G, c, rev;
    __device__ void init(int M, int N, int G_, int c_, int rev_ = 0) { nM = M / BM; nN = N / BM; nwg = nM * nN; G = G_; c = c_; rev = rev_; }
    __device__ bool next(int i, Unit& u) const {
        const int nround = (nwg + G - 1) / G; if (i >= nround) return false;
        const long L = (long)(rev ? (nround - 1 - i) : i) * G + c; if (L >= nwg) return false;
        int wgid = (int)L; { const int q = nwg / NXCD, r = nwg % NXCD, xcd = wgid % NXCD, off = wgid / NXCD; wgid = (xcd < r ? xcd * (q + 1) : r * (q + 1) + (xcd - r) * q) + off; }
        const int nig = WGM * nN, gid = wgid / nig, fm = gid * WGM, gsz = (nM - fm) < WGM ? (nM - fm) : WGM;
        u.pm = fm + ((wgid % nig) % gsz); u.pn = (wgid % nig) / gsz; return true;
    }
};

template <int ACT> struct EpiIn {
    static constexpr bool PERM = true, PRE = true;
    bf16_t* O; int ldc; const float* rowss;
    __device__ __forceinline__ void operator()(const f32x4 (&acc)[2][2][4][2], const Unit& u, int wr, int wc, int fr, int fq, const LAS float* RS) const {
        const int row0 = u.pm * BM + wr * 64 + fr, col0 = u.pn * BM + wc * 32 + 8 * fq;
        const bool do_gelu = (ACT == 1) && (u.pn < 4);
        float rs[8];
#pragma unroll
        for (int i = 0; i < 8; ++i) rs[i] = RS[(i >> 2) * HALF + wr * 64 + (i & 3) * 16 + fr];
#pragma unroll
        for (int ai = 0; ai < 2; ++ai)
#pragma unroll
            for (int m = 0; m < 4; ++m) {
                const int row = row0 + ai * HALF + m * 16;
                const float rstd = rs[ai * 4 + m];
                bf16_t* rowp = (ACT == 2) ? O + tiled((size_t)row, col0, ldc) : O + proj_off((size_t)row, ldc) + col0;
#pragma unroll
                for (int bj = 0; bj < 2; ++bj) {
                    f32x4 v0 = acc[ai][bj][m][0] * rstd, v1 = acc[ai][bj][m][1] * rstd;
                    if (ACT == 1) { if (do_gelu) {
#pragma unroll
                        for (int q = 0; q < 4; ++q) { v0[q] = gelu_tanh(v0[q]); v1[q] = gelu_tanh(v1[q]); } } }
                    if (ACT == 2) {
#pragma unroll
                        for (int q = 0; q < 4; ++q) { const float a = fmaxf(v0[q], 0.f), b = fmaxf(v1[q], 0.f); v0[q] = a * a; v1[q] = b * b; } }
                    u32x4 w; w.x = cvt_pk_bf16(v0[0], v0[1]); w.y = cvt_pk_bf16(v0[2], v0[3]); w.z = cvt_pk_bf16(v1[0], v1[1]); w.w = cvt_pk_bf16(v1[2], v1[3]);
                    *(u32x4*)(rowp + bj * ((ACT == 2) ? HALF * 256 : HALF)) = w;
                }
            }
    }
};
struct EpiRes {
    static constexpr bool PERM = true, PRE = false;
    const float* res; float* H; bf16_t* HB; float* rowss;
    __device__ __forceinline__ void operator()(const f32x4 (&acc)[2][2][4][2], const Unit& u, int wr, int wc, int fr, int fq, const LAS float*) const {
        const int row0 = u.pm * BM + wr * 64 + fr, col0 = u.pn * BM + wc * 32 + 8 * fq;
#pragma unroll
        for (int ai = 0; ai < 2; ++ai) {
            f32x4 r[4][4];
#pragma unroll
            for (int m = 0; m < 4; ++m) {
                const size_t off = (size_t)(row0 + ai * HALF + m * 16) * DM + col0;
#pragma unroll
                for (int q = 0; q < 4; ++q) r[m][q] = *(const f32x4*)(res + off + (q >> 1) * HALF + (q & 1) * 4);
            }
#pragma unroll
            for (int m = 0; m < 4; ++m) {
                const int row = row0 + ai * HALF + m * 16;
                const size_t off = (size_t)row * DM + col0;
                float ss = 0.f;
#pragma unroll
                for (int bj = 0; bj < 2; ++bj) {
                    const f32x4 v0 = r[m][bj * 2] + acc[ai][bj][m][0], v1 = r[m][bj * 2 + 1] + acc[ai][bj][m][1];
                    *(f32x4*)(H + off + bj * HALF) = v0; *(f32x4*)(H + off + bj * HALF + 4) = v1;
                    ss += ((v0[0] * v0[0] + v0[1] * v0[1]) + (v0[2] * v0[2] + v0[3] * v0[3])) + ((v1[0] * v1[0] + v1[1] * v1[1]) + (v1[2] * v1[2] + v1[3] * v1[3]));
                    u32x4 w; w.x = cvt_pk_bf16(v0[0], v0[1]); w.y = cvt_pk_bf16(v0[2], v0[3]); w.z = cvt_pk_bf16(v1[0], v1[1]); w.w = cvt_pk_bf16(v1[2], v1[3]);
                    *(u32x4*)(HB + tiled((size_t)row, col0 + bj * HALF, DM)) = w;
                }
                ss += __shfl_xor(ss, 16); ss += __shfl_xor(ss, 32);
                if (fq == 0) rowss[(size_t)row * 16 + u.pn * 4 + wc] = ss;
            }
        }
    }
};

template <class Epi, class Sched>
__device__ __forceinline__ void gemm_phase(LAS unsigned char* lds, const Gemm g, const Sched& S, const Epi& E) {
    int tid = threadIdx.x; asm volatile("" : "+v"(tid));
    const int wid = __builtin_amdgcn_readfirstlane(tid >> 6), lane = tid & 63, wr = wid >> 2, wc = wid & 3, fr = lane & 15, fq = lane >> 4;
    const int K = g.K, nt = K / BK;
    unsigned voffA[2], voffB[2];
#pragma unroll
    for (int i = 0; i < 2; ++i) { int R, C; stage_rc(tid * 16 + i * 8192, R, C); const int Rb = Epi::PERM ? ((R & ~31) + perm32(R & 31)) : R;
        voffA[i] = (unsigned)(R * BK + C) * 2u; voffB[i] = (unsigned)(Rb * K + C) * 2u; }
    const size_t kstep = (size_t)(BK * 2);
    const size_t hstep = (size_t)HALF * K * 2;
    const size_t tstep = 2 * hstep;
    const size_t kstepA = (size_t)BM * BK * 2, hstepA = (size_t)HALF * BK * 2;
    const unsigned ldsw = (unsigned)wid * 1024u;
    const int aoff = lds_byte(wr * 64 + fr, fq * 8), boff = lds_byte(wc * 32 + fr, fq * 8);
    LAS float* RS = (LAS float*)(lds + STAGE_BYTES);
#define PG8_SA(b, h) (((b) * 2 + (h)) * HTB)
#define PG8_SB(b, h) ((4 + (b) * 2 + (h)) * HTB)
#define PG8_STAGE(bufoff, gbase, voff) do { _Pragma("unroll") for (int _i = 0; _i < 2; ++_i) \
        __builtin_amdgcn_global_load_lds((const unsigned*)((const char*)(gbase) + (voff)[_i]), (LAS unsigned*)(lds + (bufoff) + ldsw + _i * 8192), 16, 0, 0); } while (0)
#define PG8_LDA(dst, b, h) do { _Pragma("unroll") for (int m = 0; m < 4; ++m) _Pragma("unroll") for (int k = 0; k < 2; ++k) dst[m][k] = *(const LAS bf16x8*)(lds + PG8_SA(b, h) + aoff + m * 2048 + k * 1024); } while (0)
#define PG8_LDB(dst, b, h) do { _Pragma("unroll") for (int n = 0; n < 2; ++n) _Pragma("unroll") for (int k = 0; k < 2; ++k) dst[n][k] = *(const LAS bf16x8*)(lds + PG8_SB(b, h) + boff + n * 2048 + k * 1024); } while (0)
#define PG8_MMA(ai, bj, At, Bt) do { __builtin_amdgcn_s_setprio(1); _Pragma("unroll") for (int m = 0; m < 4; ++m) _Pragma("unroll") for (int n = 0; n < 2; ++n) _Pragma("unroll") for (int k = 0; k < 2; ++k) \
        acc[ai][bj][m][n] = __builtin_amdgcn_mfma_f32_16x16x32_bf16(Bt[n][k], At[m][k], acc[ai][bj][m][n], 0, 0, 0); __builtin_amdgcn_s_setprio(0); } while (0)
#define PG8_WAIT_V(n) asm volatile("s_waitcnt vmcnt(" #n ")" ::: "memory")
#define PG8_WAIT_L(n) asm volatile("s_waitcnt lgkmcnt(" #n ")" ::: "memory")
#define PG8_BAR __builtin_amdgcn_s_barrier()
#define PG8_SCHED __builtin_amdgcn_sched_barrier(0)
    Unit cur, nxt; int ui = 0;
    if (!S.next(0, cur)) return;
    f32x4 acc[2][2][4][2];
#pragma unroll
    for (int a = 0; a < 2; ++a)
#pragma unroll
        for (int b = 0; b < 2; ++b)
#pragma unroll
            for (int m = 0; m < 4; ++m)
#pragma unroll
                for (int n = 0; n < 2; ++n) acc[a][b][m][n] = (f32x4){0.f, 0.f, 0.f, 0.f};
    bf16x8 At[4][2], B0[2][2], B1[2][2];
    const char* cA = (const char*)g.A + (size_t)cur.pm * tstep; const char* cB = (const char*)g.Bt + (size_t)cur.pn * tstep;
    PG8_STAGE(PG8_SB(0, 0), cB, voffB); PG8_STAGE(PG8_SA(0, 0), cA, voffA); PG8_STAGE(PG8_SB(0, 1), cB + hstep, voffB); PG8_STAGE(PG8_SA(0, 1), cA + hstepA, voffA);
    if (wr == 1) PG8_BAR;
    PG8_WAIT_V(4); PG8_BAR;
    PG8_STAGE(PG8_SB(1, 0), cB + kstep, voffB); PG8_STAGE(PG8_SA(1, 0), cA + kstepA, voffA); PG8_STAGE(PG8_SB(1, 1), cB + hstep + kstep, voffB);
    PG8_WAIT_V(6); PG8_BAR;
    for (;;) {
        const bool has_next = S.next(ui + 1, nxt);
        const char* nA = has_next ? (const char*)g.A + (size_t)nxt.pm * tstep : cA; const char* nB = has_next ? (const char*)g.Bt + (size_t)nxt.pn * tstep : cB;
        for (int t = 0; t < nt; t += 2) {
            const bool last = (t == nt - 2);
            const char* a1 = cA + (size_t)(t + 1) * kstepA;
            const char* a2 = last ? nA : cA + (size_t)(t + 2) * kstepA; const char* b2 = last ? nB : cB + (size_t)(t + 2) * kstep;
            const char* a3 = a2 + kstepA; const char* b3 = b2 + kstep;
            f32x4 rsA;
            if constexpr (Epi::PRE) { if (t <= 2) { const float* rp = E.rowss + (size_t)(cur.pm * BM + (t >> 1) * HALF + (tid >> 2)) * 16 + (tid & 3) * 4;
                asm volatile("global_load_dwordx4 %0, %1, off" : "=&v"(rsA) : "v"(rp) : "memory"); } }
            PG8_LDB(B0, 0, 0); PG8_SCHED; PG8_LDA(At, 0, 0); PG8_STAGE(PG8_SA(1, 1), a1 + hstepA, voffA);
            PG8_WAIT_L(8); PG8_BAR; PG8_WAIT_L(0); PG8_MMA(0, 0, At, B0); PG8_BAR; PG8_SCHED;
            PG8_LDB(B1, 0, 1); PG8_STAGE(PG8_SB(0, 0), b2, voffB);
            PG8_BAR; PG8_WAIT_L(0); PG8_MMA(0, 1, At, B1); PG8_BAR;
            PG8_LDA(At, 0, 1); PG8_STAGE(PG8_SA(0, 0), a2, voffA);
            PG8_BAR; PG8_WAIT_L(0); PG8_MMA(1, 0, At, B0); PG8_BAR; PG8_SCHED;
            PG8_STAGE(PG8_SB(0, 1), b2 + hstep, voffB);
            PG8_WAIT_V(6); PG8_BAR; PG8_MMA(1, 1, At, B1); PG8_BAR;
            if constexpr (Epi::PRE) { if (t <= 2) { asm volatile("s_waitcnt vmcnt(8)" : "+v"(rsA) :: "memory"); float sq = (rsA[0] + rsA[1]) + (rsA[2] + rsA[3]); sq += __shfl_xor(sq, 1); sq += __shfl_xor(sq, 2);
                if (!(tid & 3)) RS[(t >> 1) * HALF + (tid >> 2)] = rsqrtf(sq * (1.0f / 1024.0f) + EPS); } }
            PG8_LDB(B0, 1, 0); PG8_SCHED; PG8_LDA(At, 1, 0); PG8_STAGE(PG8_SA(0, 1), a2 + hstepA, voffA);
            PG8_WAIT_L(8); PG8_BAR; PG8_WAIT_L(0); PG8_MMA(0, 0, At, B0); PG8_BAR; PG8_SCHED;
            PG8_LDB(B1, 1, 1); PG8_STAGE(PG8_SB(1, 0), b3, voffB);
            PG8_BAR; PG8_WAIT_L(0); PG8_MMA(0, 1, At, B1); PG8_BAR;
            PG8_LDA(At, 1, 1); PG8_STAGE(PG8_SA(1, 0), a3, voffA);
            PG8_BAR; PG8_WAIT_L(0); PG8_MMA(1, 0, At, B0); PG8_BAR; PG8_SCHED;
            PG8_STAGE(PG8_SB(1, 1), b3 + hstep, voffB);
            PG8_WAIT_V(6); PG8_BAR; PG8_MMA(1, 1, At, B1); PG8_BAR;
        }
        E(acc, cur, wr, wc, fr, fq, RS);
        if (!has_next) break;
#pragma unroll
        for (int a = 0; a < 2; ++a)
#pragma unroll
            for (int b = 0; b < 2; ++b)
#pragma unroll
                for (int m = 0; m < 4; ++m)
#pragma unroll
                    for (int n = 0; n < 2; ++n) acc[a][b][m][n] = (f32x4){0.f, 0.f, 0.f, 0.f};
        cur = nxt; cA = nA; cB = nB; ++ui;
    }
    PG8_WAIT_V(0);
    if (wr == 0) PG8_BAR;
    PG8_BAR;
#undef PG8_SA
#undef PG8_SB
#undef PG8_STAGE
#undef PG8_LDA
#undef PG8_LDB
#undef PG8_MMA
#undef PG8_WAIT_V
#undef PG8_WAIT_L
#undef PG8_BAR
#undef PG8_SCHED
}
}

__device__ __forceinline__ void transpose_item(const float* W, int K, int N, bf16_t* WT, const float* kscale, LAS float* scr, int item, int lane) {
    const int nblk = N / 32, kb = item / nblk, nb = item % nblk, k0 = 64 * kb, n0 = 32 * nb;
    float wv[32];
#pragma unroll
    for (int i = 0; i < 32; ++i) wv[i] = W[(size_t)(k0 + 2 * i + (lane >> 5)) * N + n0 + (lane & 31)];
#pragma unroll
    for (int i = 0; i < 32; ++i) { const int kk = 2 * i + (lane >> 5); const float s = kscale ? kscale[k0 + kk] : 1.0f; scr[kk * 33 + (lane & 31)] = wv[i] * s; }
    LDS_WAIT();
    const int c = lane & 7;
#pragma unroll
    for (int j = 0; j < 4; ++j) { const int n = (lane >> 3) + 8 * j; const LAS float* s = scr + (8 * c) * 33 + n;
        u32x4 o; o.x = cvt_pk_bf16(s[0 * 33], s[1 * 33]); o.y = cvt_pk_bf16(s[2 * 33], s[3 * 33]); o.z = cvt_pk_bf16(s[4 * 33], s[5 * 33]); o.w = cvt_pk_bf16(s[6 * 33], s[7 * 33]);
        *(u32x4*)(WT + (size_t)(n0 + n) * K + k0 + 8 * c) = o; }
    LDS_WAIT();
}

__device__ __forceinline__ void phase0(LAS unsigned char* lds, const Params& p) {
    int tid = threadIdx.x; asm volatile("" : "+v"(tid));
    const int lane = tid & 63, wave = tid >> 6;
    const int gw = blockIdx.x * 8 + wave, NGW = gridDim.x * 8;
    LAS float* scr = (LAS float*)(lds + wave * 8704);
    bf16_t* WTb = (bf16_t*)(p.ws + WS_WT);
#pragma unroll 1
    for (int mat = 0; mat < 16; ++mat) {
        const float* W; int K, N; bf16_t* WT; const float* ks = nullptr;
        if (mat < 2)       { W = p.in[3] + (size_t)mat * 1024 * 3072; K = 1024; N = 3072; WT = WTb + OFF_INE + (size_t)mat * 3145728; ks = p.in[1] + (2 * mat) * 1024; }
        else if (mat < 4)  { const int j = mat - 2; W = p.in[13] + (size_t)j * 1048576; K = 1024; N = 1024; WT = WTb + OFF_OUTE + (size_t)j * 1048576; }
        else if (mat < 6)  { const int j = mat - 4; W = p.in[14] + (size_t)j * 1024 * 1536; K = 1024; N = 1536; WT = WTb + OFF_INO + (size_t)j * 1572864; ks = p.in[1] + (2 * j + 1) * 1024; }
        else if (mat < 8)  { const int j = mat - 6; W = p.in[19] + (size_t)j * 1048576; K = 1024; N = 1024; WT = WTb + OFF_OUTO + (size_t)j * 1048576; }
        else if (mat < 12) { const int l = mat - 8; W = p.in[20] + (size_t)l * 4194304; K = 1024; N = 4096; WT = WTb + OFF_FIN + (size_t)l * 4194304; ks = p.in[2] + l * 1024; }
        else               { const int l = mat - 12; W = p.in[21] + (size_t)l * 4194304; K = 4096; N = 1024; WT = WTb + OFF_FOUT + (size_t)l * 4194304; }
        const int nitems = (K / 64) * (N / 32);
        for (int it = gw; it < nitems; it += NGW) transpose_item(W, K, N, WT, ks, scr, it, lane);
    }
    {
        const size_t gtid = (size_t)blockIdx.x * NTHR + tid, gsz = (size_t)gridDim.x * NTHR;
        bf16_t* WaT = (bf16_t*)(p.ws + WS_SMALL + SM_WAT); bf16_t* WxT = (bf16_t*)(p.ws + WS_SMALL + SM_WXT);
        bf16_t* SW = (bf16_t*)(p.ws + WS_SMALL + SM_SGUW); bf16_t* PWT = (bf16_t*)(p.ws + WS_SMALL + SM_PWT);
        for (size_t i = gtid; i < 131072; i += gsz) {
            const int ii = i & 63, jo = (i >> 6) & 63; const size_t lh = i >> 12;
            if (i < 65536) { WaT[i] = f2bf(p.in[6][lh * 4096 + ii * 64 + jo]);
            WxT[i] = f2bf(p.in[8][lh * 4096 + ii * 64 + jo]); }
            const int s = i & 127, t = (i >> 7) & 127;
            SW[i] = f2bf(s <= t ? p.in[15][i] : 0.f);
            const int c = i & 127, d = (i >> 7) & 127; const size_t lg = i >> 14; const size_t l = lg >> 2, gi = lg & 3;
            PWT[i] = f2bf(p.in[17][lg * 16384 + c * 128 + d] * p.in[18][l * 512 + gi * 128 + d]);
        }
    }
    {
        const float* x = p.in[0]; bf16_t* HB = (bf16_t*)(p.ws + WS_HB); float* rowss = (float*)(p.ws + WS_ROWSS);
        for (int row = gw; row < MTOK; row += 2 * NGW) {
            const int row2 = row + NGW;
            const f32x4* xr = (const f32x4*)(x + (size_t)row * DM) + lane;
            const f32x4* xr2 = (const f32x4*)(x + (size_t)row2 * DM) + lane;
            f32x4 v[4], v2[4]; float s = 0.f, s2 = 0.f;
#pragma unroll
            for (int j = 0; j < 4; ++j) { v[j] = xr[64 * j]; v2[j] = xr2[64 * j]; }
#pragma unroll
            for (int j = 0; j < 4; ++j) { s += (v[j][0] * v[j][0] + v[j][1] * v[j][1]) + (v[j][2] * v[j][2] + v[j][3] * v[j][3]); s2 += (v2[j][0] * v2[j][0] + v2[j][1] * v2[j][1]) + (v2[j][2] * v2[j][2] + v2[j][3] * v2[j][3]); }
#pragma unroll
            for (int o = 1; o < 64; o <<= 1) { s += __shfl_xor(s, o); s2 += __shfl_xor(s2, o); }
            u32x2* o8 = (u32x2*)(HB + tiled((size_t)row, 4 * lane, DM)); u32x2* o82 = (u32x2*)(HB + tiled((size_t)row2, 4 * lane, DM));
#pragma unroll
            for (int j = 0; j < 4; ++j) { u32x2 w; w.x = cvt_pk_bf16(v[j][0], v[j][1]); w.y = cvt_pk_bf16(v[j][2], v[j][3]); o8[16384 * j] = w;
                u32x2 w2; w2.x = cvt_pk_bf16(v2[j][0], v2[j][1]); w2.y = cvt_pk_bf16(v2[j][2], v2[j][3]); o82[16384 * j] = w2; }
            if (lane < 16) { rowss[(size_t)row * 16 + lane] = (lane == 0) ? s : 0.f; rowss[(size_t)row2 * 16 + lane] = (lane == 0) ? s2 : 0.f; }
        }
    }
}

template <int PASS>
__device__ __forceinline__ void lru_pass(LAS unsigned char* lds, const Params& p, int j, int item) {
    int tid = threadIdx.x; asm volatile("" : "+v"(tid));
    const int lane = tid & 63, w = __builtin_amdgcn_readfirstlane(tid >> 6), fr = lane & 15, fq = lane >> 4;
    const int b = item >> 4, seg = item & 15;
    const bf16_t* PROJ = (const bf16_t*)(p.ws + WS_BIG);
    bf16_t* Y = (bf16_t*)(p.ws + WS_Y);
    float* Pbuf = (float*)(p.ws + WS_LRUC); float* Hbuf = Pbuf + 256 * 512;
    LAS bf16_t* U = (LAS bf16_t*)lds;
    LAS bf16_t* HS = (LAS bf16_t*)(lds + 66560);
    const bf16_t* WaT = (const bf16_t*)(p.ws + WS_SMALL + SM_WAT) + (size_t)(j * 8 + w) * 4096;
    const bf16_t* WxT = (const bf16_t*)(p.ws + WS_SMALL + SM_WXT) + (size_t)(j * 8 + w) * 4096;
    bf16x8 Ba[4][2], Bx[4][2];
#pragma unroll
    for (int n = 0; n < 4; ++n)
#pragma unroll
        for (int kk = 0; kk < 2; ++kk) { Ba[n][kk] = *(const bf16x8*)(WaT + (n * 16 + fr) * 64 + kk * 32 + fq * 8); Bx[n][kk] = *(const bf16x8*)(WxT + (n * 16 + fr) * 64 + kk * 32 + fq * 8); }
    float ba[4], bx[4], sp[4], h[4], P[4];
#pragma unroll
    for (int n = 0; n < 4; ++n) {
        const int c = w * 64 + n * 16 + fr;
        ba[n] = p.in[7][j * 512 + c]; bx[n] = p.in[9][j * 512 + c];
        const float lam = p.in[10][j * 512 + c];
        sp[n] = 8.0f * 1.44269504f * log1pf(__expf(-lam));
        float hh = 0.f;
        if (PASS == 2) {
            float pq[15], hq[15];
#pragma unroll
            for (int s = 0; s < 15; ++s) { pq[s] = Pbuf[(size_t)(b * 16 + s) * 512 + c]; hq[s] = Hbuf[(size_t)(b * 16 + s) * 512 + c]; }
#pragma unroll
            for (int s = 0; s < 15; ++s) hh = (s < seg) ? pq[s] * hh + hq[s] : hh;
        }
        h[n] = hh; P[n] = 1.0f;
    }
    const int c8 = (tid & 63) * 8, tg = tid >> 6;
    LAS float* CW = (LAS float*)(lds + 133120);
    {
        const float* src = (tid < 128 * 4) ? p.in[4] + (size_t)j * 2048 : p.in[4];
        *(LAS f32x4*)(CW + tid * 4) = *(const f32x4*)(src + tid * 4);
        if (tid < 128) *(LAS f32x4*)(CW + 2048 + tid * 4) = *(const f32x4*)(p.in[5] + j * 512 + tid * 4);
    }
    __syncthreads();
#pragma unroll 1
    for (int sub = 0; sub < 4; ++sub) {
        const int t0 = seg * 256 + sub * 64;
        const size_t rowbase = (size_t)b * SEQ + t0;

        {
            float cw[4][8], cb[8];
#pragma unroll
            for (int k = 0; k < 4; ++k) { const f32x4 a = *(const LAS f32x4*)(CW + k * 512 + c8), bq = *(const LAS f32x4*)(CW + k * 512 + c8 + 4);
#pragma unroll
                for (int q = 0; q < 4; ++q) { cw[k][q] = a[q]; cw[k][4 + q] = bq[q]; } }
            { const f32x4 a = *(const LAS f32x4*)(CW + 2048 + c8), bq = *(const LAS f32x4*)(CW + 2048 + c8 + 4);
#pragma unroll
                for (int q = 0; q < 4; ++q) { cb[q] = a[q]; cb[4 + q] = bq[q]; } }
            u32x4 xw[4];
#pragma unroll
            for (int k = 0; k < 3; ++k) { const int tl = tg * 8 - 3 + k; xw[k] = (t0 + tl >= 0) ? *(const u32x4*)(PROJ + proj_off(rowbase + tl, 3072) + c8) : (u32x4){0u, 0u, 0u, 0u}; }
#pragma unroll
            for (int i = 0; i < 8; ++i) {
                const int tl = tg * 8 + i;
                xw[3] = *(const u32x4*)(PROJ + proj_off(rowbase + tl, 3072) + c8);
                float uo[8];
#pragma unroll
                for (int q = 0; q < 4; ++q) {
                    float lo = cb[2 * q], hi = cb[2 * q + 1];
#pragma unroll
                    for (int k = 0; k < 4; ++k) { lo += cw[k][2 * q] * bf_lo(xw[k][q]); hi += cw[k][2 * q + 1] * bf_hi(xw[k][q]); }
                    uo[2 * q] = lo; uo[2 * q + 1] = hi;
                }
                u32x4 o; o.x = cvt_pk_bf16(uo[0], uo[1]); o.y = cvt_pk_bf16(uo[2], uo[3]); o.z = cvt_pk_bf16(uo[4], uo[5]); o.w = cvt_pk_bf16(uo[6], uo[7]);
                *(LAS u32x4*)(U + tl * 520 + c8) = o;
                xw[0] = xw[1]; xw[1] = xw[2]; xw[2] = xw[3];
            }
        }
        __syncthreads();
#pragma unroll 1
        for (int tt = 0; tt < 4; ++tt) {
            bf16x8 a0 = *(const LAS bf16x8*)(U + (tt * 16 + fr) * 520 + w * 64 + fq * 8);
            bf16x8 a1 = *(const LAS bf16x8*)(U + (tt * 16 + fr) * 520 + w * 64 + 32 + fq * 8);
#pragma unroll
            for (int n = 0; n < 4; ++n) {
                f32x4 ar = (f32x4){ba[n], ba[n], ba[n], ba[n]}, ai = (f32x4){bx[n], bx[n], bx[n], bx[n]};
                ar = __builtin_amdgcn_mfma_f32_16x16x32_bf16(a0, Ba[n][0], ar, 0, 0, 0); ar = __builtin_amdgcn_mfma_f32_16x16x32_bf16(a1, Ba[n][1], ar, 0, 0, 0);
                ai = __builtin_amdgcn_mfma_f32_16x16x32_bf16(a0, Bx[n][0], ai, 0, 0, 0); ai = __builtin_amdgcn_mfma_f32_16x16x32_bf16(a1, Bx[n][1], ai, 0, 0, 0);
                const int c = w * 64 + n * 16 + fr;
                float av[4], bv[4];
#pragma unroll
                for (int jj = 0; jj < 4; ++jj) {
                    const int t = tt * 16 + fq * 4 + jj;
                    const float u = bf2f(U[t * 520 + c]);
                    const float r = sigmoid_(ar[jj]), ig = sigmoid_(ai[jj]);
                    const float a = __builtin_amdgcn_exp2f(-r * sp[n]);
                    const float beta = __builtin_amdgcn_sqrtf(fmaxf(1.0f - a * a, 0.f));
                    av[jj] = a; bv[jj] = beta * ig * u;
                }
                const float A4 = (av[0] * av[1]) * (av[2] * av[3]);
                const float B4 = ((bv[0] * av[1] + bv[1]) * av[2] + bv[2]) * av[3] + bv[3];
                float hs = h[n];
#pragma unroll
                for (int g = 0; g < 4; ++g) {
                    const float he = A4 * hs + B4;
                    const float nx = __shfl(he, fr + 16 * g);
                    if (fq > g) hs = nx;
                    if (g == 3) h[n] = nx;
                }
                if (PASS == 1) { float pp = A4; pp *= __shfl_xor(pp, 16); pp *= __shfl_xor(pp, 32); P[n] *= pp; }
                if (PASS == 2) {
                    float xh = hs;
#pragma unroll
                    for (int jj = 0; jj < 4; ++jj) { xh = av[jj] * xh + bv[jj]; HS[(tt * 16 + fq * 4 + jj) * 520 + c] = f2bf(xh); }
                }
            }
        }
        if (PASS == 2) {
            __syncthreads();
            u32x4 gpre[8];
#pragma unroll
            for (int i = 0; i < 8; ++i) gpre[i] = *(const u32x4*)(PROJ + proj_off(rowbase + tg * 8 + i, 3072) + 512 + c8);
#pragma unroll
            for (int i = 0; i < 8; ++i) {
                const int tl = tg * 8 + i;
                const u32x4 hv = *(const LAS u32x4*)(HS + tl * 520 + c8);
                const u32x4 gv = gpre[i];
                u32x4 o;
#pragma unroll
                for (int q = 0; q < 4; ++q) o[q] = cvt_pk_bf16(bf_lo(hv[q]) * gelu_tanh(bf_lo(gv[q])), bf_hi(hv[q]) * gelu_tanh(bf_hi(gv[q])));
                *(u32x4*)(Y + tiled(rowbase + tl, c8, 1024)) = o;
            }
        }
        __syncthreads();
    }
    if (PASS == 1) {
        if (fq == 0) {
#pragma unroll
            for (int n = 0; n < 4; ++n) { const int c = w * 64 + n * 16 + fr; Pbuf[(size_t)item * 512 + c] = P[n]; Hbuf[(size_t)item * 512 + c] = h[n]; }
        }
    }
}


__device__ __forceinline__ void hgrn_bcum2(LAS float* BC, LAS float* PT, const u32x4 (&zv)[2], const float (&lb)[8], int tid, float (&kout)[2][8]) {
    {
        const int d8 = (tid & 15) * 8, t = tid >> 4;
#pragma unroll
        for (int rr = 0; rr < 2; ++rr) {
            const int tr = t + rr * 32;
            float lf[8];
#pragma unroll
            for (int q = 0; q < 4; ++q) {
                const float z0 = bf_lo(zv[rr][q]), z1 = bf_hi(zv[rr][q]);
                const float k0 = (1.0f - lb[2 * q]) * sigmoid_(-z0), k1 = (1.0f - lb[2 * q + 1]) * sigmoid_(-z1);
                kout[rr][2 * q] = k0; kout[rr][2 * q + 1] = k1;
                lf[2 * q] = __logf(fmaxf(1.0f - k0, 1e-20f));
                lf[2 * q + 1] = __logf(fmaxf(1.0f - k1, 1e-20f));
            }
            *(LAS f32x4*)(BC + tr * 128 + d8) = (f32x4){lf[0], lf[1], lf[2], lf[3]};
            *(LAS f32x4*)(BC + tr * 128 + d8 + 4) = (f32x4){lf[4], lf[5], lf[6], lf[7]};
        }
    }
    __syncthreads();
    const int d = tid & 127, part = tid >> 7;
    {
        float a = 0.f;
#pragma unroll
        for (int i = 0; i < 16; ++i) { const int t = part * 16 + i; a += BC[t * 128 + d]; BC[t * 128 + d] = a; }
        PT[part * 128 + d] = a;
    }
    __syncthreads();
}
struct HcPre { u32x4 zv[2], vv[2], qv[2], gp[2]; };
template <int PASS>
__device__ __forceinline__ void hgrn2_load(const Params& p, int item, int c, HcPre& r) {
    int tid = threadIdx.x; asm volatile("" : "+v"(tid));
    const int bh = item >> 3, sup = item & 7, b = bh >> 2, h = bh & 3;
    const bf16_t* PROJ = (const bf16_t*)(p.ws + WS_BIG);
    const size_t rowbase = (size_t)b * SEQ + (size_t)(sup * 8 + c) * 64;
    const int d8 = (tid & 15) * 8, t = tid >> 4;
#pragma unroll
    for (int rr = 0; rr < 2; ++rr) {
        r.zv[rr] = *(const u32x4*)(PROJ + proj_off(rowbase + t + rr * 32, 3072) + 1536 + h * 128 + d8);
        r.vv[rr] = *(const u32x4*)(PROJ + proj_off(rowbase + t + rr * 32, 3072) + 2048 + h * 128 + d8);
        if (PASS == 2) r.qv[rr] = *(const u32x4*)(PROJ + proj_off(rowbase + t + rr * 32, 3072) + 1024 + h * 128 + d8);
    }
    if (PASS == 2) {
        const bf16_t* gp = PROJ + proj_off(rowbase + (tid >> 3), 3072) + 2560 + h * 128 + (tid & 7) * 16;
        r.gp[0] = *(const u32x4*)gp; r.gp[1] = *(const u32x4*)(gp + 8);
    }
}
template <int PASS>
__device__ __forceinline__ void hgrn2_init(const Params& p, int item, f32x4 (&S)[8], float (&Gt)[4]) {
    int tid = threadIdx.x; asm volatile("" : "+v"(tid));
    const int lane = tid & 63, w = __builtin_amdgcn_readfirstlane(tid >> 6), fq = lane >> 4;
#pragma unroll
    for (int n = 0; n < 8; ++n) S[n] = (f32x4){0.f, 0.f, 0.f, 0.f};
#pragma unroll
    for (int jj = 0; jj < 4; ++jj) Gt[jj] = 1.0f;
    if (PASS == 2) {
        const int bh = item >> 3, sup = item & 7;
        const float* SUMb = (const float*)(p.ws + WS_ST); const float* GTb = (const float*)(p.ws + WS_HGG);
        for (int s2 = 0; s2 < sup; s2 += 2) {
            const bool two = (s2 + 1 < sup);
            const size_t ita = (size_t)bh * 8 + s2, itb = (size_t)bh * 8 + (two ? s2 + 1 : s2);
            const f32x4 ga = *(const f32x4*)(GTb + ita * 128 + w * 16 + fq * 4), gb = *(const f32x4*)(GTb + itb * 128 + w * 16 + fq * 4);
            f32x4 Ta[8], Tb[8];
#pragma unroll
            for (int n = 0; n < 8; ++n) { Ta[n] = *(const f32x4*)(SUMb + ita * 16384 + (size_t)((n * 8 + w) * 64 + lane) * 4); Tb[n] = *(const f32x4*)(SUMb + itb * 16384 + (size_t)((n * 8 + w) * 64 + lane) * 4); }
#pragma unroll
            for (int n = 0; n < 8; ++n) { S[n] = ga * S[n] + Ta[n]; if (two) S[n] = gb * S[n] + Tb[n]; }
        }
    }
}
__device__ __forceinline__ void hgrn2_finish(const Params& p, int item, const f32x4 (&S)[8], const float (&Gt)[4]) {
    int tid = threadIdx.x; asm volatile("" : "+v"(tid));
    const int lane = tid & 63, w = __builtin_amdgcn_readfirstlane(tid >> 6), fr = lane & 15, fq = lane >> 4;
    float* SUMb = (float*)(p.ws + WS_ST); float* GTb = (float*)(p.ws + WS_HGG);
#pragma unroll
    for (int n = 0; n < 8; ++n) *(f32x4*)(SUMb + (size_t)item * 16384 + (size_t)((n * 8 + w) * 64 + lane) * 4) = S[n];
    if (fr == 0) *(f32x4*)(GTb + (size_t)item * 128 + w * 16 + fq * 4) = (f32x4){Gt[0], Gt[1], Gt[2], Gt[3]};
}
template <int PASS>
__device__ __forceinline__ void hgrn2_chunk(LAS unsigned char* lds, const Params& p, int j, int item, int c, const HcPre& pre, f32x4 (&S)[8], float (&Gt)[4], const float (&lb)[8]) {
    int tid = threadIdx.x; asm volatile("" : "+v"(tid));
    const int lane = tid & 63, w = __builtin_amdgcn_readfirstlane(tid >> 6), fr = lane & 15, fq = lane >> 4;
    const int bh = item >> 3, sup = item & 7, b = bh >> 2, h = bh & 3;
    bf16_t* Y = (bf16_t*)(p.ws + WS_Y);
    const size_t rowbase = (size_t)b * SEQ + (size_t)(sup * 8 + c) * 64;
    LAS float* BC = (LAS float*)lds;
    LAS bf16_t* QA = (LAS bf16_t*)(lds + 32768);
    LAS bf16_t* KA = (LAS bf16_t*)(lds + 50176);
    LAS bf16_t* VT = (LAS bf16_t*)(lds + 67584);
    LAS bf16_t* SS = (LAS bf16_t*)(lds + 86016);
    LAS bf16_t* AT = (LAS bf16_t*)(lds + 120832);
    LAS float* PT = (LAS float*)(lds + 130048);
    LAS bf16_t* VN = SS;
    const float* lbl = p.in[11];
    const int d8 = (tid & 15) * 8, t = tid >> 4;
    u32x4 zv[2], vv[2], qv[2], gpre[2];
#pragma unroll
    for (int rr = 0; rr < 2; ++rr) { zv[rr] = pre.zv[rr]; vv[rr] = pre.vv[rr]; if (PASS == 2) { qv[rr] = pre.qv[rr]; gpre[rr] = pre.gp[rr]; } }
    f32x4 gnv[4];
    if (PASS == 2) {
        const float* gn0 = p.in[12] + j * 512 + h * 128 + (tid & 7) * 16;
#pragma unroll
        for (int q = 0; q < 4; ++q) gnv[q] = *(const f32x4*)(gn0 + q * 4);
    }
#pragma unroll
    for (int rr = 0; rr < 2; ++rr) *(LAS u32x4*)(VN + (t + rr * 32) * 136 + d8) = vv[rr];
    float kq[2][8];
    hgrn_bcum2(BC, PT, zv, lb, tid, kq);
    {
        float bref[8], c1[8], c2[8], c3[8];
        {
            const f32x4 pa0 = *(const LAS f32x4*)(PT + d8), pa1 = *(const LAS f32x4*)(PT + d8 + 4);
            const f32x4 pb0 = *(const LAS f32x4*)(PT + 128 + d8), pb1 = *(const LAS f32x4*)(PT + 128 + d8 + 4);
            const f32x4 pc0 = *(const LAS f32x4*)(PT + 256 + d8), pc1 = *(const LAS f32x4*)(PT + 256 + d8 + 4);
#pragma unroll
            for (int q = 0; q < 4; ++q) { c1[q] = pa0[q]; c1[4 + q] = pa1[q]; c2[q] = pa0[q] + pb0[q]; c2[4 + q] = pa1[q] + pb1[q]; c3[q] = c2[q] + pc0[q]; c3[4 + q] = c2[4 + q] + pc1[q]; }
        }
        const bool hi16 = (t >> 4) != 0;
#pragma unroll
        for (int q = 0; q < 8; ++q) bref[q] = BC[31 * 128 + d8 + q] + c1[q];
#pragma unroll
        for (int rr = 0; rr < 2; ++rr) {
            const int tr = t + rr * 32;
            float qa[8], ka[8];
#pragma unroll
            for (int q = 0; q < 8; ++q) {
                const float bc = BC[tr * 128 + d8 + q] + (rr == 0 ? (hi16 ? c1[q] : 0.f) : (hi16 ? c3[q] : c2[q]));
                const float dq = fminf(fmaxf(bc - bref[q], -80.f), 80.f);
                const float e1 = __expf(dq);
                if (PASS == 2) { const float qq = silu_((q & 1) ? bf_hi(qv[rr][q >> 1]) : bf_lo(qv[rr][q >> 1])); qa[q] = qq * e1; }
                ka[q] = kq[rr][q] * rcp_(e1);
            }
            u32x4 o;
            if (PASS == 2) {
#pragma unroll
                for (int q = 0; q < 4; ++q) o[q] = cvt_pk_bf16(qa[2 * q], qa[2 * q + 1]);
                *(LAS u32x4*)(QA + tr * 136 + d8) = o;
            }
#pragma unroll
            for (int q = 0; q < 4; ++q) o[q] = cvt_pk_bf16(ka[2 * q], ka[2 * q + 1]);
            *(LAS u32x4*)(KA + tr * 136 + d8) = o;
        }
        {
            const int e = tid & 127, tq = tid >> 7;
            bf16_t vq[16];
#pragma unroll
            for (int i = 0; i < 16; ++i) vq[i] = VN[(tq * 16 + i) * 136 + e];
            u32x4 p0, p1;
#pragma unroll
            for (int q = 0; q < 4; ++q) { p0[q] = (unsigned)vq[2 * q] | ((unsigned)vq[2 * q + 1] << 16); p1[q] = (unsigned)vq[8 + 2 * q] | ((unsigned)vq[8 + 2 * q + 1] << 16); }
            *(LAS u32x4*)(VT + e * 72 + tq * 16) = p0; *(LAS u32x4*)(VT + e * 72 + tq * 16 + 8) = p1;
        }
    }
    float gsc[4], sc[4], eb[4];
#pragma unroll
    for (int jj = 0; jj < 4; ++jj) { const int dd = w * 16 + fq * 4 + jj; const float p0 = PT[dd], br = BC[31 * 128 + dd] + p0, bl = BC[63 * 128 + dd] + ((p0 + PT[128 + dd]) + PT[256 + dd]); gsc[jj] = __expf(bl); sc[jj] = __expf(bl - br); eb[jj] = __expf(br); }
    __syncthreads();
    if (PASS == 2) {
#pragma unroll
        for (int n = 0; n < 8; ++n) { u32x2 o; o.x = cvt_pk_bf16(S[n][0] * eb[0], S[n][1] * eb[1]); o.y = cvt_pk_bf16(S[n][2] * eb[2], S[n][3] * eb[3]);
            *(LAS u32x2*)(SS + (n * 16 + fr) * 136 + w * 16 + fq * 4) = o; }
        {
            const int tt = w >> 1;
#pragma unroll
            for (int si = 0; si < 2; ++si) {
                const int ss = (w & 1) * 2 + si;
                f32x4 acc = (f32x4){0.f, 0.f, 0.f, 0.f};
                if (ss <= tt) {
#pragma unroll
                    for (int kk = 0; kk < 4; ++kk) {
                        const bf16x8 a = *(const LAS bf16x8*)(QA + (tt * 16 + fr) * 136 + kk * 32 + fq * 8);
                        const bf16x8 bb = *(const LAS bf16x8*)(KA + (ss * 16 + fr) * 136 + kk * 32 + fq * 8);
                        acc = __builtin_amdgcn_mfma_f32_16x16x32_bf16(a, bb, acc, 0, 0, 0);
                    }
                }
#pragma unroll
                for (int jj = 0; jj < 4; ++jj) {
                    const int tq2 = tt * 16 + fq * 4 + jj, sq2 = ss * 16 + fr;
                    const float v = (sq2 <= tq2) ? acc[jj] : 0.f;
                    AT[tq2 * 72 + sq2] = f2bf(v);
                }
            }
        }
        __syncthreads();
        {
            const int tt = w >> 1, n0 = (w & 1) * 4;
            f32x4 acc[4];
#pragma unroll
            for (int n = 0; n < 4; ++n) acc[n] = (f32x4){0.f, 0.f, 0.f, 0.f};
#pragma unroll
            for (int kk = 0; kk < 4; ++kk) {
                const bf16x8 a = *(const LAS bf16x8*)(QA + (tt * 16 + fr) * 136 + kk * 32 + fq * 8);
#pragma unroll
                for (int n = 0; n < 4; ++n) { const bf16x8 bb = *(const LAS bf16x8*)(SS + ((n0 + n) * 16 + fr) * 136 + kk * 32 + fq * 8); acc[n] = __builtin_amdgcn_mfma_f32_16x16x32_bf16(a, bb, acc[n], 0, 0, 0); }
            }
#pragma unroll
            for (int kk = 0; kk < 2; ++kk) {
                if (kk * 32 <= tt * 16 + 15) {
                    const bf16x8 a = *(const LAS bf16x8*)(AT + (tt * 16 + fr) * 72 + kk * 32 + fq * 8);
#pragma unroll
                    for (int n = 0; n < 4; ++n) { const bf16x8 bb = *(const LAS bf16x8*)(VT + ((n0 + n) * 16 + fr) * 72 + kk * 32 + fq * 8); acc[n] = __builtin_amdgcn_mfma_f32_16x16x32_bf16(a, bb, acc[n], 0, 0, 0); }
                }
            }
            LAS float* OS = BC;
#pragma unroll
            for (int n = 0; n < 4; ++n)
#pragma unroll
                for (int jj = 0; jj < 4; ++jj) OS[(tt * 16 + fq * 4 + jj) * 128 + (n0 + n) * 16 + fr] = acc[n][jj];
        }
    }
    {
        bf16x8 af[2];
#pragma unroll
        for (int kk = 0; kk < 2; ++kk)
#pragma unroll
            for (int i = 0; i < 8; ++i) af[kk][i] = (short)KA[(kk * 32 + fq * 8 + i) * 136 + w * 16 + fr];
#pragma unroll
        for (int n = 0; n < 8; ++n) {
            f32x4 acc = (f32x4){0.f, 0.f, 0.f, 0.f};
#pragma unroll
            for (int kk = 0; kk < 2; ++kk) { const bf16x8 bb = *(const LAS bf16x8*)(VT + (n * 16 + fr) * 72 + kk * 32 + fq * 8); acc = __builtin_amdgcn_mfma_f32_16x16x32_bf16(af[kk], bb, acc, 0, 0, 0); }
#pragma unroll
            for (int jj = 0; jj < 4; ++jj) S[n][jj] = gsc[jj] * S[n][jj] + sc[jj] * acc[jj];
        }
        if (PASS == 1) {
#pragma unroll
            for (int jj = 0; jj < 4; ++jj) Gt[jj] *= gsc[jj];
        }
    }
    if (PASS == 2) {
        __syncthreads();
        LAS float* OS = BC;
        const int t2 = tid >> 3, e16 = (tid & 7) * 16;
        f32x4 ov[4]; float ss = 0.f;
#pragma unroll
        for (int q = 0; q < 4; ++q) { ov[q] = *(const LAS f32x4*)(OS + t2 * 128 + e16 + q * 4); ss += (ov[q][0] * ov[q][0] + ov[q][1] * ov[q][1]) + (ov[q][2] * ov[q][2] + ov[q][3] * ov[q][3]); }
        ss += __shfl_xor(ss, 1); ss += __shfl_xor(ss, 2); ss += __shfl_xor(ss, 4);
        const float rstd = rsqrtf(ss * (1.0f / 128.0f) + EPS);
        bf16_t* yp = Y + tiled(rowbase + t2, 512 + h * 128 + e16, 1024);
#pragma unroll
        for (int hlf = 0; hlf < 2; ++hlf) {
            const u32x4 gv = gpre[hlf];
            const f32x4 n0v = gnv[hlf * 2], n1v = gnv[hlf * 2 + 1];
            u32x4 o;
#pragma unroll
            for (int q = 0; q < 4; ++q) {
                const float o0 = ov[hlf * 2 + (q >> 1)][(q & 1) * 2], o1 = ov[hlf * 2 + (q >> 1)][(q & 1) * 2 + 1];
                const float g0 = (q < 2) ? n0v[2 * q] : n1v[2 * q - 4], g1 = (q < 2) ? n0v[2 * q + 1] : n1v[2 * q - 3];
                o[q] = cvt_pk_bf16(o0 * rstd * g0 * silu_(bf_lo(gv[q])), o1 * rstd * g1 * silu_(bf_hi(gv[q])));
            }
            *(u32x4*)(yp + hlf * 8) = o;
        }
        __syncthreads();
    }
}
template <int PASS>
__device__ __forceinline__ void hgrn2_run(LAS unsigned char* lds, const Params& p, int j, int bid, int G, int nitems) {
    f32x4 S[8]; float Gt[4]; float lbv[8]; HcPre nxt;
    const int nsteps = nitems * 8;
    if (nsteps <= 0) return;
    hgrn2_load<PASS>(p, bid, 0, nxt);
#pragma unroll 1
    for (int step = 0; step < nsteps; ++step) {
        const bool mir = (G == 32) && (nitems == 2);
        const int k0 = step >> 3, k1 = (step + 1) >> 3;
        const int item = (mir && k0 == 1) ? ((bid & ~31) + 32 + ((bid & 31) ^ 7)) : bid + k0 * G, c = step & 7;
        const HcPre cur = nxt;
        if (step + 1 < nsteps) hgrn2_load<PASS>(p, (mir && k1 == 1) ? ((bid & ~31) + 32 + ((bid & 31) ^ 7)) : bid + k1 * G, (step + 1) & 7, nxt);
        if (c == 0) {
            hgrn2_init<PASS>(p, item, S, Gt);
            int tl = threadIdx.x; asm volatile("" : "+v"(tl));
            const int hh = (item >> 3) & 3, d8l = (tl & 15) * 8; const float* lbl = p.in[11];
#pragma unroll
            for (int q = 0; q < 8; ++q) { const int ch = hh * 128 + d8l + q; lbv[q] = (j == 0) ? 0.f : sigmoid_(lbl[512 + ch] - lbl[ch]); }
        }
        hgrn2_chunk<PASS>(lds, p, j, item, c, cur, S, Gt, lbv);
        if (PASS == 1 && c == 7) hgrn2_finish(p, item, S, Gt);
    }
    __syncthreads();
}

struct SguPre { u32x4 vv[4]; u32x2 uv[8]; float bias; };
__device__ __forceinline__ void sgu_load(const Params& p, int j, int item, SguPre& r) {
    int tid = threadIdx.x; asm volatile("" : "+v"(tid));
    const int lane = tid & 63, w = __builtin_amdgcn_readfirstlane(tid >> 6), fr = lane & 15, fq = lane >> 4;
    const int g = item & 3, n = (item >> 2) & 31, b = item >> 7;
    const bf16_t* PROJ = (const bf16_t*)(p.ws + WS_BIG);
    const size_t rowbase = (size_t)b * SEQ + n * 128;
    const bf16_t* vp = PROJ + proj_off(rowbase + (tid >> 2), 1536) + 512 + g * 128 + (tid & 3) * 32;
#pragma unroll
    for (int i = 0; i < 4; ++i) r.vv[i] = *(const u32x4*)(vp + i * 8);
    const bf16_t* up = PROJ + proj_off(rowbase + w * 16 + fr, 1536) + g * 128 + fq * 4;
#pragma unroll
    for (int q = 0; q < 8; ++q) r.uv[q] = *(const u32x2*)(up + q * 16);
    r.bias = p.in[16][(size_t)(j * 4 + g) * 128 + w * 16 + fr];
}
__device__ __forceinline__ void sgu_weights(LAS unsigned char* lds, const Params& p, int j, int g) {
    int tid = threadIdx.x; asm volatile("" : "+v"(tid));
    LAS bf16_t* WL = (LAS bf16_t*)(lds + 69632);
    const bf16_t* Wm = (const bf16_t*)(p.ws + WS_SMALL + SM_SGUW) + (size_t)(j * 4 + g) * 16384;
#pragma unroll
    for (int i = 0; i < 4; ++i) { const int idx = tid + i * 512; *(LAS u32x4*)(WL + (idx >> 4) * 136 + (idx & 15) * 8) = *(const u32x4*)(Wm + (idx >> 4) * 128 + (idx & 15) * 8); }
}
__device__ __forceinline__ void sgu_item(LAS unsigned char* lds, const Params& p, int j, int item, const SguPre& pre) {
    int tid = threadIdx.x; asm volatile("" : "+v"(tid));
    const int lane = tid & 63, w = __builtin_amdgcn_readfirstlane(tid >> 6), fr = lane & 15, fq = lane >> 4;
    const int g = item & 3, n = (item >> 2) & 31, b = item >> 7;
    bf16_t* Y = (bf16_t*)(p.ws + WS_Y);
    const size_t rowbase = (size_t)b * SEQ + n * 128;
    LAS bf16_t* VT = (LAS bf16_t*)lds;
    LAS bf16_t* WL = (LAS bf16_t*)(lds + 69632);
    const int tC = w * 16 + fr;
    u32x2 uv[8];
#pragma unroll
    for (int q = 0; q < 8; ++q) uv[q] = pre.uv[q];
    {
        const int s = tid >> 2, qtr = tid & 3;
        float v[32]; float sum = 0.f;
#pragma unroll
        for (int i = 0; i < 4; ++i) { const u32x4 vv = pre.vv[i];
#pragma unroll
            for (int q = 0; q < 4; ++q) { v[i * 8 + 2 * q] = bf_lo(vv[q]); v[i * 8 + 2 * q + 1] = bf_hi(vv[q]); sum += v[i * 8 + 2 * q] + v[i * 8 + 2 * q + 1]; } }
        sum += __shfl_xor(sum, 1); sum += __shfl_xor(sum, 2);
        const float mu = sum * (1.0f / 128.0f); float var = 0.f;
#pragma unroll
        for (int i = 0; i < 32; ++i) { v[i] -= mu; var += v[i] * v[i]; }
        var += __shfl_xor(var, 1); var += __shfl_xor(var, 2);
        const float rstd = rsqrtf(var * (1.0f / 128.0f) + EPS);
        LAS bf16_t* VN = (LAS bf16_t*)(lds + 34816);
#pragma unroll
        for (int i = 0; i < 4; ++i) { u32x4 o;
#pragma unroll
            for (int q = 0; q < 4; ++q) o[q] = cvt_pk_bf16(v[i * 8 + 2 * q] * rstd, v[i * 8 + 2 * q + 1] * rstd);
            *(LAS u32x4*)(VN + s * 136 + qtr * 32 + i * 8) = o; }
    }
    __syncthreads();
    {
        LAS const bf16_t* VN = (LAS const bf16_t*)(lds + 34816);
        const int c = tid & 127, sq = tid >> 7;
        bf16_t vq[32];
#pragma unroll
        for (int i = 0; i < 32; ++i) vq[i] = VN[(sq * 32 + i) * 136 + c];
#pragma unroll
        for (int i = 0; i < 4; ++i) { u32x4 o;
#pragma unroll
            for (int q = 0; q < 4; ++q) o[q] = (unsigned)vq[i * 8 + 2 * q] | ((unsigned)vq[i * 8 + 2 * q + 1] << 16);
            *(LAS u32x4*)(VT + c * 136 + sq * 32 + i * 8) = o; }
    }
    __syncthreads();
    {
        f32x4 acc[8];
#pragma unroll
        for (int q = 0; q < 8; ++q) acc[q] = (f32x4){0.f, 0.f, 0.f, 0.f};
        const int kmax = w >> 1;
#pragma unroll
        for (int kk = 0; kk < 4; ++kk) {
            if (kk <= kmax) {
                const bf16x8 wf = *(const LAS bf16x8*)(WL + (w * 16 + fr) * 136 + kk * 32 + fq * 8);
#pragma unroll
                for (int q = 0; q < 8; ++q) { const bf16x8 vf = *(const LAS bf16x8*)(VT + (q * 16 + fr) * 136 + kk * 32 + fq * 8); acc[q] = __builtin_amdgcn_mfma_f32_16x16x32_bf16(vf, wf, acc[q], 0, 0, 0); }
            }
        }
        const float bias = pre.bias;
        bf16_t* yp = Y + tiled(rowbase + tC, g * 128 + fq * 4, 1024);
#pragma unroll
        for (int q = 0; q < 8; ++q) {
            u32x2 o; o.x = cvt_pk_bf16(bf_lo(uv[q].x) * (acc[q][0] + bias), bf_hi(uv[q].x) * (acc[q][1] + bias)); o.y = cvt_pk_bf16(bf_lo(uv[q].y) * (acc[q][2] + bias), bf_hi(uv[q].y) * (acc[q][3] + bias));
            *(u32x2*)(yp + (q >> 2) * 16384 + (q & 3) * 16) = o;
        }
    }
    __syncthreads();
}

struct PoolPre { u32x4 pl[5]; u32x4 wt[4]; };
__device__ __forceinline__ void pool_load(const Params& p, int j, int item, PoolPre& r) {
    int tid = threadIdx.x; asm volatile("" : "+v"(tid));
    const int gi = item & 3, tile = (item >> 2) & 31, b = item >> 7;
    const bf16_t* PROJ = (const bf16_t*)(p.ws + WS_BIG);
    const int t0 = tile * 128;
    const bf16_t* PWT = (const bf16_t*)(p.ws + WS_SMALL + SM_PWT) + (size_t)(j * 4 + gi) * 16384;
#pragma unroll
    for (int i = 0; i < 4; ++i) { const int idx = tid + i * 512; r.wt[i] = *(const u32x4*)(PWT + (idx >> 4) * 128 + (idx & 15) * 8); }
#pragma unroll
    for (int i = 0; i < 5; ++i) {
        const int idx = tid + i * 512; const int rr = idx >> 4, c8 = (idx & 15) * 8; const int ts = t0 - 16 + rr;
        u32x4 vv = (u32x4){0u, 0u, 0u, 0u};
        if (idx < 144 * 16 && ts >= 0) vv = *(const u32x4*)(PROJ + proj_off((size_t)b * SEQ + ts, 1536) + 1024 + gi * 128 + c8);
        r.pl[i] = vv;
    }
}
__device__ __forceinline__ void pool_item(LAS unsigned char* lds, const Params& p, int j, int item, const PoolPre& pre) {
    int tid = threadIdx.x; asm volatile("" : "+v"(tid));
    const int lane = tid & 63, w = __builtin_amdgcn_readfirstlane(tid >> 6), fr = lane & 15, fq = lane >> 4;
    const int gi = item & 3, tile = (item >> 2) & 31, b = item >> 7;
    bf16_t* Y = (bf16_t*)(p.ws + WS_Y);
    const int t0 = tile * 128;
    const size_t rowbase = (size_t)b * SEQ + t0;
    LAS float* PL = (LAS float*)lds;
    LAS bf16_t* PA = (LAS bf16_t*)(lds + 73728);
    LAS bf16_t* PWL = (LAS bf16_t*)(lds + 108544);
    {
#pragma unroll
        for (int i = 0; i < 5; ++i) {
            const int idx = tid + i * 512;
            if (idx < 144 * 16) {
                const int rr = idx >> 4, c8 = (idx & 15) * 8; const u32x4 vv = pre.pl[i];
                *(LAS f32x4*)(PL + rr * 128 + c8) = (f32x4){bf_lo(vv[0]), bf_hi(vv[0]), bf_lo(vv[1]), bf_hi(vv[1])};
                *(LAS f32x4*)(PL + rr * 128 + c8 + 4) = (f32x4){bf_lo(vv[2]), bf_hi(vv[2]), bf_lo(vv[3]), bf_hi(vv[3])};
            }
        }
#pragma unroll
        for (int i = 0; i < 4; ++i) { const int idx = tid + i * 512; *(LAS u32x4*)(PWL + (idx >> 4) * 136 + (idx & 15) * 8) = pre.wt[i]; }
    }
    __syncthreads();
    {
        const int tg = tid >> 4, c8 = (tid & 15) * 8; const int win = 2 << gi;
        const int tf = tg * 4;
        f32x4 s0 = (f32x4){0.f, 0.f, 0.f, 0.f}, s1 = (f32x4){0.f, 0.f, 0.f, 0.f};
        for (int k = 0; k < win; ++k) { const LAS float* rp = PL + (tf + 16 - k) * 128 + c8; s0 += *(const LAS f32x4*)rp; s1 += *(const LAS f32x4*)(rp + 4); }
#pragma unroll
        for (int i = 0; i < 4; ++i) {
            const int t = tf + i;
            const LAS float* cp = PL + (t + 16) * 128 + c8;
            const f32x4 c0 = *(const LAS f32x4*)cp, c1 = *(const LAS f32x4*)(cp + 4);
            if (i > 0) { const LAS float* op = PL + (t + 16 - win) * 128 + c8; s0 += c0 - *(const LAS f32x4*)op; s1 += c1 - *(const LAS f32x4*)(op + 4); }
            const int tabs = t0 + t; const int cnt = (tabs + 1 < win) ? tabs + 1 : win;
            const float inv = rcp_((float)cnt);
            const f32x4 a = s0 * inv - c0, bq = s1 * inv - c1;
            u32x4 o; o.x = cvt_pk_bf16(a[0], a[1]); o.y = cvt_pk_bf16(a[2], a[3]); o.z = cvt_pk_bf16(bq[0], bq[1]); o.w = cvt_pk_bf16(bq[2], bq[3]);
            *(LAS u32x4*)(PA + t * 136 + c8) = o;
        }
    }
    __syncthreads();
    {
        f32x4 acc[8];
#pragma unroll
        for (int q = 0; q < 8; ++q) acc[q] = (f32x4){0.f, 0.f, 0.f, 0.f};
#pragma unroll
        for (int kk = 0; kk < 4; ++kk) {
            const bf16x8 pf = *(const LAS bf16x8*)(PA + (w * 16 + fr) * 136 + kk * 32 + fq * 8);
#pragma unroll
            for (int q = 0; q < 8; ++q) { const bf16x8 wf = *(const LAS bf16x8*)(PWL + (q * 16 + fr) * 136 + kk * 32 + fq * 8); acc[q] = __builtin_amdgcn_mfma_f32_16x16x32_bf16(wf, pf, acc[q], 0, 0, 0); }
        }
        const int t = w * 16 + fr;
        bf16_t* yp = Y + tiled(rowbase + t, 512 + gi * 128 + fq * 4, 1024);
#pragma unroll
        for (int q = 0; q < 8; ++q) { u32x2 o; o.x = cvt_pk_bf16(acc[q][0], acc[q][1]); o.y = cvt_pk_bf16(acc[q][2], acc[q][3]); *(u32x2*)(yp + (q >> 2) * 16384 + (q & 3) * 16) = o; }
    }
    __syncthreads();
}

__device__ __forceinline__ void zero_y(const Params& p) {
    int tid = threadIdx.x; asm volatile("" : "+v"(tid));
    u32x4* yz = (u32x4*)(p.ws + WS_Y);
    for (size_t i = (size_t)blockIdx.x * NTHR + tid; i < (size_t)MTOK * 128; i += (size_t)gridDim.x * NTHR) yz[i] = (u32x4){0u, 0u, 0u, 0u};
}
__device__ __forceinline__ void final_norm(const Params& p) {
    int tid = threadIdx.x; asm volatile("" : "+v"(tid));
    const int lane = tid & 63, wave = tid >> 6;
    const int gw = blockIdx.x * 8 + wave, NGW = gridDim.x * 8;
    const float* rowss = (const float*)(p.ws + WS_ROWSS); const float* gain = p.in[22];
    f32x4 gv[4];
#pragma unroll
    for (int q = 0; q < 4; ++q) gv[q] = *((const f32x4*)gain + lane + 64 * q);
    for (int row = gw; row < MTOK; row += 4 * NGW) {
        f32x4 v[4][4]; f32x4 st[4];
#pragma unroll
        for (int r = 0; r < 4; ++r) {
            const f32x4* hr = (const f32x4*)(p.out + (size_t)(row + r * NGW) * DM) + lane;
#pragma unroll
            for (int q = 0; q < 4; ++q) v[r][q] = hr[64 * q];
            const f32x4* sp = (const f32x4*)(rowss + (size_t)(row + r * NGW) * 16);
            st[r] = (sp[0] + sp[1]) + (sp[2] + sp[3]);
        }
#pragma unroll
        for (int r = 0; r < 4; ++r) {
            const float rstd = rsqrtf(((st[r][0] + st[r][1]) + (st[r][2] + st[r][3])) * (1.0f / 1024.0f) + EPS);
            f32x4* hw = (f32x4*)(p.out + (size_t)(row + r * NGW) * DM) + lane;
#pragma unroll
            for (int q = 0; q < 4; ++q) hw[64 * q] = v[r][q] * rstd * gv[q];
        }
    }
}

#define XB_TMO      128
#define XB_XCNT(j)  (256  + 64 * (j))
#define XB_XSUB(j)  (1280 + 64 * (j))
#define XB_XGEN(j)  (2304 + 64 * (j))
#define XB_TOP      3328
#define XB_TOPGEN   3392
#define XCD_BAR_WORDS 3456
#define XB_SPIN_CAP (1u << 18)
__device__ __forceinline__ unsigned xb_ld(unsigned* p)              { return __hip_atomic_load(p, __ATOMIC_RELAXED, __HIP_MEMORY_SCOPE_AGENT); }
__device__ __forceinline__ unsigned xb_add(unsigned* p, unsigned v) { return __hip_atomic_fetch_add(p, v, __ATOMIC_RELAXED, __HIP_MEMORY_SCOPE_AGENT); }
__device__ __forceinline__ unsigned xb_xcc_id() { return (unsigned)__builtin_amdgcn_s_getreg((3 << 11) | 20) & 0xFu; }
#define XB_SPIN(cond, bar) do { unsigned _sp = 0; while (cond) { __builtin_amdgcn_s_sleep(1); \
    if ((++_sp & 255u) == 0u) { if (xb_ld(&(bar)[XB_TMO])) break; if (_sp > XB_SPIN_CAP) { atomicAdd(&(bar)[XB_TMO], 1u); break; } } } } while (0)
struct XcdBarrier { unsigned* bar; unsigned x; volatile LAS unsigned* st; };
__device__ __forceinline__ XcdBarrier xcd_barrier_post(unsigned* bar, volatile LAS unsigned* st) {
    XcdBarrier b; b.bar = bar; b.x = xb_xcc_id(); b.st = st;
    if (threadIdx.x == 0) (void)xb_add(&bar[XB_XCNT(b.x)], 1u);
    return b;
}
__device__ __forceinline__ void xcd_barrier_complete(unsigned* bar, unsigned x, unsigned& nloc, unsigned& nx) {
    const unsigned G = gridDim.x * gridDim.y * gridDim.z;
    unsigned sum, cnt, mine, sp = 0u;
    for (;;) {
        sum = 0u; cnt = 0u; mine = 0u;
#pragma unroll
        for (unsigned j = 0; j < 16; ++j) { const unsigned c = xb_ld(&bar[XB_XCNT(j)]); sum += c; cnt += (c > 0u) ? 1u : 0u; mine = (j == x) ? c : mine; }
        if (sum == G) break;
        __builtin_amdgcn_s_sleep(1);
        if ((++sp & 255u) == 0u) { if (xb_ld(&bar[XB_TMO])) break; if (sp > XB_SPIN_CAP) { atomicAdd(&bar[XB_TMO], 1u); break; } }
    }
    nloc = mine > 0u ? mine : 1u; nx = cnt > 0u ? cnt : 1u;
}
__device__ __forceinline__ void xcd_barrier(const XcdBarrier& b) {
    asm volatile("s_waitcnt vmcnt(0)" ::: "memory");
    __syncthreads();
    if (threadIdx.x == 0) {
        unsigned* bar = b.bar;
        __builtin_amdgcn_s_waitcnt(0);
        unsigned nloc = b.st[0], nx = b.st[1];
        if (nloc == 0u) { xcd_barrier_complete(bar, b.x, nloc, nx); b.st[0] = nloc; b.st[1] = nx; }
        const unsigned old = xb_add(&bar[XB_XSUB(b.x)], 1u);
        const unsigned gen = old / nloc;
        if (old + 1u == (gen + 1u) * nloc) {
            __builtin_amdgcn_fence(__ATOMIC_RELEASE, "agent");
            asm volatile("s_waitcnt vmcnt(0)" ::: "memory");
            const unsigned og = xb_add(&bar[XB_TOP], 1u);
            const unsigned tg = og / nx;
            if (og + 1u == (tg + 1u) * nx) xb_add(&bar[XB_TOPGEN], 1u);
            else XB_SPIN(xb_ld(&bar[XB_TOPGEN]) == tg, bar);
            __builtin_amdgcn_fence(__ATOMIC_ACQUIRE, "agent");
            xb_add(&bar[XB_XGEN(b.x)], 1u);
            asm volatile("s_waitcnt vmcnt(0)" ::: "memory");
        } else {
            XB_SPIN(xb_ld(&bar[XB_XGEN(b.x)]) == gen, bar);
            __builtin_amdgcn_fence(__ATOMIC_ACQUIRE, "agent");
            asm volatile("s_waitcnt vmcnt(0)" ::: "memory");
        }
    }
    __syncthreads();
}

__device__ __forceinline__ void xcd_local_barrier(const XcdBarrier& b) {
    asm volatile("s_waitcnt vmcnt(0)" ::: "memory");
    __syncthreads();
    if (threadIdx.x == 0) {
        unsigned* bar = b.bar;
        __builtin_amdgcn_s_waitcnt(0);
        const unsigned nloc = b.st[0];
        const unsigned old = xb_add(&bar[XB_XSUB(b.x)], 1u);
        const unsigned gen = old / nloc;
        if (old + 1u == (gen + 1u) * nloc) xb_add(&bar[XB_XGEN(b.x)], 1u);
        else XB_SPIN(xb_ld(&bar[XB_XGEN(b.x)]) == gen, bar);
        __builtin_amdgcn_fence(__ATOMIC_ACQUIRE, "agent");
        asm volatile("s_waitcnt vmcnt(0)" ::: "memory");
    }
    __syncthreads();
}

__global__ void __launch_bounds__(NTHR, 2) fwd_megakernel(Params p) {
    extern __shared__ __attribute__((aligned(16))) unsigned char lds_raw[];
    LAS unsigned char* lds = (LAS unsigned char*)lds_raw;
    const int G = gridDim.x, bid = blockIdx.x;
    bf16_t* WTb = (bf16_t*)(p.ws + WS_WT);
    bf16_t* HB = (bf16_t*)(p.ws + WS_HB); bf16_t* Y = (bf16_t*)(p.ws + WS_Y); bf16_t* BIG = (bf16_t*)(p.ws + WS_BIG);
    float* rowss = (float*)(p.ws + WS_ROWSS);

    volatile LAS unsigned* xst = (volatile LAS unsigned*)(lds + LDS_BYTES - 64);
    if (threadIdx.x < 8) xst[threadIdx.x] = 0u;
    __syncthreads();
    XcdBarrier xbar; xbar.bar = (unsigned*)(p.ws + WS_BAR); xbar.st = xst; xbar.x = xb_xcc_id();
    if (threadIdx.x == 0) xst[2] = xb_add(&xbar.bar[XB_XCNT(xbar.x)], 1u);
    for (int rep = 0; rep < DBG_REP_P0; ++rep) phase0(lds, p);
    cg::this_grid().sync();
    if (threadIdx.x == 0) {
        bool okc = (G % 8) == 0;
        for (unsigned jx = 0; jx < 16; ++jx) { const unsigned cx = xb_ld(&xbar.bar[XB_XCNT(jx)]); okc = okc && (cx == (jx < 8 ? (unsigned)G / 8u : 0u)); }
        xst[4] = okc ? (xst[2] * 8u + xbar.x) : (unsigned)bid; xst[5] = okc ? 1u : 0u;
    }
    __syncthreads();
    const int vid = __builtin_amdgcn_readfirstlane((int)xst[4]);
    const bool xlocal = USE_LOCAL_BAR && (__builtin_amdgcn_readfirstlane((int)xst[5]) != 0);
    const int NX = ((G & 7) == 0) ? 8 : 1, xv = vid % NX, rk = vid / NX, RK = G / NX;
#define SEAM() do { if (xlocal) xcd_local_barrier(xbar); else xcd_barrier(xbar); } while (0)
#define GRID_SYNC() xcd_barrier(xbar)
#pragma unroll 1
    for (int layer = 0; layer < 4; ++layer) {
        const int j = layer >> 1;
        const bool even = (layer & 1) == 0;
        if (even) {
            pg8::Gemm g{HB, WTb + OFF_INE + (size_t)j * 3145728, MTOK, 3072, 1024}; pg8::StaticOrder S; int vq1 = vid, Gq1 = G; asm volatile("" : "+s"(vq1), "+s"(Gq1)); S.init(MTOK, 3072, Gq1, vq1, 0);
            pg8::EpiIn<0> E{BIG, 3072, rowss};
            pg8::gemm_phase(lds, g, S, E);
        } else {
            pg8::Gemm g{HB, WTb + OFF_INO + (size_t)j * 1572864, MTOK, 1536, 1024}; pg8::StaticOrder S; int vq2 = vid, Gq2 = G; asm volatile("" : "+s"(vq2), "+s"(Gq2)); S.init(MTOK, 1536, Gq2, vq2, 0);
            pg8::EpiIn<1> E{BIG, 1536, rowss};
            pg8::gemm_phase(lds, g, S, E);
        }
        if (layer == 0) GRID_SYNC(); else SEAM();
        if (even) {
            for (int i = rk; i < 256 / NX; i += RK) lru_pass<1>(lds, p, j, xv * (256 / NX) + i);
            hgrn2_run<1>(lds, p, j, xv * (512 / NX) + rk, RK, (512 / NX - rk + RK - 1) / RK);
            SEAM();
            for (int i = rk; i < 256 / NX; i += RK) lru_pass<2>(lds, p, j, xv * (256 / NX) + i);
            hgrn2_run<2>(lds, p, j, xv * (512 / NX) + rk, RK, (512 / NX - rk + RK - 1) / RK);
        } else {
            if (rk < 2048 / NX) {
                const int sbase = xv * (2048 / NX);
                if ((RK & 3) == 0) sgu_weights(lds, p, j, (sbase + rk) & 3);
                SguPre snx; sgu_load(p, j, sbase + rk, snx);
                for (int i = rk; i < 2048 / NX; i += RK) {
                    const SguPre scur = snx;
                    if ((RK & 3) != 0) { __syncthreads(); sgu_weights(lds, p, j, (sbase + i) & 3); }
                    if (i + RK < 2048 / NX) sgu_load(p, j, sbase + i + RK, snx);
                    sgu_item(lds, p, j, sbase + i, scur);
                }
            }
            if (rk < 2048 / NX) {
                const int pbase = xv * (2048 / NX);
                PoolPre pnx; pool_load(p, j, pbase + (rk & ~3) + (rk & 3), pnx);
                for (int i = rk, k = 0; i < 2048 / NX; i += RK, ++k) {
                    const PoolPre pcur = pnx;
                    const int i2 = i + RK;
                    if (i2 < 2048 / NX) pool_load(p, j, pbase + (i2 & ~3) + ((i2 + k + 1) & 3), pnx);
                    pool_item(lds, p, j, pbase + (i & ~3) + ((i + k) & 3), pcur);
                }
            }
        }
        SEAM();
        {
            const bf16_t* Wt = even ? WTb + OFF_OUTE + (size_t)j * 1048576 : WTb + OFF_OUTO + (size_t)j * 1048576;
            pg8::Gemm g{Y, Wt, MTOK, 1024, 1024}; pg8::StaticOrder S; int vq3 = vid, Gq3 = G; asm volatile("" : "+s"(vq3), "+s"(Gq3)); S.init(MTOK, 1024, Gq3, vq3, 1);
            pg8::EpiRes E{layer == 0 ? p.in[0] : (const float*)p.out, p.out, HB, rowss};
            pg8::gemm_phase(lds, g, S, E);
        }
        SEAM();
        {
            pg8::Gemm g{HB, WTb + OFF_FIN + (size_t)layer * 4194304, MTOK, 4096, 1024}; pg8::StaticOrder S; int vq4 = vid, Gq4 = G; asm volatile("" : "+s"(vq4), "+s"(Gq4)); S.init(MTOK, 4096, Gq4, vq4, 0);
            pg8::EpiIn<2> E{BIG, 4096, rowss};
            pg8::gemm_phase(lds, g, S, E);
        }
        SEAM();
        {
            pg8::Gemm g{BIG, WTb + OFF_FOUT + (size_t)layer * 4194304, MTOK, 1024, 4096}; pg8::StaticOrder S; int vq5 = vid, Gq5 = G; asm volatile("" : "+s"(vq5), "+s"(Gq5)); S.init(MTOK, 1024, Gq5, vq5, 1);
            pg8::EpiRes E{(const float*)p.out, p.out, HB, rowss};
            pg8::gemm_phase(lds, g, S, E);
        }
        if (layer == 3) GRID_SYNC(); else SEAM();
    }
    for (int rep = 0; rep < DBG_EXTRA_SYNCS; ++rep) GRID_SYNC();
    final_norm(p);
}

extern "C" void kernel_launch(void* const* d_in, const int* in_sizes, int n_in, void* d_out, int out_size, void* d_ws, size_t ws_size, hipStream_t stream) {
    static int grid_blocks = 0;
    if (!grid_blocks) {
        int dev = 0, cus = 0, per_cu = 0;
        (void)hipGetDevice(&dev);
        (void)hipDeviceGetAttribute(&cus, hipDeviceAttributeMultiprocessorCount, dev);
        (void)hipFuncSetAttribute((const void*)fwd_megakernel, hipFuncAttributeMaxDynamicSharedMemorySize, LDS_BYTES);
        (void)hipOccupancyMaxActiveBlocksPerMultiprocessor(&per_cu, (const void*)fwd_megakernel, NTHR, LDS_BYTES);
        (void)hipGetLastError();
        grid_blocks = cus > 0 ? cus : 256;
        if (n_in != 23 || out_size != MTOK * DM || ws_size < (size_t)868 * MiB) fprintf(stderr, "kernel_launch: unexpected shapes n_in %d out %d ws %zu\n", n_in, out_size, ws_size);
    }
    Params p{};
    for (int i = 0; i < 23; ++i) p.in[i] = (const float*)d_in[i];
    p.out = (float*)d_out; p.ws = (unsigned char*)d_ws;
    (void)hipMemsetAsync((unsigned char*)d_ws + WS_BAR, 0, 16384, stream);
    void* args[] = {&p};
    hipError_t e = hipLaunchCooperativeKernel((void*)fwd_megakernel, dim3(grid_blocks), dim3(NTHR), args, LDS_BYTES, stream);
    if (e != hipSuccess) fprintf(stderr, "cooperative launch failed: %s (grid %d)\n", hipGetErrorString(e), grid_blocks);
}
```
